# Optimizing an MI355X kernel written in HIP

```python
import math
import jax, jax.numpy as jnp
from jax import lax
import numpy as np

D_MODEL = 1024
BATCH = 8
SEQ = 8192
DEPTH = 2

HEAD_DIM = 64
M_HEADS = 4
M_DIM = 64
CONV_WIDTH = 4
CHUNK = 128
S_HEADS = 8
S_KV_HEADS = 2
WINDOW = 128
D_HEADS = 4
D_QK = 32
D_V = 64
Q_BLOCK = 128
ROPE_THETA = 10000.0
D_FF = 4 * D_MODEL
EPS = 1e-6

M_WIDTH = M_HEADS * M_DIM
S_WIDTH = S_HEADS * HEAD_DIM
S_KV_WIDTH = S_KV_HEADS * HEAD_DIM
D_QK_WIDTH = D_HEADS * 2 * D_QK
D_WIDTH = D_HEADS * D_V
MIX_WIDTH = M_WIDTH + S_WIDTH + D_WIDTH
SPLIT_SIZES = (M_WIDTH, M_WIDTH, M_WIDTH, M_WIDTH, M_HEADS, M_HEADS,
               S_WIDTH, S_KV_WIDTH, S_KV_WIDTH,
               D_QK_WIDTH, D_QK_WIDTH, D_WIDTH)
IN_WIDTH = sum(SPLIT_SIZES)

kernel_name = 'hybrid_mlstm_swa_diffattn_block'


def rms_norm(x, g):
    xf = x.astype(jnp.float32)
    y = xf * lax.rsqrt(jnp.mean(xf * xf, axis=-1, keepdims=True) + EPS)
    return (y * g.astype(jnp.float32)).astype(x.dtype)


def rope(x, pos):
    d = x.shape[-1]
    half = d // 2
    inv = ROPE_THETA ** (-jnp.arange(half, dtype=jnp.float32) * 2.0 / d)
    ang = pos.astype(jnp.float32)[:, None] * inv[None, :]
    cos = jnp.cos(ang)[None, :, None, :]
    sin = jnp.sin(ang)[None, :, None, :]
    xf = x.astype(jnp.float32)
    x1, x2 = xf[..., :half], xf[..., half:]
    return jnp.concatenate([x1 * cos - x2 * sin, x2 * cos + x1 * sin], axis=-1).astype(x.dtype)


def split_columns(z):
    parts = []
    start = 0
    for size in SPLIT_SIZES:
        parts.append(z[..., start:start + size])
        start += size
    return parts


def causal_conv(x, w, b):
    K = w.shape[0]
    S = x.shape[1]
    xp = jnp.pad(x, ((0, 0), (K - 1, 0), (0, 0)))
    y = xp[:, 0:S, :] * w[0]
    for j in range(1, K):
        y = y + xp[:, j:j + S, :] * w[j]
    return y + b


def mlstm_chunkwise(q, k, v, i_pre, f_pre):
    B, S, H, D = q.shape
    L = CHUNK
    nC = S // L
    qf = q.astype(jnp.float32)
    kf = k.astype(jnp.float32) * (D ** -0.5)
    vf = v.astype(jnp.float32)
    logf = jax.nn.log_sigmoid(f_pre.astype(jnp.float32))
    ig = i_pre.astype(jnp.float32)

    def to_chunks(a):
        a = a.reshape((B, nC, L, H) + a.shape[3:])
        return jnp.moveaxis(a, (1, 3), (0, 2))

    causal = jnp.tril(jnp.ones((L, L), dtype=bool))

    def step(carry, xs):
        C, n, m = carry
        qc, kc, vc, ic, fc = xs
        b = jnp.cumsum(fc, axis=-1)
        dmat = b[..., :, None] - b[..., None, :] + ic[..., None, :]
        dmat = jnp.where(causal, dmat, -jnp.inf)
        inter = b + m[..., None]
        m_t = jnp.maximum(inter, jnp.max(dmat, axis=-1))
        w_intra = jnp.exp(dmat - m_t[..., None])
        sc = jnp.einsum('bhtd,bhsd->bhts', qc, kc) * w_intra
        a_inter = jnp.exp(inter - m_t)
        num = (a_inter[..., None] * jnp.einsum('bhvk,bhtk->bhtv', C, qc)
               + jnp.einsum('bhts,bhsv->bhtv', sc, vc))
        den = a_inter * jnp.einsum('bhk,bhtk->bht', n, qc) + jnp.sum(sc, axis=-1)
        h = num / jnp.maximum(jnp.abs(den), jnp.exp(-m_t))[..., None]
        b_last = b[..., -1]
        g = b_last[..., None] - b + ic
        m_new = jnp.maximum(b_last + m, jnp.max(g, axis=-1))
        w_state = jnp.exp(g - m_new[..., None])
        decay = jnp.exp(b_last + m - m_new)
        C_new = decay[..., None, None] * C + jnp.einsum('bhs,bhsv,bhsk->bhvk', w_state, vc, kc)
        n_new = decay[..., None] * n + jnp.einsum('bhs,bhsk->bhk', w_state, kc)
        return (C_new, n_new, m_new), h

    init = (jnp.zeros((B, H, D, D), jnp.float32),
            jnp.zeros((B, H, D), jnp.float32),
            jnp.zeros((B, H), jnp.float32))
    xs = (to_chunks(qf), to_chunks(kf), to_chunks(vf), to_chunks(ig), to_chunks(logf))
    _, h = lax.scan(step, init, xs)
    return jnp.moveaxis(h, (0, 2), (1, 3)).reshape(B, S, H, D)


def sliding_window_gqa(q, k, v, sinks):
    B, S, Hq, D = q.shape
    Hkv = k.shape[2]
    G = Hq // Hkv
    W = WINDOW
    nB = S // W
    qb = q.reshape(B, nB, W, Hkv, G, D)

    def band(a):
        ab = a.reshape(B, nB, W, Hkv, D)
        prev = jnp.pad(ab, ((0, 0), (1, 0), (0, 0), (0, 0), (0, 0)))[:, :-1]
        return jnp.concatenate([prev, ab], axis=2)

    kb, vb = band(k), band(v)
    s = jnp.einsum('bnqhgd,bnkhd->bnhgqk', qb, kb).astype(jnp.float32) * (D ** -0.5)
    qpos = jnp.arange(W)[:, None] + W
    kpos = jnp.arange(2 * W)[None, :]
    rel = qpos - kpos
    valid = (rel >= 0) & (rel < W)
    valid = valid[None] & ((jnp.arange(nB)[:, None, None] > 0) | (kpos[None] >= W))
    s = jnp.where(valid[None, :, None, None], s, -jnp.inf)
    sink = sinks.astype(jnp.float32).reshape(Hkv, G)[None, None, :, :, None]
    mx = jnp.maximum(jnp.max(s, axis=-1), sink)
    e = jnp.exp(s - mx[..., None])
    denom = jnp.sum(e, axis=-1) + jnp.exp(sink - mx)
    p = e / denom[..., None]
    o = jnp.einsum('bnhgqk,bnkhd->bnqhgd', p.astype(v.dtype), vb)
    return o.reshape(B, S, Hq, D)


def differential_attention(q, k, v, lam):
    B, S, H, _, Dk = q.shape
    nQ = S // Q_BLOCK
    qb = jnp.moveaxis(q.reshape(B, nQ, Q_BLOCK, H, 2, Dk), 1, 0)
    kpos = jnp.arange(S)

    def block(args):
        qblk, i = args
        s = jnp.einsum('bqhmd,bkhmd->bhmqk', qblk, k).astype(jnp.float32) * (Dk ** -0.5)
        qpos = i * Q_BLOCK + jnp.arange(Q_BLOCK)
        s = jnp.where(kpos[None, :] <= qpos[:, None], s, -jnp.inf)
        p = jax.nn.softmax(s, axis=-1)
        a = p[:, :, 0] - lam * p[:, :, 1]
        return jnp.einsum('bhqk,bkhd->bqhd', a.astype(v.dtype), v)

    o = lax.map(block, (qb, jnp.arange(nQ)))
    return jnp.moveaxis(o, 0, 1).reshape(B, S, H, v.shape[-1])


def hybrid_layer(x, layer_idx, w_in, conv_w, conv_b, i_bias, f_bias, m_norm_g, sinks,
                 lam_q1, lam_k1, lam_q2, lam_k2, sub_g, w_out, w_up, w_down,
                 g_pre_mix, g_post_mix, g_pre_mlp, g_post_mlp):
    B, S, _ = x.shape
    pos = jnp.arange(S)
    h = rms_norm(x, g_pre_mix)
    z = h @ w_in
    mq, mk, mv, mo, mi, mf, sq, sk, sv, dq, dk, dv = split_columns(z)

    qk = jax.nn.silu(causal_conv(jnp.concatenate([mq, mk], axis=-1), conv_w, conv_b))
    m_q = qk[..., :M_WIDTH].reshape(B, S, M_HEADS, M_DIM)
    m_k = qk[..., M_WIDTH:].reshape(B, S, M_HEADS, M_DIM)
    m_v = mv.reshape(B, S, M_HEADS, M_DIM)
    h_m = mlstm_chunkwise(m_q, m_k, m_v, mi + i_bias, mf + f_bias)
    h_m = rms_norm(h_m, m_norm_g.reshape(M_HEADS, M_DIM)).reshape(B, S, M_WIDTH)
    out_m = (jax.nn.sigmoid(mo.astype(jnp.float32)) * h_m).astype(x.dtype)

    s_q = rope(sq.reshape(B, S, S_HEADS, HEAD_DIM), pos)
    s_k = rope(sk.reshape(B, S, S_KV_HEADS, HEAD_DIM), pos)
    s_v = sv.reshape(B, S, S_KV_HEADS, HEAD_DIM)
    out_s = sliding_window_gqa(s_q, s_k, s_v, sinks).reshape(B, S, S_WIDTH)

    d_q = rope(dq.reshape(B, S, D_HEADS * 2, D_QK), pos).reshape(B, S, D_HEADS, 2, D_QK)
    d_k = rope(dk.reshape(B, S, D_HEADS * 2, D_QK), pos).reshape(B, S, D_HEADS, 2, D_QK)
    d_v = dv.reshape(B, S, D_HEADS, D_V)
    lam_init = 0.8 - 0.6 * math.exp(-0.3 * layer_idx)
    lam = (jnp.exp(jnp.sum(lam_q1.astype(jnp.float32) * lam_k1.astype(jnp.float32)))
           - jnp.exp(jnp.sum(lam_q2.astype(jnp.float32) * lam_k2.astype(jnp.float32)))
           + lam_init)
    o_d = differential_attention(d_q, d_k, d_v, lam)
    out_d = (rms_norm(o_d, sub_g) * (1.0 - lam_init)).reshape(B, S, D_WIDTH).astype(x.dtype)

    mix = jnp.concatenate([out_m, out_s.astype(x.dtype), out_d], axis=-1) @ w_out
    x = x + rms_norm(mix, g_post_mix)

    h2 = rms_norm(x, g_pre_mlp)
    u = jnp.square(jax.nn.relu(h2 @ w_up))
    x = x + rms_norm(u @ w_down, g_post_mlp)
    return x


def setup_inputs(seed: int = 0) -> dict:
    key = jax.random.key(seed)
    ks = jax.random.split(key, 21)
    f32 = jnp.float32

    def nrm(k, shape, scale):
        return jax.random.normal(k, shape, f32) * scale

    def gain(k, shape):
        return 1.0 + 0.02 * jax.random.normal(k, shape, f32)

    return {
        'x': jax.random.normal(ks[0], (BATCH, SEQ, D_MODEL), f32),
        'w_in': nrm(ks[1], (DEPTH, D_MODEL, IN_WIDTH), D_MODEL ** -0.5),
        'conv_w': nrm(ks[2], (DEPTH, CONV_WIDTH, 2 * M_WIDTH), CONV_WIDTH ** -0.5),
        'conv_b': nrm(ks[3], (DEPTH, 2 * M_WIDTH), 0.01),
        'i_bias': nrm(ks[4], (DEPTH, M_HEADS), 0.1),
        'f_bias': 3.0 + nrm(ks[5], (DEPTH, M_HEADS), 0.5),
        'm_norm_g': gain(ks[6], (DEPTH, M_WIDTH)),
        'sinks': nrm(ks[7], (DEPTH, S_HEADS), 0.5),
        'lam_q1': nrm(ks[8], (DEPTH, D_QK), 0.1),
        'lam_k1': nrm(ks[9], (DEPTH, D_QK), 0.1),
        'lam_q2': nrm(ks[10], (DEPTH, D_QK), 0.1),
        'lam_k2': nrm(ks[11], (DEPTH, D_QK), 0.1),
        'sub_g': gain(ks[12], (DEPTH, D_V)),
        'w_out': nrm(ks[13], (DEPTH, MIX_WIDTH, D_MODEL), MIX_WIDTH ** -0.5),
        'w_up': nrm(ks[14], (DEPTH, D_MODEL, D_FF), D_MODEL ** -0.5),
        'w_down': nrm(ks[15], (DEPTH, D_FF, D_MODEL), D_FF ** -0.5),
        'g_pre_mix': gain(ks[16], (DEPTH, D_MODEL)),
        'g_post_mix': gain(ks[17], (DEPTH, D_MODEL)),
        'g_pre_mlp': gain(ks[18], (DEPTH, D_MODEL)),
        'g_post_mlp': gain(ks[19], (DEPTH, D_MODEL)),
    }


def reference(x, w_in, conv_w, conv_b, i_bias, f_bias, m_norm_g, sinks,
              lam_q1, lam_k1, lam_q2, lam_k2, sub_g, w_out, w_up, w_down,
              g_pre_mix, g_post_mix, g_pre_mlp, g_post_mlp):
    for l in range(DEPTH):
        x = hybrid_layer(x, l, w_in[l], conv_w[l], conv_b[l], i_bias[l], f_bias[l],
                         m_norm_g[l], sinks[l], lam_q1[l], lam_k1[l], lam_q2[l], lam_k2[l],
                         sub_g[l], w_out[l], w_up[l], w_down[l],
                         g_pre_mix[l], g_post_mix[l], g_pre_mlp[l], g_post_mlp[l])
    return x
```

```cpp
#include <hip/hip_runtime.h>
#include <hip/hip_cooperative_groups.h>
#include <cstdio>
#include <cstdint>
namespace cg = cooperative_groups;

#ifndef PH_MASK
#define PH_MASK 0x3ff
#endif
#ifndef ONE_LAUNCH
#define ONE_LAUNCH 0
#endif

#define LAS __attribute__((address_space(3)))
typedef unsigned short bf16_t;
typedef short bf16x8 __attribute__((ext_vector_type(8)));
typedef short s16x4 __attribute__((ext_vector_type(4)));
typedef float f32x4 __attribute__((ext_vector_type(4)));
typedef float f32x2 __attribute__((ext_vector_type(2)));
typedef float f32x16 __attribute__((ext_vector_type(16)));
typedef unsigned u32x4 __attribute__((ext_vector_type(4)));
typedef unsigned u32x2 __attribute__((ext_vector_type(2)));
typedef __bf16 bf16x2_t __attribute__((ext_vector_type(2)));
typedef LAS unsigned char* lds_t;

constexpr int BATCH = 8, SEQ = 8192, DM = 1024, FF = 4096, NTOK = BATCH * SEQ;
constexpr int INW = 2568, ZP = 2816;
constexpr int ZC_MQ = 0, ZC_MK = 256, ZC_MV = 512, ZC_MO = 768, ZC_SQ = 1024, ZC_SK = 1536, ZC_SV = 1664, ZC_DQ = 1792, ZC_DK = 2048, ZC_DV = 2304, ZC_G = 2560;
constexpr float EPS = 1e-6f;
constexpr int NWAVES = 8, NTHREADS = 512;

constexpr size_t MiB = 1u << 20;
constexpr size_t WS_W = 2 * MiB;
constexpr size_t W_LAYER = 24 * MiB, W_IN = 0, W_OUT = 6 * MiB, W_UP = 8 * MiB, W_DOWN = 16 * MiB;
constexpr size_t WS_ROPE = 50 * MiB;
constexpr size_t WS_RS = 52 * MiB;
constexpr size_t WS_XB = 54 * MiB;
constexpr size_t WS_MIX = 182 * MiB;
constexpr size_t WS_U = 310 * MiB;
constexpr size_t WS_ZB = 310 * MiB;
constexpr size_t WS_CAT = 662 * MiB;
constexpr size_t WS_DC = 822 * MiB;
constexpr size_t WS_DN = 854 * MiB;
constexpr size_t WS_DEC = 855 * MiB;
constexpr size_t WS_CS = 856 * MiB;
constexpr size_t WS_NS = 872 * MiB;
constexpr size_t WS_END = 874 * MiB;

constexpr int LDS_BYTES = 147456;

struct Params {
    const float* in[20];
    float* out;
    unsigned char* ws;
    int ph_lo, ph_hi;
};

__device__ __forceinline__ unsigned pk2(float lo, float hi) { f32x2 v = {lo, hi}; bf16x2_t b = __builtin_convertvector(v, bf16x2_t); return __builtin_bit_cast(unsigned, b); }
__device__ __forceinline__ bf16_t f2bf(float f) { return (bf16_t)(pk2(f, 0.f) & 0xffffu); }
__device__ __forceinline__ float bf2f(unsigned u16) { return __uint_as_float(u16 << 16); }
__device__ __forceinline__ float bflo(unsigned w) { return __uint_as_float(w << 16); }
__device__ __forceinline__ float bfhi(unsigned w) { return __uint_as_float(w & 0xffff0000u); }
__device__ __forceinline__ int crow(int i, int h) { return (i & 3) + 8 * (i >> 2) + 4 * h; }
__device__ __forceinline__ float wave_sum(float v) {
#pragma unroll
    for (int o = 1; o < 64; o <<= 1) v += __shfl_xor(v, o);
    return v;
}
__device__ __forceinline__ float swap_add(float v) { auto rr = __builtin_amdgcn_permlane32_swap(__float_as_uint(v), __float_as_uint(v), false, false); return __uint_as_float(rr[0]) + __uint_as_float(rr[1]); }
__device__ __forceinline__ float swap_max(float v) { auto rr = __builtin_amdgcn_permlane32_swap(__float_as_uint(v), __float_as_uint(v), false, false); return fmaxf(__uint_as_float(rr[0]), __uint_as_float(rr[1])); }
#define MFMA32(a, b, c) __builtin_amdgcn_mfma_f32_32x32x16_bf16((a), (b), (c), 0, 0, 0)
__device__ __forceinline__ bf16x8 pack8(const f32x16& x, int s) {
    u32x4 p; p.x = pk2(x[8 * s], x[8 * s + 1]); p.y = pk2(x[8 * s + 2], x[8 * s + 3]); p.z = pk2(x[8 * s + 4], x[8 * s + 5]); p.w = pk2(x[8 * s + 6], x[8 * s + 7]);
    return __builtin_bit_cast(bf16x8, p);
}
__device__ __forceinline__ bf16x8 lds16(lds_t p) { return *(const LAS bf16x8*)p; }
__device__ __forceinline__ bf16x8 lds8x2(lds_t p0, lds_t p1) { s16x4 a = *(const LAS s16x4*)p0, b = *(const LAS s16x4*)p1; return __builtin_shufflevector(a, b, 0, 1, 2, 3, 4, 5, 6, 7); }
__device__ __forceinline__ float sigmoidf_(float x) { return 1.f / (1.f + __expf(-x)); }
__device__ __forceinline__ float logsigmoidf_(float x) { return fminf(x, 0.f) - log1pf(__expf(-fabsf(x))); }

__device__ __forceinline__ int otid() { int t = threadIdx.x; asm volatile("" : "+v"(t)); return t; }
template <class T> __device__ __forceinline__ T* optr(T* p) { asm volatile("" : "+s"(p)); return p; }
namespace pg8 {
constexpr int BM = 256, BK = 64, HALF = 128, HTB = HALF * BK * 2, STAGE_BYTES = 8 * HTB, NXCD = 8, WGM = 8;
__host__ __device__ __forceinline__ int lds_byte(int r, int c) { const int st = (r >> 4) * 2 + (c >> 5), rr = r & 15, cc = c & 31, ob = rr * 64 + cc * 2; return st * 1024 + (ob ^ (((ob >> 9) & 1) << 5)); }
__host__ __device__ __forceinline__ void stage_rc(int b, int& R, int& C) { const int st = b / 1024, sb = b % 1024, swz = sb ^ (((sb >> 9) & 1) << 5); R = (st >> 1) * 16 + swz / 64; C = (st & 1) * 32 + (swz % 64) / 2; }
__host__ __device__ __forceinline__ int perm32(int rho) { const int n = rho >> 4, i = rho & 15; return 8 * (i >> 2) + 4 * n + (i & 3); }
struct Unit { int pm, pn; };
struct Gemm { const bf16_t* A; const bf16_t* Bt; int M, N, K; };
struct StaticOrder {
    int nM, nN, nwg, G, c;
    __host__ __device__ void init(int M, int N, int G_, int c_) { nM = M / BM; nN = N / BM; nwg = nM * nN; G = G_; c = c_; }
    __host__ __device__ bool next(int i, Unit& u) const {
        const long L = (long)i * G + c; if (L >= nwg) return false;
        int wgid = (int)L; { const int q = nwg / NXCD, r = nwg % NXCD, xcd = wgid % NXCD, off = wgid / NXCD; wgid = (xcd < r ? xcd * (q + 1) : r * (q + 1) + (xcd - r) * q) + off; }
        const int nig = WGM * nN, gid = wgid / nig, fm = gid * WGM, gsz = (nM - fm) < WGM ? (nM - fm) : WGM;
        u.pm = fm + ((wgid % nig) % gsz); u.pn = (wgid % nig) / gsz; return true;
    }
    __device__ __forceinline__ void a_ready(const Unit&) const {}
    __device__ __forceinline__ void done(const Unit&) const {}
};

template <int ACT> struct EpiRow {
    static constexpr bool PERM = true, AFTER_DRAIN = false;
    bf16_t* O; int ldc; const float* rs;
    __device__ __forceinline__ void operator()(const f32x4 (&acc)[2][2][4][2], const Unit& u, int wr, int wc, int fr, int fq) const {
        const int row0 = u.pm * BM + wr * 64 + fr, col0 = u.pn * BM + wc * 32 + 8 * fq;
#pragma unroll
        for (int ai = 0; ai < 2; ++ai)
#pragma unroll
            for (int m = 0; m < 4; ++m) { const int row = row0 + ai * HALF + m * 16; const float s = rs ? rs[row] : 1.f; bf16_t* rowp = O + (size_t)row * ldc + col0;
#pragma unroll
                for (int bj = 0; bj < 2; ++bj) { f32x4 v0 = acc[ai][bj][m][0] * s, v1 = acc[ai][bj][m][1] * s;
                    if (ACT == 1) {
#pragma unroll
                        for (int i = 0; i < 4; ++i) { const float a = fmaxf(v0[i], 0.f), b = fmaxf(v1[i], 0.f); v0[i] = a * a; v1[i] = b * b; } }
                    u32x4 w; w.x = pk2(v0[0], v0[1]); w.y = pk2(v0[2], v0[3]); w.z = pk2(v1[0], v1[1]); w.w = pk2(v1[2], v1[3]);
                    *(u32x4*)(rowp + bj * HALF) = w; } }
    }
};
struct EpiInProj {
    static constexpr bool PERM = true, AFTER_DRAIN = false;
    bf16_t* O; const float* rs; const f32x2* rope;
    __device__ __forceinline__ void operator()(const f32x4 (&acc)[2][2][4][2], const Unit& u, int wr, int wc, int fr, int fq) const {
        const int row0 = u.pm * BM + wr * 64 + fr, col0 = u.pn * BM + wc * 32 + 8 * fq;
        const int pn = u.pn;
        const int j64 = 4 * (wc & 1) + fq;
#pragma unroll
        for (int ai = 0; ai < 2; ++ai)
#pragma unroll
            for (int m = 0; m < 4; ++m) { const int row = row0 + ai * HALF + m * 16; const float s = rs[row]; bf16_t* rowp = O + (size_t)row * ZP + col0;
                const f32x2* tb = rope + (size_t)(row & (SEQ - 1)) * 32;
#pragma unroll
                for (int bj = 0; bj < 2; ++bj) { f32x4 v0 = acc[ai][bj][m][0] * s, v1 = acc[ai][bj][m][1] * s;
                    const bool r64 = (pn == 4) || (pn == 5) || (pn == 6 && bj == 0), r32 = (pn == 7) || (pn == 8);
                    if (r64 || r32) {
                        f32x2 cs[4];
                        if (r64) { const f32x4 t0 = *(const f32x4*)(tb + 4 * j64), t1 = *(const f32x4*)(tb + 4 * j64 + 2); cs[0] = (f32x2){t0[0], t0[1]}; cs[1] = (f32x2){t0[2], t0[3]}; cs[2] = (f32x2){t1[0], t1[1]}; cs[3] = (f32x2){t1[2], t1[3]}; }
                        else {
#pragma unroll
                            for (int i = 0; i < 4; ++i) cs[i] = tb[8 * fq + 2 * i]; }
#pragma unroll
                        for (int i = 0; i < 4; ++i) { const float a = v0[i], b = v1[i]; v0[i] = a * cs[i].x - b * cs[i].y; v1[i] = b * cs[i].x + a * cs[i].y; }
                    }
                    u32x4 w; w.x = pk2(v0[0], v0[1]); w.y = pk2(v0[2], v0[3]); w.z = pk2(v1[0], v1[1]); w.w = pk2(v1[2], v1[3]);
                    *(u32x4*)(rowp + bj * HALF) = w; } }
    }
};

template <class Epi, class Sched, bool ALIGN_EPI = false, bool SP2 = false>
__device__ __forceinline__ void gemm_phase(lds_t lds, const Gemm g, const Sched& S, const Epi& E) {
    const int tid = otid(), wid = __builtin_amdgcn_readfirstlane(tid >> 6), lane = tid & 63, wr = wid >> 2, wc = wid & 3, fr = lane & 15, fq = lane >> 4;
    const int K = g.K, nt = K / BK;
    unsigned voffA[2], voffB[2];
#pragma unroll
    for (int i = 0; i < 2; ++i) { int R, C; stage_rc(tid * 16 + i * 8192, R, C); const int Rb = Epi::PERM ? ((R & ~31) + perm32(R & 31)) : R;
        voffA[i] = (unsigned)(R * K + C) * 2u; voffB[i] = (unsigned)(Rb * K + C) * 2u; }
    const size_t kstep = (size_t)(BK * 2);
    const size_t hstep = (size_t)HALF * K * 2;
    const size_t tstep = 2 * hstep;
    const unsigned ldsw = (unsigned)wid * 1024u;
    const int aoff = lds_byte(wr * 64 + fr, fq * 8), boff = lds_byte(wc * 32 + fr, fq * 8);
#define PG8_SA(b, h) (((b) * 2 + (h)) * HTB)
#define PG8_SB(b, h) ((4 + (b) * 2 + (h)) * HTB)
#define PG8_STAGE(bufoff, gbase, voff) do { _Pragma("unroll") for (int _i = 0; _i < 2; ++_i) \
        __builtin_amdgcn_global_load_lds((const unsigned*)((const char*)(gbase) + (voff)[_i]), (LAS unsigned*)(lds + (bufoff) + ldsw + _i * 8192), 16, 0, 0); } while (0)
#define PG8_LDA(dst, b, h) do { _Pragma("unroll") for (int m = 0; m < 4; ++m) _Pragma("unroll") for (int k = 0; k < 2; ++k) dst[m][k] = *(const LAS bf16x8*)(lds + PG8_SA(b, h) + aoff + m * 2048 + k * 1024); } while (0)
#define PG8_LDB(dst, b, h) do { _Pragma("unroll") for (int n = 0; n < 2; ++n) _Pragma("unroll") for (int k = 0; k < 2; ++k) dst[n][k] = *(const LAS bf16x8*)(lds + PG8_SB(b, h) + boff + n * 2048 + k * 1024); } while (0)
#define PG8_MMA(ai, bj, At, Bt) do { __builtin_amdgcn_s_setprio(1); _Pragma("unroll") for (int m = 0; m < 4; ++m) _Pragma("unroll") for (int n = 0; n < 2; ++n) _Pragma("unroll") for (int k = 0; k < 2; ++k) \
        acc[ai][bj][m][n] = __builtin_amdgcn_mfma_f32_16x16x32_bf16(Bt[n][k], At[m][k], acc[ai][bj][m][n], 0, 0, 0); __builtin_amdgcn_s_setprio(0); } while (0)
#define PG8_WAIT_V(n) asm volatile("s_waitcnt vmcnt(" #n ")" ::: "memory")
#define PG8_WAIT_L(n) asm volatile("s_waitcnt lgkmcnt(" #n ")" ::: "memory")
#define PG8_BAR __builtin_amdgcn_s_barrier()
#define PG8_SCHED __builtin_amdgcn_sched_barrier(0)
    Unit cur, nxt; int ui = 0;
    if (!S.next(0, cur)) return;
    f32x4 acc[2][2][4][2];
#pragma unroll
    for (int a = 0; a < 2; ++a)
#pragma unroll
        for (int b = 0; b < 2; ++b)
#pragma unroll
            for (int m = 0; m < 4; ++m)
#pragma unroll
                for (int n = 0; n < 2; ++n) acc[a][b][m][n] = (f32x4){0.f, 0.f, 0.f, 0.f};
    bf16x8 At[4][2], B0[2][2], B1[2][2];
    const char* cA = (const char*)g.A + (size_t)cur.pm * tstep; const char* cB = (const char*)g.Bt + (size_t)cur.pn * tstep;
    S.a_ready(cur);
    if constexpr (SP2) {
        PG8_STAGE(PG8_SB(0, 0), cB, voffB); PG8_STAGE(PG8_SB(0, 1), cB + hstep, voffB); PG8_STAGE(PG8_SA(0, 0), cA, voffA); PG8_STAGE(PG8_SA(0, 1), cA + hstep, voffA);
        if (wr == 1) PG8_BAR;
        PG8_WAIT_V(2); PG8_BAR;
        PG8_STAGE(PG8_SB(1, 0), cB + kstep, voffB); PG8_STAGE(PG8_SA(1, 0), cA + kstep, voffA); PG8_STAGE(PG8_SB(1, 1), cB + hstep + kstep, voffB);
        PG8_WAIT_V(6); PG8_BAR;
    } else {
        PG8_STAGE(PG8_SB(0, 0), cB, voffB); PG8_STAGE(PG8_SA(0, 0), cA, voffA); PG8_STAGE(PG8_SB(0, 1), cB + hstep, voffB); PG8_STAGE(PG8_SA(0, 1), cA + hstep, voffA);
        if (wr == 1) PG8_BAR;
        PG8_WAIT_V(4); PG8_BAR;
        PG8_STAGE(PG8_SB(1, 0), cB + kstep, voffB); PG8_STAGE(PG8_SA(1, 0), cA + kstep, voffA); PG8_STAGE(PG8_SB(1, 1), cB + hstep + kstep, voffB);
        PG8_WAIT_V(6); PG8_BAR;
    }
    for (;;) {
        const bool has_next = S.next(ui + 1, nxt);
        const char* nA = has_next ? (const char*)g.A + (size_t)nxt.pm * tstep : cA; const char* nB = has_next ? (const char*)g.Bt + (size_t)nxt.pn * tstep : cB;
        for (int t = 0; t < nt; t += 2) {
            const bool last = (t == nt - 2);
            const char* a1 = cA + (size_t)(t + 1) * kstep;
            const char* a2 = last ? nA : cA + (size_t)(t + 2) * kstep; const char* b2 = last ? nB : cB + (size_t)(t + 2) * kstep;
            const char* a3 = a2 + kstep; const char* b3 = b2 + kstep;
            if (last && has_next) S.a_ready(nxt);
            if constexpr (SP2) {
            PG8_LDB(B0, 0, 0); PG8_LDB(B1, 0, 1); PG8_SCHED; PG8_LDA(At, 0, 0); PG8_STAGE(PG8_SA(1, 1), a1 + hstep, voffA);
            PG8_WAIT_V(8); PG8_WAIT_L(0); PG8_BAR; PG8_MMA(0, 0, At, B0); PG8_MMA(0, 1, At, B1); PG8_BAR; PG8_SCHED;
            PG8_LDA(At, 0, 1); PG8_STAGE(PG8_SB(0, 0), b2, voffB); PG8_STAGE(PG8_SB(0, 1), b2 + hstep, voffB); PG8_STAGE(PG8_SA(0, 0), a2, voffA);
            PG8_WAIT_V(8); PG8_WAIT_L(0); PG8_BAR; PG8_MMA(1, 0, At, B0); PG8_MMA(1, 1, At, B1); PG8_BAR; PG8_SCHED;
            PG8_LDB(B0, 1, 0); PG8_LDB(B1, 1, 1); PG8_SCHED; PG8_LDA(At, 1, 0); PG8_STAGE(PG8_SA(0, 1), a2 + hstep, voffA);
            PG8_WAIT_V(8); PG8_WAIT_L(0); PG8_BAR; PG8_MMA(0, 0, At, B0); PG8_MMA(0, 1, At, B1); PG8_BAR; PG8_SCHED;
            PG8_LDA(At, 1, 1); PG8_STAGE(PG8_SB(1, 0), b3, voffB); PG8_STAGE(PG8_SB(1, 1), b3 + hstep, voffB); PG8_STAGE(PG8_SA(1, 0), a3, voffA);
            PG8_WAIT_V(8); PG8_WAIT_L(0); PG8_BAR; PG8_MMA(1, 0, At, B0); PG8_MMA(1, 1, At, B1); PG8_BAR; PG8_SCHED;
            } else {
            PG8_LDB(B0, 0, 0); PG8_SCHED; PG8_LDA(At, 0, 0); PG8_STAGE(PG8_SA(1, 1), a1 + hstep, voffA);
            PG8_WAIT_L(8); PG8_BAR; PG8_WAIT_L(0); PG8_MMA(0, 0, At, B0); PG8_BAR; PG8_SCHED;
            PG8_LDB(B1, 0, 1); PG8_STAGE(PG8_SB(0, 0), b2, voffB);
            PG8_BAR; PG8_WAIT_L(0); PG8_MMA(0, 1, At, B1); PG8_BAR;
            PG8_LDA(At, 0, 1); PG8_STAGE(PG8_SA(0, 0), a2, voffA);
            PG8_BAR; PG8_WAIT_L(0); PG8_MMA(1, 0, At, B0); PG8_BAR; PG8_SCHED;
            PG8_STAGE(PG8_SB(0, 1), b2 + hstep, voffB);
            PG8_WAIT_V(6); PG8_BAR; PG8_MMA(1, 1, At, B1); PG8_BAR;
            PG8_LDB(B0, 1, 0); PG8_SCHED; PG8_LDA(At, 1, 0); PG8_STAGE(PG8_SA(0, 1), a2 + hstep, voffA);
            PG8_WAIT_L(8); PG8_BAR; PG8_WAIT_L(0); PG8_MMA(0, 0, At, B0); PG8_BAR; PG8_SCHED;
            PG8_LDB(B1, 1, 1); PG8_STAGE(PG8_SB(1, 0), b3, voffB);
            PG8_BAR; PG8_WAIT_L(0); PG8_MMA(0, 1, At, B1); PG8_BAR;
            PG8_LDA(At, 1, 1); PG8_STAGE(PG8_SA(1, 0), a3, voffA);
            PG8_BAR; PG8_WAIT_L(0); PG8_MMA(1, 0, At, B0); PG8_BAR; PG8_SCHED;
            PG8_STAGE(PG8_SB(1, 1), b3 + hstep, voffB);
            PG8_WAIT_V(6); PG8_BAR; PG8_MMA(1, 1, At, B1); PG8_BAR;
            }
        }
        if constexpr (ALIGN_EPI) { if (wr == 0) PG8_BAR; }
        E(acc, cur, wr, wc, fr, fq); S.done(cur);
        if (!has_next) break;
#pragma unroll
        for (int a = 0; a < 2; ++a)
#pragma unroll
            for (int b = 0; b < 2; ++b)
#pragma unroll
                for (int m = 0; m < 4; ++m)
#pragma unroll
                    for (int n = 0; n < 2; ++n) acc[a][b][m][n] = (f32x4){0.f, 0.f, 0.f, 0.f};
        cur = nxt; cA = nA; cB = nB; ++ui;
        if constexpr (ALIGN_EPI) { if (wr == 1) PG8_BAR; }
    }
    PG8_WAIT_V(0);
    if constexpr (!ALIGN_EPI) { if (wr == 0) PG8_BAR; }
    PG8_BAR;
#undef PG8_SA
#undef PG8_SB
#undef PG8_STAGE
#undef PG8_LDA
#undef PG8_LDB
#undef PG8_MMA
#undef PG8_WAIT_V
#undef PG8_WAIT_L
#undef PG8_BAR
#undef PG8_SCHED
}
}

__device__ __forceinline__ int zsrc(int c) {
    if (c < 1024) return c;
    if (c < ZC_SK) { const int x = c - ZC_SQ, hh = x >> 6, p = x & 63, j = p >> 3, i = p & 7; return 1032 + hh * 64 + (i < 4 ? 4 * j + i : 32 + 4 * j + (i - 4)); }
    if (c < ZC_SV) { const int x = c - ZC_SK, hh = x >> 6, p = x & 63, j = p >> 3, i = p & 7; return 1544 + hh * 64 + (i < 4 ? 4 * j + i : 32 + 4 * j + (i - 4)); }
    if (c < ZC_DQ) return 1672 + (c - ZC_SV);
    if (c < ZC_DK) { const int x = c - ZC_DQ, hh = x >> 5, p = x & 31, j = p >> 3, i = p & 7; return 1800 + hh * 32 + (i < 4 ? 4 * j + i : 16 + 4 * j + (i - 4)); }
    if (c < ZC_DV) { const int x = c - ZC_DK, hh = x >> 5, p = x & 31, j = p >> 3, i = p & 7; return 2056 + hh * 32 + (i < 4 ? 4 * j + i : 16 + 4 * j + (i - 4)); }
    if (c < ZC_G) return 2312 + (c - ZC_DV);
    if (c < ZC_G + 8) return 1024 + (c - ZC_G);
    return -1;
}
template <bool MAPZ> __device__ __forceinline__ void transpose_item(const float* W, int K, int N, int Nst, const float* gk, bf16_t* WT, LAS float* scr, int item, int lane) {
    const int nblk = Nst / 32, kb = item / nblk, nb = item % nblk, k0 = 64 * kb, n0 = 32 * nb;
    const int nsrc = MAPZ ? zsrc(n0 + (lane & 31)) : (n0 + (lane & 31));
#pragma unroll 8
    for (int i = 0; i < 32; ++i) { const int kk = 2 * i + (lane >> 5); float v = 0.f; if (nsrc >= 0) v = W[(size_t)(k0 + kk) * N + nsrc]; if (gk) v *= gk[k0 + kk]; scr[kk * 33 + (lane & 31)] = v; }
    asm volatile("s_waitcnt lgkmcnt(0)" ::: "memory");
    const int c = lane & 7;
#pragma unroll
    for (int j = 0; j < 4; ++j) { const int n = (lane >> 3) + 8 * j; const LAS float* s = scr + (8 * c) * 33 + n;
        u32x4 o; o.x = pk2(s[0 * 33], s[1 * 33]); o.y = pk2(s[2 * 33], s[3 * 33]); o.z = pk2(s[4 * 33], s[5 * 33]); o.w = pk2(s[6 * 33], s[7 * 33]);
        *(u32x4*)(WT + (size_t)(n0 + n) * K + k0 + 8 * c) = o; }
    asm volatile("s_waitcnt lgkmcnt(0)" ::: "memory");
}
__device__ __forceinline__ void sincos_red(double x, float& c, float& s) {
    const double k = rint(x * 0.15915494309189535), r = x - k * 6.283185307179586, r2 = r * r;
    double sn = 1.0, cs = 1.0;
#pragma unroll
    for (int n = 14; n >= 1; --n) { sn = 1.0 - r2 * (1.0 / (double)((2 * n) * (2 * n + 1))) * sn; cs = 1.0 - r2 * (1.0 / (double)((2 * n - 1) * (2 * n))) * cs; }
    s = (float)(r * sn); c = (float)cs;
}
__device__ __forceinline__ void row_to_bf16(const float* xrow, bf16_t* orow, float* rs, int lane) {
    const f32x4* xr = (const f32x4*)xrow + lane;
    f32x4 v[4]; float s = 0.f;
#pragma unroll
    for (int j = 0; j < 4; ++j) { v[j] = xr[64 * j]; s += (v[j].x * v[j].x + v[j].y * v[j].y) + (v[j].z * v[j].z + v[j].w * v[j].w); }
    s = wave_sum(s);
    u32x2* o8 = (u32x2*)orow + lane;
#pragma unroll
    for (int j = 0; j < 4; ++j) o8[64 * j] = (u32x2){pk2(v[j].x, v[j].y), pk2(v[j].z, v[j].w)};
    if (lane == 0) *rs = 1.f / sqrtf(s * (1.f / DM) + EPS);
}
__device__ __forceinline__ void prologue(const Params& P, lds_t lds, int G) {
    const int tid = otid(), lane = tid & 63, wave = tid >> 6; unsigned char* const ws_ = optr(P.ws);
    LAS float* scr = (LAS float*)(lds + wave * 16384);
    const int gw = blockIdx.x * NWAVES + wave, NGW = G * NWAVES;
    constexpr int I_IN = (DM / 64) * (ZP / 32), I_OUT = (DM / 64) * (DM / 32), I_UP = (DM / 64) * (FF / 32), I_DN = (FF / 64) * (DM / 32), I_L = I_IN + I_OUT + I_UP + I_DN;
    for (int it = gw; it < 2 * I_L; it += NGW) {
        const int l = it / I_L; int r = it % I_L;
        unsigned char* wb = ws_ + WS_W + (size_t)l * W_LAYER;
        if (r < I_IN) { transpose_item<true>(P.in[1] + (size_t)l * DM * INW, DM, INW, ZP, P.in[16] + l * DM, (bf16_t*)(wb + W_IN), scr, r, lane); continue; } r -= I_IN;
        if (r < I_OUT) { transpose_item<false>(P.in[13] + (size_t)l * DM * DM, DM, DM, DM, nullptr, (bf16_t*)(wb + W_OUT), scr, r, lane); continue; } r -= I_OUT;
        if (r < I_UP) { transpose_item<false>(P.in[14] + (size_t)l * DM * FF, DM, FF, FF, P.in[18] + l * DM, (bf16_t*)(wb + W_UP), scr, r, lane); continue; } r -= I_UP;
        transpose_item<false>(P.in[15] + (size_t)l * FF * DM, FF, DM, DM, nullptr, (bf16_t*)(wb + W_DOWN), scr, r, lane);
    }
    f32x2* rope = (f32x2*)(ws_ + WS_ROPE);
    for (int e = blockIdx.x * NTHREADS + tid; e < SEQ * 32; e += G * NTHREADS) {
        const int pos = e >> 5, i = e & 31;
        const float inv = (float)exp(-(double)i * (9.210340371976184 / 32.0));
        const float ang = (float)pos * inv;
        float c, s; sincos_red((double)ang, c, s);
        rope[e] = (f32x2){c, s};
    }
    bf16_t* XB = (bf16_t*)(ws_ + WS_XB); float* RS = (float*)(ws_ + WS_RS);
    for (int m = gw; m < NTOK; m += NGW) row_to_bf16(P.in[0] + (size_t)m * DM, XB + (size_t)m * DM, RS + m, lane);
}

__device__ __forceinline__ void resid_pass(const Params& P, const float* base, const float* gpost, bool write_xb, int G) {
    const int tid = otid(), lane = tid & 63, wave = tid >> 6; unsigned char* const ws_ = optr(P.ws);
    const int gw = blockIdx.x * NWAVES + wave, NGW = G * NWAVES;
    const bf16_t* MIX = (const bf16_t*)(ws_ + WS_MIX); bf16_t* XB = (bf16_t*)(ws_ + WS_XB); float* RS = (float*)(ws_ + WS_RS);
    f32x4 gv[4];
#pragma unroll
    for (int j = 0; j < 4; ++j) gv[j] = ((const f32x4*)gpost)[lane + 64 * j];
    for (int m = gw; m < NTOK; m += NGW) {
        const u32x2* mr = (const u32x2*)(MIX + (size_t)m * DM) + lane;
        const f32x4* br = (const f32x4*)(base + (size_t)m * DM) + lane;
        f32x4 mv[4], bv[4]; float s = 0.f;
#pragma unroll
        for (int j = 0; j < 4; ++j) { const u32x2 w = mr[64 * j]; mv[j] = (f32x4){bflo(w.x), bfhi(w.x), bflo(w.y), bfhi(w.y)}; bv[j] = br[64 * j];
            s += (mv[j].x * mv[j].x + mv[j].y * mv[j].y) + (mv[j].z * mv[j].z + mv[j].w * mv[j].w); }
        s = wave_sum(s);
        const float r = 1.f / sqrtf(s * (1.f / DM) + EPS);
        float s2 = 0.f;
#pragma unroll
        for (int j = 0; j < 4; ++j) { bv[j] = bv[j] + mv[j] * r * gv[j]; s2 += (bv[j].x * bv[j].x + bv[j].y * bv[j].y) + (bv[j].z * bv[j].z + bv[j].w * bv[j].w); }
        f32x4* orow = (f32x4*)(P.out + (size_t)m * DM) + lane;
#pragma unroll
        for (int j = 0; j < 4; ++j) orow[64 * j] = bv[j];
        if (write_xb) {
            s2 = wave_sum(s2);
            u32x2* o8 = (u32x2*)(XB + (size_t)m * DM) + lane;
#pragma unroll
            for (int j = 0; j < 4; ++j) o8[64 * j] = (u32x2){pk2(bv[j].x, bv[j].y), pk2(bv[j].z, bv[j].w)};
            if (lane == 0) RS[m] = 1.f / sqrtf(s2 * (1.f / DM) + EPS);
        }
    }
}

__device__ __forceinline__ void mlstm_gates(const bf16_t* Z, size_t t0, int hh, float ib, float fb, LAS float* bc, LAS float* ig, int tid) {
    if (tid < 64) {
        const int lane = tid;
        const bf16_t* g0 = Z + (t0 + 2 * lane) * ZP + ZC_G; const bf16_t* g1 = g0 + ZP;
        const float i0 = bf2f(g0[hh]) + ib, i1 = bf2f(g1[hh]) + ib;
        const float l0 = logsigmoidf_(bf2f(g0[4 + hh]) + fb), l1 = logsigmoidf_(bf2f(g1[4 + hh]) + fb);
        float x = l0 + l1;
#pragma unroll
        for (int o = 1; o < 64; o <<= 1) { const float t = __shfl_up(x, o); if (lane >= o) x += t; }
        bc[2 * lane] = x - l1; bc[2 * lane + 1] = x; ig[2 * lane] = i0; ig[2 * lane + 1] = i1;
    }
}
__device__ __forceinline__ void conv8(const bf16_t* zp, int tseq, const float* cw, const float* cb, int ch, float scale, float (&y)[8]) {
    const f32x4 b0 = *(const f32x4*)(cb + ch), b1 = *(const f32x4*)(cb + ch + 4);
    y[0] = b0[0]; y[1] = b0[1]; y[2] = b0[2]; y[3] = b0[3]; y[4] = b1[0]; y[5] = b1[1]; y[6] = b1[2]; y[7] = b1[3];
#pragma unroll
    for (int j = 0; j < 4; ++j) {
        if (tseq - 3 + j >= 0) {
            const u32x4 w = *(const u32x4*)(zp - (size_t)(3 - j) * ZP);
            const f32x4 c0 = *(const f32x4*)(cw + j * 512 + ch), c1 = *(const f32x4*)(cw + j * 512 + ch + 4);
            y[0] += bflo(w.x) * c0[0]; y[1] += bfhi(w.x) * c0[1]; y[2] += bflo(w.y) * c0[2]; y[3] += bfhi(w.y) * c0[3];
            y[4] += bflo(w.z) * c1[0]; y[5] += bfhi(w.z) * c1[1]; y[6] += bflo(w.w) * c1[2]; y[7] += bfhi(w.w) * c1[3];
        }
    }
#pragma unroll
    for (int i = 0; i < 8; ++i) y[i] = y[i] * sigmoidf_(y[i]) * scale;
}
constexpr int TS128 = 264;
constexpr int RS64 = 144;
__device__ __forceinline__ void mlstm_a_item(const Params& P, int l, int item, lds_t lds) {
    const int tid = otid(), lane = tid & 63, w = tid >> 6, r = lane & 31, h = lane >> 5; unsigned char* const ws_ = optr(P.ws);
    const int c = item & 63, hh = (item >> 6) & 3, b = item >> 8;
    const size_t t0 = (size_t)b * SEQ + (size_t)c * 128;
    const bf16_t* Z = (const bf16_t*)(ws_ + WS_ZB);
    const float* cw = P.in[2] + l * 4 * 512; const float* cb = P.in[3] + l * 512;
    lds_t KT = lds, VT = lds + 64 * TS128; LAS float* bc = (LAS float*)(lds + 2 * 64 * TS128); LAS float* ig = bc + 128; LAS float* wst = ig + 128;
    mlstm_gates(Z, t0, hh, P.in[4][l * 4 + hh], P.in[5][l * 4 + hh], bc, ig, tid);
    __syncthreads();
    const float blast = bc[127];
    if (tid < 128) wst[tid] = __expf(blast - bc[tid] + ig[tid]);
    __syncthreads();
#pragma unroll
    for (int q = 0; q < 2; ++q) {
        const int e = tid + q * 512, s = e >> 3, ch = e & 7;
        float y[8];
        conv8(Z + (t0 + s) * ZP + ZC_MK + hh * 64 + 8 * ch, c * 128 + s, cw, cb, 256 + hh * 64 + 8 * ch, 0.125f, y);
#pragma unroll
        for (int i = 0; i < 8; ++i) *(LAS bf16_t*)(KT + (8 * ch + i) * TS128 + s * 2) = f2bf(y[i]);
        const u32x4 vw = *(const u32x4*)(Z + (t0 + s) * ZP + ZC_MV + hh * 64 + 8 * ch);
        const float ws_ = wst[s];
        const float vv[8] = {bflo(vw.x), bfhi(vw.x), bflo(vw.y), bfhi(vw.y), bflo(vw.z), bfhi(vw.z), bflo(vw.w), bfhi(vw.w)};
#pragma unroll
        for (int i = 0; i < 8; ++i) *(LAS bf16_t*)(VT + (8 * ch + i) * TS128 + s * 2) = f2bf(vv[i] * ws_);
    }
    __syncthreads();
    float* DC = (float*)(ws_ + WS_DC) + (size_t)item * 4096; float* DN = (float*)(ws_ + WS_DN) + (size_t)item * 64; float* DEC = (float*)(ws_ + WS_DEC);
    if (w < 4) {
        const int vt = w >> 1, kt = w & 1;
        f32x16 acc = {};
#pragma unroll
        for (int ks = 0; ks < 8; ++ks) {
            const bf16x8 a = lds16(VT + (32 * vt + r) * TS128 + (16 * ks + 8 * h) * 2);
            const bf16x8 bb = lds16(KT + (32 * kt + r) * TS128 + (16 * ks + 8 * h) * 2);
            acc = MFMA32(a, bb, acc);
        }
#pragma unroll
        for (int i = 0; i < 16; ++i) DC[(32 * vt + crow(i, h)) * 64 + 32 * kt + r] = acc[i];
    } else if (w == 4) {
        float sum = 0.f;
#pragma unroll 4
        for (int s8 = 0; s8 < 16; ++s8) {
            const u32x4 kw = *(const LAS u32x4*)(KT + lane * TS128 + s8 * 16);
            const f32x4 w0 = *(const LAS f32x4*)(wst + 8 * s8), w1 = *(const LAS f32x4*)(wst + 8 * s8 + 4);
            sum += bflo(kw.x) * w0[0] + bfhi(kw.x) * w0[1] + bflo(kw.y) * w0[2] + bfhi(kw.y) * w0[3] + bflo(kw.z) * w1[0] + bfhi(kw.z) * w1[1] + bflo(kw.w) * w1[2] + bfhi(kw.w) * w1[3];
        }
        DN[lane] = sum;
    } else if (w == 5 && lane == 0) DEC[item] = __expf(blast);
    __syncthreads();
}
__device__ __forceinline__ void mlstm_scan(const Params& P, int G) {
    unsigned char* const ws_ = optr(P.ws); const int tid = otid();
    const float* DC = (const float*)(ws_ + WS_DC); const float* DN = (const float*)(ws_ + WS_DN); const float* DEC = (const float*)(ws_ + WS_DEC);
    bf16_t* CS = (bf16_t*)(ws_ + WS_CS); float* NS = (float*)(ws_ + WS_NS);
    for (int ch = blockIdx.x * NTHREADS + tid; ch < 32 * 4160; ch += G * NTHREADS) {
        const int seq = ch / 4160, e = ch % 4160;
        float st = 0.f;
        if (e < 4096) {
#pragma unroll 8
            for (int c = 0; c < 64; ++c) { const int it = seq * 64 + c; CS[(size_t)it * 4096 + e] = f2bf(st); st = DEC[it] * st + DC[(size_t)it * 4096 + e]; }
        } else {
            const int k = e - 4096;
#pragma unroll 8
            for (int c = 0; c < 64; ++c) { const int it = seq * 64 + c; NS[it * 64 + k] = st; st = DEC[it] * st + DN[it * 64 + k]; }
        }
    }
}
__device__ __forceinline__ void mlstm_c_item(const Params& P, int l, int item, lds_t lds) {
    const int tid = otid(), lane = tid & 63, w = tid >> 6, r = lane & 31, h = lane >> 5; unsigned char* const ws_ = optr(P.ws);
    const int c = item & 63, hh = (item >> 6) & 3, b = item >> 8;
    const size_t t0 = (size_t)b * SEQ + (size_t)c * 128;
    const bf16_t* Z = (const bf16_t*)(ws_ + WS_ZB);
    const float* cw = P.in[2] + l * 4 * 512; const float* cb = P.in[3] + l * 512;
    lds_t Qs = lds, Ks = Qs + 128 * RS64, VT = Ks + 128 * RS64, Cs = VT + 64 * TS128, Hs = Cs + 64 * RS64;
    LAS float* bc = (LAS float*)(Hs + 128 * RS64); LAS float* ig = bc + 128; LAS float* ns = ig + 128;
    mlstm_gates(Z, t0, hh, P.in[4][l * 4 + hh], P.in[5][l * 4 + hh], bc, ig, tid);
#pragma unroll
    for (int q = 0; q < 2; ++q) {
        const int e = tid + q * 512, s = e >> 3, ch = e & 7;
        float y[8];
        conv8(Z + (t0 + s) * ZP + ZC_MQ + hh * 64 + 8 * ch, c * 128 + s, cw, cb, hh * 64 + 8 * ch, 1.f, y);
        *(LAS u32x4*)(Qs + s * RS64 + ch * 16) = (u32x4){pk2(y[0], y[1]), pk2(y[2], y[3]), pk2(y[4], y[5]), pk2(y[6], y[7])};
        conv8(Z + (t0 + s) * ZP + ZC_MK + hh * 64 + 8 * ch, c * 128 + s, cw, cb, 256 + hh * 64 + 8 * ch, 0.125f, y);
        *(LAS u32x4*)(Ks + s * RS64 + ch * 16) = (u32x4){pk2(y[0], y[1]), pk2(y[2], y[3]), pk2(y[4], y[5]), pk2(y[6], y[7])};
        const u32x4 vw = *(const u32x4*)(Z + (t0 + s) * ZP + ZC_MV + hh * 64 + 8 * ch);
        const unsigned vv[4] = {vw.x, vw.y, vw.z, vw.w};
#pragma unroll
        for (int i = 0; i < 4; ++i) { *(LAS bf16_t*)(VT + (8 * ch + 2 * i) * TS128 + s * 2) = (bf16_t)(vv[i] & 0xffffu); *(LAS bf16_t*)(VT + (8 * ch + 2 * i + 1) * TS128 + s * 2) = (bf16_t)(vv[i] >> 16); }
    }
    { const int v = tid >> 3, ch = tid & 7; *(LAS u32x4*)(Cs + v * RS64 + ch * 16) = *(const u32x4*)((const bf16_t*)(ws_ + WS_CS) + (size_t)item * 4096 + v * 64 + ch * 8); }
    if (tid < 64) ns[tid] = ((const float*)(ws_ + WS_NS))[item * 64 + tid];
    __syncthreads();
    if (w < 4) {
        const int tt = w, tl = 32 * tt + r;
        bf16x8 qf[4];
#pragma unroll
        for (int ks = 0; ks < 4; ++ks) qf[ks] = lds16(Qs + tl * RS64 + (16 * ks + 8 * h) * 2);
        f32x16 num[2] = {};
#pragma unroll
        for (int vt = 0; vt < 2; ++vt)
#pragma unroll
            for (int ks = 0; ks < 4; ++ks) num[vt] = MFMA32(lds16(Cs + (32 * vt + r) * RS64 + (16 * ks + 8 * h) * 2), qf[ks], num[vt]);
        float nq = 0.f;
#pragma unroll
        for (int ks = 0; ks < 4; ++ks) {
            const u32x4 qw = __builtin_bit_cast(u32x4, qf[ks]);
            const f32x4 n0 = *(const LAS f32x4*)(ns + 16 * ks + 8 * h), n1 = *(const LAS f32x4*)(ns + 16 * ks + 8 * h + 4);
            nq += bflo(qw.x) * n0[0] + bfhi(qw.x) * n0[1] + bflo(qw.y) * n0[2] + bfhi(qw.y) * n0[3] + bflo(qw.z) * n1[0] + bfhi(qw.z) * n1[1] + bflo(qw.w) * n1[2] + bfhi(qw.w) * n1[3];
        }
        nq = swap_add(nq);
        const float bt = bc[tl], eb = __expf(bt);
#pragma unroll
        for (int vt = 0; vt < 2; ++vt)
#pragma unroll
            for (int i = 0; i < 16; ++i) num[vt][i] *= eb;
        float den = 0.f;
        for (int st = 0; st <= tt; ++st) {
            f32x16 S = {};
#pragma unroll
            for (int ks = 0; ks < 4; ++ks) S = MFMA32(lds16(Ks + (32 * st + r) * RS64 + (16 * ks + 8 * h) * 2), qf[ks], S);
#pragma unroll
            for (int i = 0; i < 16; ++i) { const int s = 32 * st + crow(i, h); const float wgt = (s <= tl) ? __expf(bt - bc[s] + ig[s]) : 0.f; S[i] *= wgt; den += S[i]; }
#pragma unroll
            for (int s2 = 0; s2 < 2; ++s2) { const bf16x8 pf = pack8(S, s2);
#pragma unroll
                for (int vt = 0; vt < 2; ++vt) { lds_t vp = VT + (32 * vt + r) * TS128 + (32 * st + 16 * s2 + 4 * h) * 2; num[vt] = MFMA32(lds8x2(vp, vp + 16), pf, num[vt]); } }
        }
        den = swap_add(den) + eb * nq;
        const float dinv = 1.f / fmaxf(fabsf(den), 1.f);
        float ss = 0.f;
#pragma unroll
        for (int vt = 0; vt < 2; ++vt)
#pragma unroll
            for (int i = 0; i < 16; ++i) { num[vt][i] *= dinv; ss += num[vt][i] * num[vt][i]; }
        ss = swap_add(ss);
        const float rn = 1.f / sqrtf(ss * (1.f / 64.f) + EPS);
#pragma unroll
        for (int vt = 0; vt < 2; ++vt)
#pragma unroll
            for (int i = 0; i < 16; ++i) *(LAS bf16_t*)(Hs + tl * RS64 + (32 * vt + crow(i, h)) * 2) = f2bf(num[vt][i] * rn);
    }
    __syncthreads();
    bf16_t* CAT = (bf16_t*)(ws_ + WS_CAT);
    const float* mg = P.in[6] + l * 256 + hh * 64;
#pragma unroll
    for (int q = 0; q < 2; ++q) {
        const int e = tid + q * 512, t = e >> 3, ch = e & 7;
        const u32x4 hw = *(const LAS u32x4*)(Hs + t * RS64 + ch * 16);
        const u32x4 ow = *(const u32x4*)(Z + (t0 + t) * ZP + ZC_MO + hh * 64 + 8 * ch);
        const f32x4 g0 = *(const f32x4*)(mg + 8 * ch), g1 = *(const f32x4*)(mg + 8 * ch + 4);
        u32x4 o;
        o.x = pk2(bflo(hw.x) * g0[0] * sigmoidf_(bflo(ow.x)), bfhi(hw.x) * g0[1] * sigmoidf_(bfhi(ow.x)));
        o.y = pk2(bflo(hw.y) * g0[2] * sigmoidf_(bflo(ow.y)), bfhi(hw.y) * g0[3] * sigmoidf_(bfhi(ow.y)));
        o.z = pk2(bflo(hw.z) * g1[0] * sigmoidf_(bflo(ow.z)), bfhi(hw.z) * g1[1] * sigmoidf_(bfhi(ow.z)));
        o.w = pk2(bflo(hw.w) * g1[2] * sigmoidf_(bflo(ow.w)), bfhi(hw.w) * g1[3] * sigmoidf_(bfhi(ow.w)));
        *(u32x4*)(CAT + (t0 + t) * DM + hh * 64 + 8 * ch) = o;
    }
    __syncthreads();
}

constexpr int TS256 = 520;
__device__ __forceinline__ void swa_item(const Params& P, int l, int item, lds_t lds) {
    const int tid = otid(), lane = tid & 63, w = tid >> 6, r = lane & 31, h = lane >> 5; unsigned char* const ws_ = optr(P.ws);
    const int kvh = item & 1, nb = (item >> 1) & 63, b = item >> 7;
    const size_t t0 = (size_t)b * SEQ + (size_t)nb * 128;
    const bf16_t* Z = (const bf16_t*)(ws_ + WS_ZB);
    lds_t Ks = lds, VT = lds + 256 * RS64, Os = VT + 64 * TS256;
#pragma unroll
    for (int q = 0; q < 4; ++q) {
        const int e = tid + q * 512, kb = e >> 3, ch = e & 7;
        u32x4 kw = {0u, 0u, 0u, 0u}, vw = {0u, 0u, 0u, 0u};
        if (nb > 0 || kb >= 128) { const bf16_t* zr = Z + (t0 - 128 + kb) * ZP; kw = *(const u32x4*)(zr + ZC_SK + kvh * 64 + 8 * ch); vw = *(const u32x4*)(zr + ZC_SV + kvh * 64 + 8 * ch); }
        *(LAS u32x4*)(Ks + kb * RS64 + ch * 16) = kw;
        const unsigned vv[4] = {vw.x, vw.y, vw.z, vw.w};
#pragma unroll
        for (int i = 0; i < 4; ++i) { *(LAS bf16_t*)(VT + (8 * ch + 2 * i) * TS256 + kb * 2) = (bf16_t)(vv[i] & 0xffffu); *(LAS bf16_t*)(VT + (8 * ch + 2 * i + 1) * TS256 + kb * 2) = (bf16_t)(vv[i] >> 16); }
    }
    __syncthreads();
    bf16_t* CAT = (bf16_t*)(ws_ + WS_CAT);
    lds_t Ow = Os + w * 32 * RS64;
    for (int cc = w; cc < 16; cc += 8) {
        const int hq = cc >> 2, qt = cc & 3, hg = kvh * 4 + hq, ql = 32 * qt + r;
        const float sink = P.in[7][l * 8 + hg];
        const bf16_t* qp = Z + (t0 + ql) * ZP + ZC_SQ + hg * 64;
        bf16x8 qf[4];
#pragma unroll
        for (int ks = 0; ks < 4; ++ks) qf[ks] = *(const bf16x8*)(qp + 16 * ks + 8 * h);
        f32x16 S[5];
        float mx = sink;
#pragma unroll
        for (int k5 = 0; k5 < 5; ++k5) {
            const int kt = qt + k5;
            S[k5] = (f32x16){};
#pragma unroll
            for (int ks = 0; ks < 4; ++ks) S[k5] = MFMA32(lds16(Ks + (32 * kt + r) * RS64 + (16 * ks + 8 * h) * 2), qf[ks], S[k5]);
#pragma unroll
            for (int i = 0; i < 16; ++i) { const int kb = 32 * kt + crow(i, h); const bool ok = (kb > ql) && (kb <= ql + 128) && (nb > 0 || kb >= 128);
                S[k5][i] = ok ? S[k5][i] * 0.125f : -1e30f; mx = fmaxf(mx, S[k5][i]); }
        }
        mx = swap_max(mx);
        float sum = 0.f;
#pragma unroll
        for (int k5 = 0; k5 < 5; ++k5)
#pragma unroll
            for (int i = 0; i < 16; ++i) { S[k5][i] = __expf(S[k5][i] - mx); sum += S[k5][i]; }
        sum = swap_add(sum) + __expf(sink - mx);
        const float inv = 1.f / sum;
        f32x16 O[2] = {};
#pragma unroll
        for (int k5 = 0; k5 < 5; ++k5) {
            const int kt = qt + k5;
#pragma unroll
            for (int i = 0; i < 16; ++i) S[k5][i] *= inv;
#pragma unroll
            for (int s2 = 0; s2 < 2; ++s2) { const bf16x8 pf = pack8(S[k5], s2);
#pragma unroll
                for (int dt = 0; dt < 2; ++dt) { lds_t vp = VT + (32 * dt + r) * TS256 + (32 * kt + 16 * s2 + 4 * h) * 2; O[dt] = MFMA32(lds8x2(vp, vp + 16), pf, O[dt]); } }
        }
#pragma unroll
        for (int dt = 0; dt < 2; ++dt)
#pragma unroll
            for (int i = 0; i < 16; ++i) *(LAS bf16_t*)(Ow + r * RS64 + (32 * dt + crow(i, h)) * 2) = f2bf(O[dt][i]);
        asm volatile("s_waitcnt lgkmcnt(0)" ::: "memory");
#pragma unroll
        for (int it = 0; it < 4; ++it) { const int row = it * 8 + (lane >> 3), ch = lane & 7; const u32x4 v = *(const LAS u32x4*)(Ow + row * RS64 + ch * 16);
            *(u32x4*)(CAT + (t0 + 32 * qt + row) * DM + 256 + hg * 64 + 8 * ch) = v; }
        asm volatile("s_waitcnt lgkmcnt(0)" ::: "memory");
    }
    __syncthreads();
}

constexpr int DK_BYTES = 64 * RS64;
constexpr int TS64 = 136;
constexpr int DV_BYTES = 64 * TS64;
constexpr int DBUF = DK_BYTES + DV_BYTES;
__device__ __forceinline__ void diff_item(const Params& P, int l, int seq, int qb, lds_t lds, float lam, float oscale) {
    const int tid = otid(), lane = tid & 63, w = tid >> 6, r = lane & 31, h = lane >> 5; unsigned char* const ws_ = optr(P.ws);
    const int b = seq >> 2, hd = seq & 3;
    const size_t row0 = (size_t)b * SEQ;
    const bf16_t* Z = (const bf16_t*)(ws_ + WS_ZB);
    const int qrow = qb * 256 + w * 32 + r, wmin = qb * 256 + w * 32;
    const bf16_t* qp = Z + (row0 + qrow) * ZP + ZC_DQ + hd * 64;
    bf16x8 qf[2][2];
#pragma unroll
    for (int m = 0; m < 2; ++m)
#pragma unroll
        for (int ks = 0; ks < 2; ++ks) qf[m][ks] = *(const bf16x8*)(qp + 32 * m + 16 * ks + 8 * h);
    f32x16 O[2][2] = {};
    float mx[2] = {-1e30f, -1e30f}, ls[2] = {0.f, 0.f};
    const int NT = 4 * qb + 4;
    constexpr float C = 0.17677669529663687f * 1.4426950408889634f;
    const int skey = tid >> 3, sch = tid & 7;
    const bf16_t* kg = Z + (row0 + skey) * ZP + ZC_DK + hd * 64 + 8 * sch; const bf16_t* vg = Z + (row0 + skey) * ZP + ZC_DV + hd * 64 + 8 * sch;
    lds_t Os = lds + 2 * DBUF;
    u32x4 kreg = *(const u32x4*)kg, vreg = *(const u32x4*)vg;
    auto stage_write = [&](int buf) {
        lds_t Kb = lds + buf * DBUF, Vb = Kb + DK_BYTES;
        *(LAS u32x4*)(Kb + skey * RS64 + sch * 16) = kreg;
        const unsigned vv[4] = {vreg.x, vreg.y, vreg.z, vreg.w};
#pragma unroll
        for (int i = 0; i < 4; ++i) { *(LAS bf16_t*)(Vb + (8 * sch + 2 * i) * TS64 + skey * 2) = (bf16_t)(vv[i] & 0xffffu); *(LAS bf16_t*)(Vb + (8 * sch + 2 * i + 1) * TS64 + skey * 2) = (bf16_t)(vv[i] >> 16); }
    };
    stage_write(0);
    __syncthreads();
    for (int kt = 0; kt < NT; ++kt) {
        if (kt + 1 < NT) { kreg = *(const u32x4*)(kg + (size_t)(kt + 1) * 64 * ZP); vreg = *(const u32x4*)(vg + (size_t)(kt + 1) * 64 * ZP); }
        if (64 * kt <= wmin + 31) {
            lds_t Kb = lds + (kt & 1) * DBUF, Vb = Kb + DK_BYTES;
            const bool needmask = (64 * kt + 63 > wmin);
            f32x16 S[2][2];
#pragma unroll
            for (int m = 0; m < 2; ++m)
#pragma unroll
                for (int kh = 0; kh < 2; ++kh) { S[m][kh] = (f32x16){};
#pragma unroll
                    for (int ks = 0; ks < 2; ++ks) S[m][kh] = MFMA32(lds16(Kb + (32 * kh + r) * RS64 + (32 * m + 16 * ks + 8 * h) * 2), qf[m][ks], S[m][kh]); }
            if (needmask) {
#pragma unroll
                for (int kh = 0; kh < 2; ++kh)
#pragma unroll
                    for (int i = 0; i < 16; ++i) { const int key = 64 * kt + 32 * kh + crow(i, h); if (key > qrow) { S[0][kh][i] = -1e30f; S[1][kh][i] = -1e30f; } }
            }
            bf16x8 pf[2][2][2];
#pragma unroll
            for (int m = 0; m < 2; ++m) {
                float tm = S[m][0][0];
#pragma unroll
                for (int kh = 0; kh < 2; ++kh)
#pragma unroll
                    for (int i = 0; i < 16; ++i) tm = fmaxf(tm, S[m][kh][i]);
                const float mnew = fmaxf(mx[m], swap_max(tm));
                if (__any(mnew > mx[m])) {
                    const float alpha = __builtin_amdgcn_exp2f((mx[m] - mnew) * C);
                    ls[m] *= alpha;
#pragma unroll
                    for (int dt = 0; dt < 2; ++dt)
#pragma unroll
                        for (int i = 0; i < 16; ++i) O[m][dt][i] *= alpha;
                    mx[m] = mnew;
                }
                const float nb = -mx[m] * C;
                float sum = 0.f;
#pragma unroll
                for (int kh = 0; kh < 2; ++kh)
#pragma unroll
                    for (int i = 0; i < 16; ++i) { const float p = __builtin_amdgcn_exp2f(fmaf(S[m][kh][i], C, nb)); S[m][kh][i] = p; sum += p; }
                ls[m] += sum;
#pragma unroll
                for (int kh = 0; kh < 2; ++kh)
#pragma unroll
                    for (int s2 = 0; s2 < 2; ++s2) pf[m][kh][s2] = pack8(S[m][kh], s2);
            }
#pragma unroll
            for (int dt = 0; dt < 2; ++dt)
#pragma unroll
                for (int kh = 0; kh < 2; ++kh)
#pragma unroll
                    for (int s2 = 0; s2 < 2; ++s2) { lds_t vp = Vb + (32 * dt + r) * TS64 + (32 * kh + 16 * s2 + 4 * h) * 2; const bf16x8 vf = lds8x2(vp, vp + 16);
                        O[0][dt] = MFMA32(vf, pf[0][kh][s2], O[0][dt]); O[1][dt] = MFMA32(vf, pf[1][kh][s2], O[1][dt]); }
        }
        if (kt + 1 < NT) stage_write((kt + 1) & 1);
        __syncthreads();
    }
    const float i1 = 1.f / swap_add(ls[0]), i2 = lam / swap_add(ls[1]);
    float ss = 0.f;
#pragma unroll
    for (int dt = 0; dt < 2; ++dt)
#pragma unroll
        for (int i = 0; i < 16; ++i) { const float o = O[0][dt][i] * i1 - O[1][dt][i] * i2; O[0][dt][i] = o; ss += o * o; }
    ss = swap_add(ss);
    const float rn = oscale / sqrtf(ss * (1.f / 64.f) + EPS);
    lds_t Ow = Os + w * 32 * RS64;
#pragma unroll
    for (int dt = 0; dt < 2; ++dt)
#pragma unroll
        for (int i = 0; i < 16; ++i) *(LAS bf16_t*)(Ow + r * RS64 + (32 * dt + crow(i, h)) * 2) = f2bf(O[0][dt][i] * rn);
    asm volatile("s_waitcnt lgkmcnt(0)" ::: "memory");
    bf16_t* CAT = (bf16_t*)(ws_ + WS_CAT);
    const float* sg = P.in[12] + l * 64;
#pragma unroll
    for (int it = 0; it < 4; ++it) { const int row = it * 8 + (lane >> 3), ch = lane & 7; const u32x4 v = *(const LAS u32x4*)(Ow + row * RS64 + ch * 16);
        const f32x4 g0 = *(const f32x4*)(sg + 8 * ch), g1 = *(const f32x4*)(sg + 8 * ch + 4);
        u32x4 o; o.x = pk2(bflo(v.x) * g0[0], bfhi(v.x) * g0[1]); o.y = pk2(bflo(v.y) * g0[2], bfhi(v.y) * g0[3]); o.z = pk2(bflo(v.z) * g1[0], bfhi(v.z) * g1[1]); o.w = pk2(bflo(v.w) * g1[2], bfhi(v.w) * g1[3]);
        *(u32x4*)(CAT + (row0 + wmin + row) * DM + 768 + hd * 64 + 8 * ch) = o; }
    __syncthreads();
}

constexpr int N_PHASES = 19;
__global__ void __launch_bounds__(NTHREADS, 2) hybrid_fwd(Params P) {
    extern __shared__ __attribute__((aligned(16))) unsigned char lds_raw[];
    lds_t lds = (lds_t)lds_raw;
    cg::grid_group grid = cg::this_grid();
    const int G = gridDim.x, lo = P.ph_lo, hi = P.ph_hi;
    int ph = 0;
#define PHASE_BEGIN(k) if (((PH_MASK >> (k)) & 1) && lo <= ph && ph < hi) {
#define PHASE_END   if (ph + 1 < hi) grid.sync(); } ++ph;
    PHASE_BEGIN(0) prologue(P, lds, G); PHASE_END
    for (int l = 0; l < 2; ++l) {
        unsigned char* wb = P.ws + WS_W + (size_t)l * W_LAYER;
        bf16_t* XB = (bf16_t*)(P.ws + WS_XB); float* RS = (float*)(P.ws + WS_RS);
        PHASE_BEGIN(1) {
            pg8::Gemm g{XB, (const bf16_t*)(wb + W_IN), NTOK, ZP, DM}; pg8::StaticOrder S; S.init(NTOK, ZP, G, (int)blockIdx.x);
            pg8::EpiInProj E{(bf16_t*)(P.ws + WS_ZB), RS, (const f32x2*)(P.ws + WS_ROPE)};
            pg8::gemm_phase<pg8::EpiInProj, pg8::StaticOrder, true, true>(lds, g, S, E);
        } PHASE_END
        PHASE_BEGIN(2) {
            for (int it = blockIdx.x; it < 2048; it += G) mlstm_a_item(P, l, it, lds);
            for (int it = blockIdx.x; it < 1024; it += G) swa_item(P, l, it, lds);
        } PHASE_END
        PHASE_BEGIN(3) {
            mlstm_scan(P, G);
            float d1 = 0.f, d2 = 0.f;
            for (int i = 0; i < 32; ++i) { d1 += P.in[8][l * 32 + i] * P.in[9][l * 32 + i]; d2 += P.in[10][l * 32 + i] * P.in[11][l * 32 + i]; }
            const float lam_init = 0.8f - 0.6f * expf(-0.3f * (float)l);
            const float lam = expf(d1) - expf(d2) + lam_init;
            for (int vg = blockIdx.x; vg < 256; vg += G) {
                const int seq = vg >> 3, j = vg & 7;
                diff_item(P, l, seq, 31 - j, lds, lam, 1.f - lam_init);
                diff_item(P, l, seq, 16 + j, lds, lam, 1.f - lam_init);
                diff_item(P, l, seq, 15 - j, lds, lam, 1.f - lam_init);
                diff_item(P, l, seq, j, lds, lam, 1.f - lam_init);
            }
        } PHASE_END
        PHASE_BEGIN(4) {
            for (int it = blockIdx.x; it < 2048; it += G) mlstm_c_item(P, l, it, lds);
        } PHASE_END
        PHASE_BEGIN(5) {
            pg8::Gemm g{(const bf16_t*)(P.ws + WS_CAT), (const bf16_t*)(wb + W_OUT), NTOK, DM, DM}; pg8::StaticOrder S; S.init(NTOK, DM, G, (int)blockIdx.x);
            pg8::EpiRow<0> E{(bf16_t*)(P.ws + WS_MIX), DM, nullptr};
            pg8::gemm_phase<pg8::EpiRow<0>, pg8::StaticOrder, true, true>(lds, g, S, E);
        } PHASE_END
        PHASE_BEGIN(6) resid_pass(P, l == 0 ? P.in[0] : P.out, P.in[17] + l * DM, true, G); PHASE_END
        PHASE_BEGIN(7) {
            pg8::Gemm g{XB, (const bf16_t*)(wb + W_UP), NTOK, FF, DM}; pg8::StaticOrder S; S.init(NTOK, FF, G, (int)blockIdx.x);
            pg8::EpiRow<1> E{(bf16_t*)(P.ws + WS_U), FF, RS};
            pg8::gemm_phase<pg8::EpiRow<1>, pg8::StaticOrder, true, true>(lds, g, S, E);
        } PHASE_END
        PHASE_BEGIN(8) {
            pg8::Gemm g{(const bf16_t*)(P.ws + WS_U), (const bf16_t*)(wb + W_DOWN), NTOK, DM, FF}; pg8::StaticOrder S; S.init(NTOK, DM, G, (int)blockIdx.x);
            pg8::EpiRow<0> E{(bf16_t*)(P.ws + WS_MIX), DM, nullptr};
            pg8::gemm_phase<pg8::EpiRow<0>, pg8::StaticOrder, true, true>(lds, g, S, E);
        } PHASE_END
        PHASE_BEGIN(9) resid_pass(P, P.out, P.in[19] + l * DM, l == 0, G); PHASE_END
    }
#undef PHASE_BEGIN
#undef PHASE_END
}

extern "C" void kernel_launch(void* const* d_in, const int* in_sizes, int n_in, void* d_out, int out_size, void* d_ws, size_t ws_size, hipStream_t stream) {
    static int grid = 0;
    if (grid == 0) {
        if (n_in != 20 || out_size != NTOK * DM || ws_size < WS_END) { fprintf(stderr, "kernel_launch: unexpected shapes (n_in %d out %d ws %zu)\n", n_in, out_size, ws_size); grid = -1; return; }
        int dev = 0, cus = 0, per_cu = 0;
        hipGetDevice(&dev); hipDeviceGetAttribute(&cus, hipDeviceAttributeMultiprocessorCount, dev);
        if (hipFuncSetAttribute((const void*)hybrid_fwd, hipFuncAttributeMaxDynamicSharedMemorySize, LDS_BYTES) != hipSuccess) { fprintf(stderr, "kernel_launch: hipFuncSetAttribute failed\n"); grid = -1; return; }
        if (hipOccupancyMaxActiveBlocksPerMultiprocessor(&per_cu, (const void*)hybrid_fwd, NTHREADS, LDS_BYTES) != hipSuccess || per_cu < 1) { fprintf(stderr, "kernel_launch: occupancy query says %d\n", per_cu); per_cu = 1; }
        (void)hipGetLastError();
        grid = cus;
    }
    if (grid < 0) return;
    Params p{};
    for (int i = 0; i < 20; ++i) p.in[i] = (const float*)d_in[i];
    p.out = (float*)d_out; p.ws = (unsigned char*)d_ws;
#if ONE_LAUNCH
    p.ph_lo = 0; p.ph_hi = N_PHASES;
    void* args[] = {&p};
    hipError_t e = hipLaunchCooperativeKernel((const void*)hybrid_fwd, dim3(grid), dim3(NTHREADS), args, LDS_BYTES, stream);
    if (e != hipSuccess) fprintf(stderr, "cooperative launch failed: %s (grid %d)\n", hipGetErrorString(e), grid);
#else
    for (int ph = 0; ph < N_PHASES; ++ph) {
        p.ph_lo = ph; p.ph_hi = ph + 1;
        hipLaunchKernelGGL(hybrid_fwd, dim3(grid), dim3(NTHREADS), LDS_BYTES, stream, p);
    }
#endif
}
```

```cpp
#include <hip/hip_runtime.h>
#include <hip/hip_cooperative_groups.h>
#include <cstdio>
#include <cstdint>
namespace cg = cooperative_groups;

#ifndef PH_MASK
#define PH_MASK 0x3ff
#endif
#ifndef ONE_LAUNCH
#define ONE_LAUNCH 1
#endif

#define LAS __attribute__((address_space(3)))
typedef unsigned short bf16_t;
typedef short bf16x8 __attribute__((ext_vector_type(8)));
typedef short s16x4 __attribute__((ext_vector_type(4)));
typedef float f32x4 __attribute__((ext_vector_type(4)));
typedef float f32x2 __attribute__((ext_vector_type(2)));
typedef float f32x16 __attribute__((ext_vector_type(16)));
typedef unsigned u32x4 __attribute__((ext_vector_type(4)));
typedef unsigned u32x2 __attribute__((ext_vector_type(2)));
typedef __bf16 bf16x2_t __attribute__((ext_vector_type(2)));
typedef LAS unsigned char* lds_t;

constexpr int BATCH = 8, SEQ = 8192, DM = 1024, FF = 4096, NTOK = BATCH * SEQ;
constexpr int INW = 2568, ZP = 2816;
constexpr int ZC_MQ = 0, ZC_MK = 256, ZC_MV = 512, ZC_MO = 768, ZC_SQ = 1024, ZC_SK = 1536, ZC_SV = 1664, ZC_DQ = 1792, ZC_DK = 2048, ZC_DV = 2304, ZC_G = 2560;
constexpr float EPS = 1e-6f;
constexpr int NWAVES = 8, NTHREADS = 512;

constexpr size_t MiB = 1u << 20;
constexpr size_t WS_W = 2 * MiB;
constexpr size_t W_LAYER = 24 * MiB, W_IN = 0, W_OUT = 6 * MiB, W_UP = 8 * MiB, W_DOWN = 16 * MiB;
constexpr size_t WS_ROPE = 50 * MiB;
constexpr size_t WS_RS = 52 * MiB;
constexpr size_t WS_XB = 54 * MiB;
constexpr size_t WS_MIX = 182 * MiB;
constexpr size_t WS_U = 310 * MiB;
constexpr size_t WS_ZB = 310 * MiB;
constexpr size_t WS_CAT = 662 * MiB;
constexpr size_t WS_DC = 822 * MiB;
constexpr size_t WS_DN = 854 * MiB;
constexpr size_t WS_DEC = 855 * MiB;
constexpr size_t WS_CS = 856 * MiB;
constexpr size_t WS_NS = 872 * MiB;
constexpr size_t WS_END = 874 * MiB;

constexpr int LDS_BYTES = 147456;

struct Params {
    const float* in[20];
    float* out;
    unsigned char* ws;
    int ph_lo, ph_hi;
};

__device__ __forceinline__ unsigned pk2(float lo, float hi) { f32x2 v = {lo, hi}; bf16x2_t b = __builtin_convertvector(v, bf16x2_t); return __builtin_bit_cast(unsigned, b); }
__device__ __forceinline__ bf16_t f2bf(float f) { return (bf16_t)(pk2(f, 0.f) & 0xffffu); }
__device__ __forceinline__ float bf2f(unsigned u16) { return __uint_as_float(u16 << 16); }
__device__ __forceinline__ float bflo(unsigned w) { return __uint_as_float(w << 16); }
__device__ __forceinline__ float bfhi(unsigned w) { return __uint_as_float(w & 0xffff0000u); }
__device__ __forceinline__ int crow(int i, int h) { return (i & 3) + 8 * (i >> 2) + 4 * h; }
__device__ __forceinline__ float wave_sum(float v) {
#pragma unroll
    for (int o = 1; o < 64; o <<= 1) v += __shfl_xor(v, o);
    return v;
}
__device__ __forceinline__ float swap_add(float v) { auto rr = __builtin_amdgcn_permlane32_swap(__float_as_uint(v), __float_as_uint(v), false, false); return __uint_as_float(rr[0]) + __uint_as_float(rr[1]); }
__device__ __forceinline__ float swap_max(float v) { auto rr = __builtin_amdgcn_permlane32_swap(__float_as_uint(v), __float_as_uint(v), false, false); return fmaxf(__uint_as_float(rr[0]), __uint_as_float(rr[1])); }
#define MFMA32(a, b, c) __builtin_amdgcn_mfma_f32_32x32x16_bf16((a), (b), (c), 0, 0, 0)
__device__ __forceinline__ bf16x8 pack8(const f32x16& x, int s) {
    u32x4 p; p.x = pk2(x[8 * s], x[8 * s + 1]); p.y = pk2(x[8 * s + 2], x[8 * s + 3]); p.z = pk2(x[8 * s + 4], x[8 * s + 5]); p.w = pk2(x[8 * s + 6], x[8 * s + 7]);
    return __builtin_bit_cast(bf16x8, p);
}
__device__ __forceinline__ bf16x8 lds16(lds_t p) { return *(const LAS bf16x8*)p; }
__device__ __forceinline__ bf16x8 lds8x2(lds_t p0, lds_t p1) { s16x4 a = *(const LAS s16x4*)p0, b = *(const LAS s16x4*)p1; return __builtin_shufflevector(a, b, 0, 1, 2, 3, 4, 5, 6, 7); }
__device__ __forceinline__ float sigmoidf_(float x) { return 1.f / (1.f + __expf(-x)); }
__device__ __forceinline__ float logsigmoidf_(float x) { return fminf(x, 0.f) - log1pf(__expf(-fabsf(x))); }

__device__ __forceinline__ int otid() { int t = threadIdx.x; asm volatile("" : "+v"(t)); return t; }
template <class T> __device__ __forceinline__ T* optr(T* p) { asm volatile("" : "+s"(p)); return p; }
namespace pg8 {
constexpr int BM = 256, BK = 64, HALF = 128, HTB = HALF * BK * 2, STAGE_BYTES = 8 * HTB, NXCD = 8, WGM = 8;
__host__ __device__ __forceinline__ int lds_byte(int r, int c) { const int st = (r >> 4) * 2 + (c >> 5), rr = r & 15, cc = c & 31, ob = rr * 64 + cc * 2; return st * 1024 + (ob ^ (((ob >> 9) & 1) << 5)); }
__host__ __device__ __forceinline__ void stage_rc(int b, int& R, int& C) { const int st = b / 1024, sb = b % 1024, swz = sb ^ (((sb >> 9) & 1) << 5); R = (st >> 1) * 16 + swz / 64; C = (st & 1) * 32 + (swz % 64) / 2; }
__host__ __device__ __forceinline__ int perm32(int rho) { const int n = rho >> 4, i = rho & 15; return 8 * (i >> 2) + 4 * n + (i & 3); }
struct Unit { int pm, pn; };
struct Gemm { const bf16_t* A; const bf16_t* Bt; int M, N, K; };
struct StaticOrder {
    int nM, nN, nwg, G, c;
    __host__ __device__ void init(int M, int N, int G_, int c_) { nM = M / BM; nN = N / BM; nwg = nM * nN; G = G_; c = c_; }
    __host__ __device__ bool next(int i, Unit& u) const {
        const long L = (long)i * G + c; if (L >= nwg) return false;
        int wgid = (int)L; { const int q = nwg / NXCD, r = nwg % NXCD, xcd = wgid % NXCD, off = wgid / NXCD; wgid = (xcd < r ? xcd * (q + 1) : r * (q + 1) + (xcd - r) * q) + off; }
        const int nig = WGM * nN, gid = wgid / nig, fm = gid * WGM, gsz = (nM - fm) < WGM ? (nM - fm) : WGM;
        u.pm = fm + ((wgid % nig) % gsz); u.pn = (wgid % nig) / gsz; return true;
    }
    __device__ __forceinline__ void a_ready(const Unit&) const {}
    __device__ __forceinline__ void done(const Unit&) const {}
};

template <int ACT> struct EpiRow {
    static constexpr bool PERM = true, AFTER_DRAIN = false;
    bf16_t* O; int ldc; const float* rs;
    __device__ __forceinline__ void operator()(const f32x4 (&acc)[2][2][4][2], const Unit& u, int wr, int wc, int fr, int fq) const {
        const int row0 = u.pm * BM + wr * 64 + fr, col0 = u.pn * BM + wc * 32 + 8 * fq;
#pragma unroll
        for (int ai = 0; ai < 2; ++ai)
#pragma unroll
            for (int m = 0; m < 4; ++m) { const int row = row0 + ai * HALF + m * 16; const float s = rs ? rs[row] : 1.f; bf16_t* rowp = O + (size_t)row * ldc + col0;
#pragma unroll
                for (int bj = 0; bj < 2; ++bj) { f32x4 v0 = acc[ai][bj][m][0] * s, v1 = acc[ai][bj][m][1] * s;
                    if (ACT == 1) {
#pragma unroll
                        for (int i = 0; i < 4; ++i) { const float a = fmaxf(v0[i], 0.f), b = fmaxf(v1[i], 0.f); v0[i] = a * a; v1[i] = b * b; } }
                    u32x4 w; w.x = pk2(v0[0], v0[1]); w.y = pk2(v0[2], v0[3]); w.z = pk2(v1[0], v1[1]); w.w = pk2(v1[2], v1[3]);
                    *(u32x4*)(rowp + bj * HALF) = w; } }
    }
};
struct EpiInProj {
    static constexpr bool PERM = true, AFTER_DRAIN = false;
    bf16_t* O; const float* rs; const f32x2* rope;
    __device__ __forceinline__ void operator()(const f32x4 (&acc)[2][2][4][2], const Unit& u, int wr, int wc, int fr, int fq) const {
        const int row0 = u.pm * BM + wr * 64 + fr, col0 = u.pn * BM + wc * 32 + 8 * fq;
        const int pn = u.pn;
        const int j64 = 4 * (wc & 1) + fq;
#pragma unroll
        for (int ai = 0; ai < 2; ++ai)
#pragma unroll
            for (int m = 0; m < 4; ++m) { const int row = row0 + ai * HALF + m * 16; const float s = rs[row]; bf16_t* rowp = O + (size_t)row * ZP + col0;
                const f32x2* tb = rope + (size_t)(row & (SEQ - 1)) * 32;
#pragma unroll
                for (int bj = 0; bj < 2; ++bj) { f32x4 v0 = acc[ai][bj][m][0] * s, v1 = acc[ai][bj][m][1] * s;
                    const bool r64 = (pn == 4) || (pn == 5) || (pn == 6 && bj == 0), r32 = (pn == 7) || (pn == 8);
                    if (r64 || r32) {
                        f32x2 cs[4];
                        if (r64) { const f32x4 t0 = *(const f32x4*)(tb + 4 * j64), t1 = *(const f32x4*)(tb + 4 * j64 + 2); cs[0] = (f32x2){t0[0], t0[1]}; cs[1] = (f32x2){t0[2], t0[3]}; cs[2] = (f32x2){t1[0], t1[1]}; cs[3] = (f32x2){t1[2], t1[3]}; }
                        else {
#pragma unroll
                            for (int i = 0; i < 4; ++i) cs[i] = tb[8 * fq + 2 * i]; }
#pragma unroll
                        for (int i = 0; i < 4; ++i) { const float a = v0[i], b = v1[i]; v0[i] = a * cs[i].x - b * cs[i].y; v1[i] = b * cs[i].x + a * cs[i].y; }
                    }
                    u32x4 w; w.x = pk2(v0[0], v0[1]); w.y = pk2(v0[2], v0[3]); w.z = pk2(v1[0], v1[1]); w.w = pk2(v1[2], v1[3]);
                    *(u32x4*)(rowp + bj * HALF) = w; } }
    }
};

template <class Epi, class Sched, bool ALIGN_EPI = false, bool SP2 = false>
__device__ __forceinline__ void gemm_phase(lds_t lds, const Gemm g, const Sched& S, const Epi& E) {
    const int tid = otid(), wid = __builtin_amdgcn_readfirstlane(tid >> 6), lane = tid & 63, wr = wid >> 2, wc = wid & 3, fr = lane & 15, fq = lane >> 4;
    const int K = g.K, nt = K / BK;
    unsigned voffA[2], voffB[2];
#pragma unroll
    for (int i = 0; i < 2; ++i) { int R, C; stage_rc(tid * 16 + i * 8192, R, C); const int Rb = Epi::PERM ? ((R & ~31) + perm32(R & 31)) : R;
        voffA[i] = (unsigned)(R * K + C) * 2u; voffB[i] = (unsigned)(Rb * K + C) * 2u; }
    const size_t kstep = (size_t)(BK * 2);
    const size_t hstep = (size_t)HALF * K * 2;
    const size_t tstep = 2 * hstep;
    const unsigned ldsw = (unsigned)wid * 1024u;
    const int aoff = lds_byte(wr * 64 + fr, fq * 8), boff = lds_byte(wc * 32 + fr, fq * 8);
#define PG8_SA(b, h) (((b) * 2 + (h)) * HTB)
#define PG8_SB(b, h) ((4 + (b) * 2 + (h)) * HTB)
#define PG8_STAGE(bufoff, gbase, voff) do { _Pragma("unroll") for (int _i = 0; _i < 2; ++_i) \
        __builtin_amdgcn_global_load_lds((const unsigned*)((const char*)(gbase) + (voff)[_i]), (LAS unsigned*)(lds + (bufoff) + ldsw + _i * 8192), 16, 0, 0); } while (0)
#define PG8_LDA(dst, b, h) do { _Pragma("unroll") for (int m = 0; m < 4; ++m) _Pragma("unroll") for (int k = 0; k < 2; ++k) dst[m][k] = *(const LAS bf16x8*)(lds + PG8_SA(b, h) + aoff + m * 2048 + k * 1024); } while (0)
#define PG8_LDB(dst, b, h) do { _Pragma("unroll") for (int n = 0; n < 2; ++n) _Pragma("unroll") for (int k = 0; k < 2; ++k) dst[n][k] = *(const LAS bf16x8*)(lds + PG8_SB(b, h) + boff + n * 2048 + k * 1024); } while (0)
#define PG8_MMA(ai, bj, At, Bt) do { __builtin_amdgcn_s_setprio(1); _Pragma("unroll") for (int m = 0; m < 4; ++m) _Pragma("unroll") for (int n = 0; n < 2; ++n) _Pragma("unroll") for (int k = 0; k < 2; ++k) \
        acc[ai][bj][m][n] = __builtin_amdgcn_mfma_f32_16x16x32_bf16(Bt[n][k], At[m][k], acc[ai][bj][m][n], 0, 0, 0); __builtin_amdgcn_s_setprio(0); } while (0)
#define PG8_WAIT_V(n) asm volatile("s_waitcnt vmcnt(" #n ")" ::: "memory")
#define PG8_WAIT_L(n) asm volatile("s_waitcnt lgkmcnt(" #n ")" ::: "memory")
#define PG8_BAR __builtin_amdgcn_s_barrier()
#define PG8_SCHED __builtin_amdgcn_sched_barrier(0)
    Unit cur, nxt; int ui = 0;
    if (!S.next(0, cur)) return;
    f32x4 acc[2][2][4][2];
#pragma unroll
    for (int a = 0; a < 2; ++a)
#pragma unroll
        for (int b = 0; b < 2; ++b)
#pragma unroll
            for (int m = 0; m < 4; ++m)
#pragma unroll
                for (int n = 0; n < 2; ++n) acc[a][b][m][n] = (f32x4){0.f, 0.f, 0.f, 0.f};
    bf16x8 At[4][2], B0[2][2], B1[2][2];
    const char* cA = (const char*)g.A + (size_t)cur.pm * tstep; const char* cB = (const char*)g.Bt + (size_t)cur.pn * tstep;
    S.a_ready(cur);
    if constexpr (SP2) {
        PG8_STAGE(PG8_SB(0, 0), cB, voffB); PG8_STAGE(PG8_SB(0, 1), cB + hstep, voffB); PG8_STAGE(PG8_SA(0, 0), cA, voffA); PG8_STAGE(PG8_SA(0, 1), cA + hstep, voffA);
        if (wr == 1) PG8_BAR;
        PG8_WAIT_V(2); PG8_BAR;
        PG8_STAGE(PG8_SB(1, 0), cB + kstep, voffB); PG8_STAGE(PG8_SA(1, 0), cA + kstep, voffA); PG8_STAGE(PG8_SB(1, 1), cB + hstep + kstep, voffB);
        PG8_WAIT_V(6); PG8_BAR;
    } else {
        PG8_STAGE(PG8_SB(0, 0), cB, voffB); PG8_STAGE(PG8_SA(0, 0), cA, voffA); PG8_STAGE(PG8_SB(0, 1), cB + hstep, voffB); PG8_STAGE(PG8_SA(0, 1), cA + hstep, voffA);
        if (wr == 1) PG8_BAR;
        PG8_WAIT_V(4); PG8_BAR;
        PG8_STAGE(PG8_SB(1, 0), cB + kstep, voffB); PG8_STAGE(PG8_SA(1, 0), cA + kstep, voffA); PG8_STAGE(PG8_SB(1, 1), cB + hstep + kstep, voffB);
        PG8_WAIT_V(6); PG8_BAR;
    }
    for (;;) {
        const bool has_next = S.next(ui + 1, nxt);
        const char* nA = has_next ? (const char*)g.A + (size_t)nxt.pm * tstep : cA; const char* nB = has_next ? (const char*)g.Bt + (size_t)nxt.pn * tstep : cB;
        for (int t = 0; t < nt; t += 2) {
            const bool last = (t == nt - 2);
            const char* a1 = cA + (size_t)(t + 1) * kstep;
            const char* a2 = last ? nA : cA + (size_t)(t + 2) * kstep; const char* b2 = last ? nB : cB + (size_t)(t + 2) * kstep;
            const char* a3 = a2 + kstep; const char* b3 = b2 + kstep;
            if (last && has_next) S.a_ready(nxt);
            if constexpr (SP2) {
            PG8_LDB(B0, 0, 0); PG8_LDB(B1, 0, 1); PG8_SCHED; PG8_LDA(At, 0, 0); PG8_STAGE(PG8_SA(1, 1), a1 + hstep, voffA);
            PG8_WAIT_V(8); PG8_WAIT_L(0); PG8_BAR; PG8_MMA(0, 0, At, B0); PG8_MMA(0, 1, At, B1); PG8_BAR; PG8_SCHED;
            PG8_LDA(At, 0, 1); PG8_STAGE(PG8_SB(0, 0), b2, voffB); PG8_STAGE(PG8_SB(0, 1), b2 + hstep, voffB); PG8_STAGE(PG8_SA(0, 0), a2, voffA);
            PG8_WAIT_V(8); PG8_WAIT_L(0); PG8_BAR; PG8_MMA(1, 0, At, B0); PG8_MMA(1, 1, At, B1); PG8_BAR; PG8_SCHED;
            PG8_LDB(B0, 1, 0); PG8_LDB(B1, 1, 1); PG8_SCHED; PG8_LDA(At, 1, 0); PG8_STAGE(PG8_SA(0, 1), a2 + hstep, voffA);
            PG8_WAIT_V(8); PG8_WAIT_L(0); PG8_BAR; PG8_MMA(0, 0, At, B0); PG8_MMA(0, 1, At, B1); PG8_BAR; PG8_SCHED;
            PG8_LDA(At, 1, 1); PG8_STAGE(PG8_SB(1, 0), b3, voffB); PG8_STAGE(PG8_SB(1, 1), b3 + hstep, voffB); PG8_STAGE(PG8_SA(1, 0), a3, voffA);
            PG8_WAIT_V(8); PG8_WAIT_L(0); PG8_BAR; PG8_MMA(1, 0, At, B0); PG8_MMA(1, 1, At, B1); PG8_BAR; PG8_SCHED;
            } else {
            PG8_LDB(B0, 0, 0); PG8_SCHED; PG8_LDA(At, 0, 0); PG8_STAGE(PG8_SA(1, 1), a1 + hstep, voffA);
            PG8_WAIT_L(8); PG8_BAR; PG8_WAIT_L(0); PG8_MMA(0, 0, At, B0); PG8_BAR; PG8_SCHED;
            PG8_LDB(B1, 0, 1); PG8_STAGE(PG8_SB(0, 0), b2, voffB);
            PG8_BAR; PG8_WAIT_L(0); PG8_MMA(0, 1, At, B1); PG8_BAR;
            PG8_LDA(At, 0, 1); PG8_STAGE(PG8_SA(0, 0), a2, voffA);
            PG8_BAR; PG8_WAIT_L(0); PG8_MMA(1, 0, At, B0); PG8_BAR; PG8_SCHED;
            PG8_STAGE(PG8_SB(0, 1), b2 + hstep, voffB);
            PG8_WAIT_V(6); PG8_BAR; PG8_MMA(1, 1, At, B1); PG8_BAR;
            PG8_LDB(B0, 1, 0); PG8_SCHED; PG8_LDA(At, 1, 0); PG8_STAGE(PG8_SA(0, 1), a2 + hstep, voffA);
            PG8_WAIT_L(8); PG8_BAR; PG8_WAIT_L(0); PG8_MMA(0, 0, At, B0); PG8_BAR; PG8_SCHED;
            PG8_LDB(B1, 1, 1); PG8_STAGE(PG8_SB(1, 0), b3, voffB);
            PG8_BAR; PG8_WAIT_L(0); PG8_MMA(0, 1, At, B1); PG8_BAR;
            PG8_LDA(At, 1, 1); PG8_STAGE(PG8_SA(1, 0), a3, voffA);
            PG8_BAR; PG8_WAIT_L(0); PG8_MMA(1, 0, At, B0); PG8_BAR; PG8_SCHED;
            PG8_STAGE(PG8_SB(1, 1), b3 + hstep, voffB);
            PG8_WAIT_V(6); PG8_BAR; PG8_MMA(1, 1, At, B1); PG8_BAR;
            }
        }
        if constexpr (ALIGN_EPI) { if (wr == 0) PG8_BAR; }
        E(acc, cur, wr, wc, fr, fq); S.done(cur);
        if (!has_next) break;
#pragma unroll
        for (int a = 0; a < 2; ++a)
#pragma unroll
            for (int b = 0; b < 2; ++b)
#pragma unroll
                for (int m = 0; m < 4; ++m)
#pragma unroll
                    for (int n = 0; n < 2; ++n) acc[a][b][m][n] = (f32x4){0.f, 0.f, 0.f, 0.f};
        cur = nxt; cA = nA; cB = nB; ++ui;
        if constexpr (ALIGN_EPI) { if (wr == 1) PG8_BAR; }
    }
    PG8_WAIT_V(0);
    if constexpr (!ALIGN_EPI) { if (wr == 0) PG8_BAR; }
    PG8_BAR;
#undef PG8_SA
#undef PG8_SB
#undef PG8_STAGE
#undef PG8_LDA
#undef PG8_LDB
#undef PG8_MMA
#undef PG8_WAIT_V
#undef PG8_WAIT_L
#undef PG8_BAR
#undef PG8_SCHED
}
}

__device__ __forceinline__ int zsrc(int c) {
    if (c < 1024) return c;
    if (c < ZC_SK) { const int x = c - ZC_SQ, hh = x >> 6, p = x & 63, j = p >> 3, i = p & 7; return 1032 + hh * 64 + (i < 4 ? 4 * j + i : 32 + 4 * j + (i - 4)); }
    if (c < ZC_SV) { const int x = c - ZC_SK, hh = x >> 6, p = x & 63, j = p >> 3, i = p & 7; return 1544 + hh * 64 + (i < 4 ? 4 * j + i : 32 + 4 * j + (i - 4)); }
    if (c < ZC_DQ) return 1672 + (c - ZC_SV);
    if (c < ZC_DK) { const int x = c - ZC_DQ, hh = x >> 5, p = x & 31, j = p >> 3, i = p & 7; return 1800 + hh * 32 + (i < 4 ? 4 * j + i : 16 + 4 * j + (i - 4)); }
    if (c < ZC_DV) { const int x = c - ZC_DK, hh = x >> 5, p = x & 31, j = p >> 3, i = p & 7; return 2056 + hh * 32 + (i < 4 ? 4 * j + i : 16 + 4 * j + (i - 4)); }
    if (c < ZC_G) return 2312 + (c - ZC_DV);
    if (c < ZC_G + 8) return 1024 + (c - ZC_G);
    return -1;
}
template <bool MAPZ> __device__ __forceinline__ void transpose_item(const float* W, int K, int N, int Nst, const float* gk, bf16_t* WT, LAS float* scr, int item, int lane) {
    const int nblk = Nst / 32, kb = item / nblk, nb = item % nblk, k0 = 64 * kb, n0 = 32 * nb;
    const int nsrc = MAPZ ? zsrc(n0 + (lane & 31)) : (n0 + (lane & 31));
#pragma unroll 8
    for (int i = 0; i < 32; ++i) { const int kk = 2 * i + (lane >> 5); float v = 0.f; if (nsrc >= 0) v = W[(size_t)(k0 + kk) * N + nsrc]; if (gk) v *= gk[k0 + kk]; scr[kk * 33 + (lane & 31)] = v; }
    asm volatile("s_waitcnt lgkmcnt(0)" ::: "memory");
    const int c = lane & 7;
#pragma unroll
    for (int j = 0; j < 4; ++j) { const int n = (lane >> 3) + 8 * j; const LAS float* s = scr + (8 * c) * 33 + n;
        u32x4 o; o.x = pk2(s[0 * 33], s[1 * 33]); o.y = pk2(s[2 * 33], s[3 * 33]); o.z = pk2(s[4 * 33], s[5 * 33]); o.w = pk2(s[6 * 33], s[7 * 33]);
        *(u32x4*)(WT + (size_t)(n0 + n) * K + k0 + 8 * c) = o; }
    asm volatile("s_waitcnt lgkmcnt(0)" ::: "memory");
}
__device__ __forceinline__ void sincos_red(double x, float& c, float& s) {
    const double k = rint(x * 0.15915494309189535), r = x - k * 6.283185307179586, r2 = r * r;
    double sn = 1.0, cs = 1.0;
#pragma unroll
    for (int n = 14; n >= 1; --n) { sn = 1.0 - r2 * (1.0 / (double)((2 * n) * (2 * n + 1))) * sn; cs = 1.0 - r2 * (1.0 / (double)((2 * n - 1) * (2 * n))) * cs; }
    s = (float)(r * sn); c = (float)cs;
}
__device__ __forceinline__ void row_to_bf16(const float* xrow, bf16_t* orow, float* rs, int lane) {
    const f32x4* xr = (const f32x4*)xrow + lane;
    f32x4 v[4]; float s = 0.f;
#pragma unroll
    for (int j = 0; j < 4; ++j) { v[j] = xr[64 * j]; s += (v[j].x * v[j].x + v[j].y * v[j].y) + (v[j].z * v[j].z + v[j].w * v[j].w); }
    s = wave_sum(s);
    u32x2* o8 = (u32x2*)orow + lane;
#pragma unroll
    for (int j = 0; j < 4; ++j) o8[64 * j] = (u32x2){pk2(v[j].x, v[j].y), pk2(v[j].z, v[j].w)};
    if (lane == 0) *rs = 1.f / sqrtf(s * (1.f / DM) + EPS);
}
__device__ __forceinline__ void prologue(const Params& P, lds_t lds, int G) {
    const int tid = otid(), lane = tid & 63, wave = tid >> 6; unsigned char* const ws_ = optr(P.ws);
    LAS float* scr = (LAS float*)(lds + wave * 16384);
    const int gw = blockIdx.x * NWAVES + wave, NGW = G * NWAVES;
    constexpr int I_IN = (DM / 64) * (ZP / 32), I_OUT = (DM / 64) * (DM / 32), I_UP = (DM / 64) * (FF / 32), I_DN = (FF / 64) * (DM / 32), I_L = I_IN + I_OUT + I_UP + I_DN;
    for (int it = gw; it < 2 * I_L; it += NGW) {
        const int l = it / I_L; int r = it % I_L;
        unsigned char* wb = ws_ + WS_W + (size_t)l * W_LAYER;
        if (r < I_IN) { transpose_item<true>(P.in[1] + (size_t)l * DM * INW, DM, INW, ZP, P.in[16] + l * DM, (bf16_t*)(wb + W_IN), scr, r, lane); continue; } r -= I_IN;
        if (r < I_OUT) { transpose_item<false>(P.in[13] + (size_t)l * DM * DM, DM, DM, DM, nullptr, (bf16_t*)(wb + W_OUT), scr, r, lane); continue; } r -= I_OUT;
        if (r < I_UP) { transpose_item<false>(P.in[14] + (size_t)l * DM * FF, DM, FF, FF, P.in[18] + l * DM, (bf16_t*)(wb + W_UP), scr, r, lane); continue; } r -= I_UP;
        transpose_item<false>(P.in[15] + (size_t)l * FF * DM, FF, DM, DM, nullptr, (bf16_t*)(wb + W_DOWN), scr, r, lane);
    }
    f32x2* rope = (f32x2*)(ws_ + WS_ROPE);
    for (int e = blockIdx.x * NTHREADS + tid; e < SEQ * 32; e += G * NTHREADS) {
        const int pos = e >> 5, i = e & 31;
        const float inv = (float)exp(-(double)i * (9.210340371976184 / 32.0));
        const float ang = (float)pos * inv;
        float c, s; sincos_red((double)ang, c, s);
        rope[e] = (f32x2){c, s};
    }
    bf16_t* XB = (bf16_t*)(ws_ + WS_XB); float* RS = (float*)(ws_ + WS_RS);
    for (int m = gw; m < NTOK; m += NGW) row_to_bf16(P.in[0] + (size_t)m * DM, XB + (size_t)m * DM, RS + m, lane);
}

__device__ __forceinline__ void resid_pass(const Params& P, const float* base, const float* gpost, bool write_xb, int G) {
    const int tid = otid(), lane = tid & 63, wave = tid >> 6; unsigned char* const ws_ = optr(P.ws);
    const int gw = blockIdx.x * NWAVES + wave, NGW = G * NWAVES;
    const bf16_t* MIX = (const bf16_t*)(ws_ + WS_MIX); bf16_t* XB = (bf16_t*)(ws_ + WS_XB); float* RS = (float*)(ws_ + WS_RS);
    f32x4 gv[4];
#pragma unroll
    for (int j = 0; j < 4; ++j) gv[j] = ((const f32x4*)gpost)[lane + 64 * j];
    for (int m = gw; m < NTOK; m += NGW) {
        const u32x2* mr = (const u32x2*)(MIX + (size_t)m * DM) + lane;
        const f32x4* br = (const f32x4*)(base + (size_t)m * DM) + lane;
        f32x4 mv[4], bv[4]; float s = 0.f;
#pragma unroll
        for (int j = 0; j < 4; ++j) { const u32x2 w = mr[64 * j]; mv[j] = (f32x4){bflo(w.x), bfhi(w.x), bflo(w.y), bfhi(w.y)}; bv[j] = br[64 * j];
            s += (mv[j].x * mv[j].x + mv[j].y * mv[j].y) + (mv[j].z * mv[j].z + mv[j].w * mv[j].w); }
        s = wave_sum(s);
        const float r = 1.f / sqrtf(s * (1.f / DM) + EPS);
        float s2 = 0.f;
#pragma unroll
        for (int j = 0; j < 4; ++j) { bv[j] = bv[j] + mv[j] * r * gv[j]; s2 += (bv[j].x * bv[j].x + bv[j].y * bv[j].y) + (bv[j].z * bv[j].z + bv[j].w * bv[j].w); }
        f32x4* orow = (f32x4*)(P.out + (size_t)m * DM) + lane;
#pragma unroll
        for (int j = 0; j < 4; ++j) orow[64 * j] = bv[j];
        if (write_xb) {
            s2 = wave_sum(s2);
            u32x2* o8 = (u32x2*)(XB + (size_t)m * DM) + lane;
#pragma unroll
            for (int j = 0; j < 4; ++j) o8[64 * j] = (u32x2){pk2(bv[j].x, bv[j].y), pk2(bv[j].z, bv[j].w)};
            if (lane == 0) RS[m] = 1.f / sqrtf(s2 * (1.f / DM) + EPS);
        }
    }
}

__device__ __forceinline__ void mlstm_gates(const bf16_t* Z, size_t t0, int hh, float ib, float fb, LAS float* bc, LAS float* ig, int tid) {
    if (tid < 64) {
        const int lane = tid;
        const bf16_t* g0 = Z + (t0 + 2 * lane) * ZP + ZC_G; const bf16_t* g1 = g0 + ZP;
        const float i0 = bf2f(g0[hh]) + ib, i1 = bf2f(g1[hh]) + ib;
        const float l0 = logsigmoidf_(bf2f(g0[4 + hh]) + fb), l1 = logsigmoidf_(bf2f(g1[4 + hh]) + fb);
        float x = l0 + l1;
#pragma unroll
        for (int o = 1; o < 64; o <<= 1) { const float t = __shfl_up(x, o); if (lane >= o) x += t; }
        bc[2 * lane] = x - l1; bc[2 * lane + 1] = x; ig[2 * lane] = i0; ig[2 * lane + 1] = i1;
    }
}
__device__ __forceinline__ void conv8(const bf16_t* zp, int tseq, const float* cw, const float* cb, int ch, float scale, float (&y)[8]) {
    const f32x4 b0 = *(const f32x4*)(cb + ch), b1 = *(const f32x4*)(cb + ch + 4);
    y[0] = b0[0]; y[1] = b0[1]; y[2] = b0[2]; y[3] = b0[3]; y[4] = b1[0]; y[5] = b1[1]; y[6] = b1[2]; y[7] = b1[3];
#pragma unroll
    for (int j = 0; j < 4; ++j) {
        if (tseq - 3 + j >= 0) {
            const u32x4 w = *(const u32x4*)(zp - (size_t)(3 - j) * ZP);
            const f32x4 c0 = *(const f32x4*)(cw + j * 512 + ch), c1 = *(const f32x4*)(cw + j * 512 + ch + 4);
            y[0] += bflo(w.x) * c0[0]; y[1] += bfhi(w.x) * c0[1]; y[2] += bflo(w.y) * c0[2]; y[3] += bfhi(w.y) * c0[3];
            y[4] += bflo(w.z) * c1[0]; y[5] += bfhi(w.z) * c1[1]; y[6] += bflo(w.w) * c1[2]; y[7] += bfhi(w.w) * c1[3];
        }
    }
#pragma unroll
    for (int i = 0; i < 8; ++i) y[i] = y[i] * sigmoidf_(y[i]) * scale;
}
constexpr int TS128 = 264;
constexpr int RS64 = 144;
__device__ __forceinline__ void mlstm_a_item(const Params& P, int l, int item, lds_t lds) {
    const int tid = otid(), lane = tid & 63, w = tid >> 6, r = lane & 31, h = lane >> 5; unsigned char* const ws_ = optr(P.ws);
    const int c = item & 63, hh = (item >> 6) & 3, b = item >> 8;
    const size_t t0 = (size_t)b * SEQ + (size_t)c * 128;
    const bf16_t* Z = (const bf16_t*)(ws_ + WS_ZB);
    const float* cw = P.in[2] + l * 4 * 512; const float* cb = P.in[3] + l * 512;
    lds_t KT = lds, VT = lds + 64 * TS128; LAS float* bc = (LAS float*)(lds + 2 * 64 * TS128); LAS float* ig = bc + 128; LAS float* wst = ig + 128;
    mlstm_gates(Z, t0, hh, P.in[4][l * 4 + hh], P.in[5][l * 4 + hh], bc, ig, tid);
    __syncthreads();
    const float blast = bc[127];
    if (tid < 128) wst[tid] = __expf(blast - bc[tid] + ig[tid]);
    __syncthreads();
#pragma unroll
    for (int q = 0; q < 2; ++q) {
        const int e = tid + q * 512, s = e >> 3, ch = e & 7;
        float y[8];
        conv8(Z + (t0 + s) * ZP + ZC_MK + hh * 64 + 8 * ch, c * 128 + s, cw, cb, 256 + hh * 64 + 8 * ch, 0.125f, y);
#pragma unroll
        for (int i = 0; i < 8; ++i) *(LAS bf16_t*)(KT + (8 * ch + i) * TS128 + s * 2) = f2bf(y[i]);
        const u32x4 vw = *(const u32x4*)(Z + (t0 + s) * ZP + ZC_MV + hh * 64 + 8 * ch);
        const float ws_ = wst[s];
        const float vv[8] = {bflo(vw.x), bfhi(vw.x), bflo(vw.y), bfhi(vw.y), bflo(vw.z), bfhi(vw.z), bflo(vw.w), bfhi(vw.w)};
#pragma unroll
        for (int i = 0; i < 8; ++i) *(LAS bf16_t*)(VT + (8 * ch + i) * TS128 + s * 2) = f2bf(vv[i] * ws_);
    }
    __syncthreads();
    float* DC = (float*)(ws_ + WS_DC) + (size_t)item * 4096; float* DN = (float*)(ws_ + WS_DN) + (size_t)item * 64; float* DEC = (float*)(ws_ + WS_DEC);
    if (w < 4) {
        const int vt = w >> 1, kt = w & 1;
        f32x16 acc = {};
#pragma unroll
        for (int ks = 0; ks < 8; ++ks) {
            const bf16x8 a = lds16(VT + (32 * vt + r) * TS128 + (16 * ks + 8 * h) * 2);
            const bf16x8 bb = lds16(KT + (32 * kt + r) * TS128 + (16 * ks + 8 * h) * 2);
            acc = MFMA32(a, bb, acc);
        }
#pragma unroll
        for (int i = 0; i < 16; ++i) DC[(32 * vt + crow(i, h)) * 64 + 32 * kt + r] = acc[i];
    } else if (w == 4) {
        float sum = 0.f;
#pragma unroll 4
        for (int s8 = 0; s8 < 16; ++s8) {
            const u32x4 kw = *(const LAS u32x4*)(KT + lane * TS128 + s8 * 16);
            const f32x4 w0 = *(const LAS f32x4*)(wst + 8 * s8), w1 = *(const LAS f32x4*)(wst + 8 * s8 + 4);
            sum += bflo(kw.x) * w0[0] + bfhi(kw.x) * w0[1] + bflo(kw.y) * w0[2] + bfhi(kw.y) * w0[3] + bflo(kw.z) * w1[0] + bfhi(kw.z) * w1[1] + bflo(kw.w) * w1[2] + bfhi(kw.w) * w1[3];
        }
        DN[lane] = sum;
    } else if (w == 5 && lane == 0) DEC[item] = __expf(blast);
    __syncthreads();
}
__device__ __forceinline__ void mlstm_scan(const Params& P, int G) {
    unsigned char* const ws_ = optr(P.ws); const int tid = otid();
    const float* DC = (const float*)(ws_ + WS_DC); const float* DN = (const float*)(ws_ + WS_DN); const float* DEC = (const float*)(ws_ + WS_DEC);
    bf16_t* CS = (bf16_t*)(ws_ + WS_CS); float* NS = (float*)(ws_ + WS_NS);
    for (int ch = blockIdx.x * NTHREADS + tid; ch < 32 * 4160; ch += G * NTHREADS) {
        const int seq = ch / 4160, e = ch % 4160;
        float st = 0.f;
        if (e < 4096) {
#pragma unroll 8
            for (int c = 0; c < 64; ++c) { const int it = seq * 64 + c; CS[(size_t)it * 4096 + e] = f2bf(st); st = DEC[it] * st + DC[(size_t)it * 4096 + e]; }
        } else {
            const int k = e - 4096;
#pragma unroll 8
            for (int c = 0; c < 64; ++c) { const int it = seq * 64 + c; NS[it * 64 + k] = st; st = DEC[it] * st + DN[it * 64 + k]; }
        }
    }
}
__device__ __forceinline__ void mlstm_c_item(const Params& P, int l, int item, lds_t lds) {
    const int tid = otid(), lane = tid & 63, w = tid >> 6, r = lane & 31, h = lane >> 5; unsigned char* const ws_ = optr(P.ws);
    const int c = item & 63, hh = (item >> 6) & 3, b = item >> 8;
    const size_t t0 = (size_t)b * SEQ + (size_t)c * 128;
    const bf16_t* Z = (const bf16_t*)(ws_ + WS_ZB);
    const float* cw = P.in[2] + l * 4 * 512; const float* cb = P.in[3] + l * 512;
    lds_t Qs = lds, Ks = Qs + 128 * RS64, VT = Ks + 128 * RS64, Cs = VT + 64 * TS128, Hs = Cs + 64 * RS64;
    LAS float* bc = (LAS float*)(Hs + 128 * RS64); LAS float* ig = bc + 128; LAS float* ns = ig + 128;
    mlstm_gates(Z, t0, hh, P.in[4][l * 4 + hh], P.in[5][l * 4 + hh], bc, ig, tid);
#pragma unroll
    for (int q = 0; q < 2; ++q) {
        const int e = tid + q * 512, s = e >> 3, ch = e & 7;
        float y[8];
        conv8(Z + (t0 + s) * ZP + ZC_MQ + hh * 64 + 8 * ch, c * 128 + s, cw, cb, hh * 64 + 8 * ch, 1.f, y);
        *(LAS u32x4*)(Qs + s * RS64 + ch * 16) = (u32x4){pk2(y[0], y[1]), pk2(y[2], y[3]), pk2(y[4], y[5]), pk2(y[6], y[7])};
        conv8(Z + (t0 + s) * ZP + ZC_MK + hh * 64 + 8 * ch, c * 128 + s, cw, cb, 256 + hh * 64 + 8 * ch, 0.125f, y);
        *(LAS u32x4*)(Ks + s * RS64 + ch * 16) = (u32x4){pk2(y[0], y[1]), pk2(y[2], y[3]), pk2(y[4], y[5]), pk2(y[6], y[7])};
        const u32x4 vw = *(const u32x4*)(Z + (t0 + s) * ZP + ZC_MV + hh * 64 + 8 * ch);
        const unsigned vv[4] = {vw.x, vw.y, vw.z, vw.w};
#pragma unroll
        for (int i = 0; i < 4; ++i) { *(LAS bf16_t*)(VT + (8 * ch + 2 * i) * TS128 + s * 2) = (bf16_t)(vv[i] & 0xffffu); *(LAS bf16_t*)(VT + (8 * ch + 2 * i + 1) * TS128 + s * 2) = (bf16_t)(vv[i] >> 16); }
    }
    { const int v = tid >> 3, ch = tid & 7; *(LAS u32x4*)(Cs + v * RS64 + ch * 16) = *(const u32x4*)((const bf16_t*)(ws_ + WS_CS) + (size_t)item * 4096 + v * 64 + ch * 8); }
    if (tid < 64) ns[tid] = ((const float*)(ws_ + WS_NS))[item * 64 + tid];
    __syncthreads();
    if (w < 4) {
        const int tt = w, tl = 32 * tt + r;
        bf16x8 qf[4];
#pragma unroll
        for (int ks = 0; ks < 4; ++ks) qf[ks] = lds16(Qs + tl * RS64 + (16 * ks + 8 * h) * 2);
        f32x16 num[2] = {};
#pragma unroll
        for (int vt = 0; vt < 2; ++vt)
#pragma unroll
            for (int ks = 0; ks < 4; ++ks) num[vt] = MFMA32(lds16(Cs + (32 * vt + r) * RS64 + (16 * ks + 8 * h) * 2), qf[ks], num[vt]);
        float nq = 0.f;
#pragma unroll
        for (int ks = 0; ks < 4; ++ks) {
            const u32x4 qw = __builtin_bit_cast(u32x4, qf[ks]);
            const f32x4 n0 = *(const LAS f32x4*)(ns + 16 * ks + 8 * h), n1 = *(const LAS f32x4*)(ns + 16 * ks + 8 * h + 4);
            nq += bflo(qw.x) * n0[0] + bfhi(qw.x) * n0[1] + bflo(qw.y) * n0[2] + bfhi(qw.y) * n0[3] + bflo(qw.z) * n1[0] + bfhi(qw.z) * n1[1] + bflo(qw.w) * n1[2] + bfhi(qw.w) * n1[3];
        }
        nq = swap_add(nq);
        const float bt = bc[tl], eb = __expf(bt);
#pragma unroll
        for (int vt = 0; vt < 2; ++vt)
#pragma unroll
            for (int i = 0; i < 16; ++i) num[vt][i] *= eb;
        float den = 0.f;
        for (int st = 0; st <= tt; ++st) {
            f32x16 S = {};
#pragma unroll
            for (int ks = 0; ks < 4; ++ks) S = MFMA32(lds16(Ks + (32 * st + r) * RS64 + (16 * ks + 8 * h) * 2), qf[ks], S);
#pragma unroll
            for (int i = 0; i < 16; ++i) { const int s = 32 * st + crow(i, h); const float wgt = (s <= tl) ? __expf(bt - bc[s] + ig[s]) : 0.f; S[i] *= wgt; den += S[i]; }
#pragma unroll
            for (int s2 = 0; s2 < 2; ++s2) { const bf16x8 pf = pack8(S, s2);
#pragma unroll
                for (int vt = 0; vt < 2; ++vt) { lds_t vp = VT + (32 * vt + r) * TS128 + (32 * st + 16 * s2 + 4 * h) * 2; num[vt] = MFMA32(lds8x2(vp, vp + 16), pf, num[vt]); } }
        }
        den = swap_add(den) + eb * nq;
        const float dinv = 1.f / fmaxf(fabsf(den), 1.f);
        float ss = 0.f;
#pragma unroll
        for (int vt = 0; vt < 2; ++vt)
#pragma unroll
            for (int i = 0; i < 16; ++i) { num[vt][i] *= dinv; ss += num[vt][i] * num[vt][i]; }
        ss = swap_add(ss);
        const float rn = 1.f / sqrtf(ss * (1.f / 64.f) + EPS);
#pragma unroll
        for (int vt = 0; vt < 2; ++vt)
#pragma unroll
            for (int i = 0; i < 16; ++i) *(LAS bf16_t*)(Hs + tl * RS64 + (32 * vt + crow(i, h)) * 2) = f2bf(num[vt][i] * rn);
    }
    __syncthreads();
    bf16_t* CAT = (bf16_t*)(ws_ + WS_CAT);
    const float* mg = P.in[6] + l * 256 + hh * 64;
#pragma unroll
    for (int q = 0; q < 2; ++q) {
        const int e = tid + q * 512, t = e >> 3, ch = e & 7;
        const u32x4 hw = *(const LAS u32x4*)(Hs + t * RS64 + ch * 16);
        const u32x4 ow = *(const u32x4*)(Z + (t0 + t) * ZP + ZC_MO + hh * 64 + 8 * ch);
        const f32x4 g0 = *(const f32x4*)(mg + 8 * ch), g1 = *(const f32x4*)(mg + 8 * ch + 4);
        u32x4 o;
        o.x = pk2(bflo(hw.x) * g0[0] * sigmoidf_(bflo(ow.x)), bfhi(hw.x) * g0[1] * sigmoidf_(bfhi(ow.x)));
        o.y = pk2(bflo(hw.y) * g0[2] * sigmoidf_(bflo(ow.y)), bfhi(hw.y) * g0[3] * sigmoidf_(bfhi(ow.y)));
        o.z = pk2(bflo(hw.z) * g1[0] * sigmoidf_(bflo(ow.z)), bfhi(hw.z) * g1[1] * sigmoidf_(bfhi(ow.z)));
        o.w = pk2(bflo(hw.w) * g1[2] * sigmoidf_(bflo(ow.w)), bfhi(hw.w) * g1[3] * sigmoidf_(bfhi(ow.w)));
        *(u32x4*)(CAT + (t0 + t) * DM + hh * 64 + 8 * ch) = o;
    }
    __syncthreads();
}

constexpr int TS256 = 520;
__device__ __forceinline__ void swa_item(const Params& P, int l, int item, lds_t lds) {
    const int tid = otid(), lane = tid & 63, w = tid >> 6, r = lane & 31, h = lane >> 5; unsigned char* const ws_ = optr(P.ws);
    const int kvh = item & 1, nb = (item >> 1) & 63, b = item >> 7;
    const size_t t0 = (size_t)b * SEQ + (size_t)nb * 128;
    const bf16_t* Z = (const bf16_t*)(ws_ + WS_ZB);
    lds_t Ks = lds, VT = lds + 256 * RS64, Os = VT + 64 * TS256;
#pragma unroll
    for (int q = 0; q < 4; ++q) {
        const int e = tid + q * 512, kb = e >> 3, ch = e & 7;
        u32x4 kw = {0u, 0u, 0u, 0u}, vw = {0u, 0u, 0u, 0u};
        if (nb > 0 || kb >= 128) { const bf16_t* zr = Z + (t0 - 128 + kb) * ZP; kw = *(const u32x4*)(zr + ZC_SK + kvh * 64 + 8 * ch); vw = *(const u32x4*)(zr + ZC_SV + kvh * 64 + 8 * ch); }
        *(LAS u32x4*)(Ks + kb * RS64 + ch * 16) = kw;
        const unsigned vv[4] = {vw.x, vw.y, vw.z, vw.w};
#pragma unroll
        for (int i = 0; i < 4; ++i) { *(LAS bf16_t*)(VT + (8 * ch + 2 * i) * TS256 + kb * 2) = (bf16_t)(vv[i] & 0xffffu); *(LAS bf16_t*)(VT + (8 * ch + 2 * i + 1) * TS256 + kb * 2) = (bf16_t)(vv[i] >> 16); }
    }
    __syncthreads();
    bf16_t* CAT = (bf16_t*)(ws_ + WS_CAT);
    lds_t Ow = Os + w * 32 * RS64;
    for (int cc = w; cc < 16; cc += 8) {
        const int hq = cc >> 2, qt = cc & 3, hg = kvh * 4 + hq, ql = 32 * qt + r;
        const float sink = P.in[7][l * 8 + hg];
        const bf16_t* qp = Z + (t0 + ql) * ZP + ZC_SQ + hg * 64;
        bf16x8 qf[4];
#pragma unroll
        for (int ks = 0; ks < 4; ++ks) qf[ks] = *(const bf16x8*)(qp + 16 * ks + 8 * h);
        f32x16 S[5];
        float mx = sink;
#pragma unroll
        for (int k5 = 0; k5 < 5; ++k5) {
            const int kt = qt + k5;
            S[k5] = (f32x16){};
#pragma unroll
            for (int ks = 0; ks < 4; ++ks) S[k5] = MFMA32(lds16(Ks + (32 * kt + r) * RS64 + (16 * ks + 8 * h) * 2), qf[ks], S[k5]);
#pragma unroll
            for (int i = 0; i < 16; ++i) { const int kb = 32 * kt + crow(i, h); const bool ok = (kb > ql) && (kb <= ql + 128) && (nb > 0 || kb >= 128);
                S[k5][i] = ok ? S[k5][i] * 0.125f : -1e30f; mx = fmaxf(mx, S[k5][i]); }
        }
        mx = swap_max(mx);
        float sum = 0.f;
#pragma unroll
        for (int k5 = 0; k5 < 5; ++k5)
#pragma unroll
            for (int i = 0; i < 16; ++i) { S[k5][i] = __expf(S[k5][i] - mx); sum += S[k5][i]; }
        sum = swap_add(sum) + __expf(sink - mx);
        const float inv = 1.f / sum;
        f32x16 O[2] = {};
#pragma unroll
        for (int k5 = 0; k5 < 5; ++k5) {
            const int kt = qt + k5;
#pragma unroll
            for (int i = 0; i < 16; ++i) S[k5][i] *= inv;
#pragma unroll
            for (int s2 = 0; s2 < 2; ++s2) { const bf16x8 pf = pack8(S[k5], s2);
#pragma unroll
                for (int dt = 0; dt < 2; ++dt) { lds_t vp = VT + (32 * dt + r) * TS256 + (32 * kt + 16 * s2 + 4 * h) * 2; O[dt] = MFMA32(lds8x2(vp, vp + 16), pf, O[dt]); } }
        }
#pragma unroll
        for (int dt = 0; dt < 2; ++dt)
#pragma unroll
            for (int i = 0; i < 16; ++i) *(LAS bf16_t*)(Ow + r * RS64 + (32 * dt + crow(i, h)) * 2) = f2bf(O[dt][i]);
        asm volatile("s_waitcnt lgkmcnt(0)" ::: "memory");
#pragma unroll
        for (int it = 0; it < 4; ++it) { const int row = it * 8 + (lane >> 3), ch = lane & 7; const u32x4 v = *(const LAS u32x4*)(Ow + row * RS64 + ch * 16);
            *(u32x4*)(CAT + (t0 + 32 * qt + row) * DM + 256 + hg * 64 + 8 * ch) = v; }
        asm volatile("s_waitcnt lgkmcnt(0)" ::: "memory");
    }
    __syncthreads();
}

constexpr int DK_BYTES = 64 * RS64;
constexpr int TS64 = 136;
constexpr int DV_BYTES = 64 * TS64;
constexpr int DBUF = DK_BYTES + DV_BYTES;
__device__ __forceinline__ void diff_item(const Params& P, int l, int seq, int qb, lds_t lds, float lam, float oscale) {
    const int tid = otid(), lane = tid & 63, w = tid >> 6, r = lane & 31, h = lane >> 5; unsigned char* const ws_ = optr(P.ws);
    const int b = seq >> 2, hd = seq & 3;
    const size_t row0 = (size_t)b * SEQ;
    const bf16_t* Z = (const bf16_t*)(ws_ + WS_ZB);
    const int qrow = qb * 256 + w * 32 + r, wmin = qb * 256 + w * 32;
    const bf16_t* qp = Z + (row0 + qrow) * ZP + ZC_DQ + hd * 64;
    bf16x8 qf[2][2];
#pragma unroll
    for (int m = 0; m < 2; ++m)
#pragma unroll
        for (int ks = 0; ks < 2; ++ks) qf[m][ks] = *(const bf16x8*)(qp + 32 * m + 16 * ks + 8 * h);
    f32x16 O[2][2] = {};
    float mx[2] = {-1e30f, -1e30f}, ls[2] = {0.f, 0.f};
    const int NT = 4 * qb + 4;
    constexpr float C = 0.17677669529663687f * 1.4426950408889634f;
    const int skey = tid >> 3, sch = tid & 7;
    const bf16_t* kg = Z + (row0 + skey) * ZP + ZC_DK + hd * 64 + 8 * sch; const bf16_t* vg = Z + (row0 + skey) * ZP + ZC_DV + hd * 64 + 8 * sch;
    lds_t Os = lds + 2 * DBUF;
    u32x4 kreg = *(const u32x4*)kg, vreg = *(const u32x4*)vg;
    auto stage_write = [&](int buf) {
        lds_t Kb = lds + buf * DBUF, Vb = Kb + DK_BYTES;
        *(LAS u32x4*)(Kb + skey * RS64 + sch * 16) = kreg;
        const unsigned vv[4] = {vreg.x, vreg.y, vreg.z, vreg.w};
#pragma unroll
        for (int i = 0; i < 4; ++i) { *(LAS bf16_t*)(Vb + (8 * sch + 2 * i) * TS64 + skey * 2) = (bf16_t)(vv[i] & 0xffffu); *(LAS bf16_t*)(Vb + (8 * sch + 2 * i + 1) * TS64 + skey * 2) = (bf16_t)(vv[i] >> 16); }
    };
    stage_write(0);
    __syncthreads();
    for (int kt = 0; kt < NT; ++kt) {
        if (kt + 1 < NT) { kreg = *(const u32x4*)(kg + (size_t)(kt + 1) * 64 * ZP); vreg = *(const u32x4*)(vg + (size_t)(kt + 1) * 64 * ZP); }
        if (64 * kt <= wmin + 31) {
            lds_t Kb = lds + (kt & 1) * DBUF, Vb = Kb + DK_BYTES;
            const bool needmask = (64 * kt + 63 > wmin);
            f32x16 S[2][2];
#pragma unroll
            for (int m = 0; m < 2; ++m)
#pragma unroll
                for (int kh = 0; kh < 2; ++kh) { S[m][kh] = (f32x16){};
#pragma unroll
                    for (int ks = 0; ks < 2; ++ks) S[m][kh] = MFMA32(lds16(Kb + (32 * kh + r) * RS64 + (32 * m + 16 * ks + 8 * h) * 2), qf[m][ks], S[m][kh]); }
            if (needmask) {
#pragma unroll
                for (int kh = 0; kh < 2; ++kh)
#pragma unroll
                    for (int i = 0; i < 16; ++i) { const int key = 64 * kt + 32 * kh + crow(i, h); if (key > qrow) { S[0][kh][i] = -1e30f; S[1][kh][i] = -1e30f; } }
            }
            bf16x8 pf[2][2][2];
#pragma unroll
            for (int m = 0; m < 2; ++m) {
                float tm = S[m][0][0];
#pragma unroll
                for (int kh = 0; kh < 2; ++kh)
#pragma unroll
                    for (int i = 0; i < 16; ++i) tm = fmaxf(tm, S[m][kh][i]);
                const float mnew = fmaxf(mx[m], swap_max(tm));
                if (__any(mnew > mx[m])) {
                    const float alpha = __builtin_amdgcn_exp2f((mx[m] - mnew) * C);
                    ls[m] *= alpha;
#pragma unroll
                    for (int dt = 0; dt < 2; ++dt)
#pragma unroll
                        for (int i = 0; i < 16; ++i) O[m][dt][i] *= alpha;
                    mx[m] = mnew;
                }
                const float nb = -mx[m] * C;
                float sum = 0.f;
#pragma unroll
                for (int kh = 0; kh < 2; ++kh)
#pragma unroll
                    for (int i = 0; i < 16; ++i) { const float p = __builtin_amdgcn_exp2f(fmaf(S[m][kh][i], C, nb)); S[m][kh][i] = p; sum += p; }
                ls[m] += sum;
#pragma unroll
                for (int kh = 0; kh < 2; ++kh)
#pragma unroll
                    for (int s2 = 0; s2 < 2; ++s2) pf[m][kh][s2] = pack8(S[m][kh], s2);
            }
#pragma unroll
            for (int dt = 0; dt < 2; ++dt)
#pragma unroll
                for (int kh = 0; kh < 2; ++kh)
#pragma unroll
                    for (int s2 = 0; s2 < 2; ++s2) { lds_t vp = Vb + (32 * dt + r) * TS64 + (32 * kh + 16 * s2 + 4 * h) * 2; const bf16x8 vf = lds8x2(vp, vp + 16);
                        O[0][dt] = MFMA32(vf, pf[0][kh][s2], O[0][dt]); O[1][dt] = MFMA32(vf, pf[1][kh][s2], O[1][dt]); }
        }
        if (kt + 1 < NT) stage_write((kt + 1) & 1);
        __syncthreads();
    }
    const float i1 = 1.f / swap_add(ls[0]), i2 = lam / swap_add(ls[1]);
    float ss = 0.f;
#pragma unroll
    for (int dt = 0; dt < 2; ++dt)
#pragma unroll
        for (int i = 0; i < 16; ++i) { const float o = O[0][dt][i] * i1 - O[1][dt][i] * i2; O[0][dt][i] = o; ss += o * o; }
    ss = swap_add(ss);
    const float rn = oscale / sqrtf(ss * (1.f / 64.f) + EPS);
    lds_t Ow = Os + w * 32 * RS64;
#pragma unroll
    for (int dt = 0; dt < 2; ++dt)
#pragma unroll
        for (int i = 0; i < 16; ++i) *(LAS bf16_t*)(Ow + r * RS64 + (32 * dt + crow(i, h)) * 2) = f2bf(O[0][dt][i] * rn);
    asm volatile("s_waitcnt lgkmcnt(0)" ::: "memory");
    bf16_t* CAT = (bf16_t*)(ws_ + WS_CAT);
    const float* sg = P.in[12] + l * 64;
#pragma unroll
    for (int it = 0; it < 4; ++it) { const int row = it * 8 + (lane >> 3), ch = lane & 7; const u32x4 v = *(const LAS u32x4*)(Ow + row * RS64 + ch * 16);
        const f32x4 g0 = *(const f32x4*)(sg + 8 * ch), g1 = *(const f32x4*)(sg + 8 * ch + 4);
        u32x4 o; o.x = pk2(bflo(v.x) * g0[0], bfhi(v.x) * g0[1]); o.y = pk2(bflo(v.y) * g0[2], bfhi(v.y) * g0[3]); o.z = pk2(bflo(v.z) * g1[0], bfhi(v.z) * g1[1]); o.w = pk2(bflo(v.w) * g1[2], bfhi(v.w) * g1[3]);
        *(u32x4*)(CAT + (row0 + wmin + row) * DM + 768 + hd * 64 + 8 * ch) = o; }
    __syncthreads();
}

constexpr int N_PHASES = 19;
__global__ void __launch_bounds__(NTHREADS, 2) hybrid_fwd(Params P) {
    extern __shared__ __attribute__((aligned(16))) unsigned char lds_raw[];
    lds_t lds = (lds_t)lds_raw;
    cg::grid_group grid = cg::this_grid();
    const int G = gridDim.x, lo = P.ph_lo, hi = P.ph_hi;
    int ph = 0;
#define PHASE_BEGIN(k) if (((PH_MASK >> (k)) & 1) && lo <= ph && ph < hi) {
#define PHASE_END   if (ph + 1 < hi) grid.sync(); } ++ph;
    PHASE_BEGIN(0) prologue(P, lds, G); PHASE_END
    for (int l = 0; l < 2; ++l) {
        unsigned char* wb = P.ws + WS_W + (size_t)l * W_LAYER;
        bf16_t* XB = (bf16_t*)(P.ws + WS_XB); float* RS = (float*)(P.ws + WS_RS);
        PHASE_BEGIN(1) {
            pg8::Gemm g{XB, (const bf16_t*)(wb + W_IN), NTOK, ZP, DM}; pg8::StaticOrder S; S.init(NTOK, ZP, G, (int)blockIdx.x);
            pg8::EpiInProj E{(bf16_t*)(P.ws + WS_ZB), RS, (const f32x2*)(P.ws + WS_ROPE)};
            pg8::gemm_phase<pg8::EpiInProj, pg8::StaticOrder, true, true>(lds, g, S, E);
        } PHASE_END
        PHASE_BEGIN(2) {
            for (int it = blockIdx.x; it < 2048; it += G) mlstm_a_item(P, l, it, lds);
            for (int it = blockIdx.x; it < 1024; it += G) swa_item(P, l, it, lds);
        } PHASE_END
        PHASE_BEGIN(3) {
            mlstm_scan(P, G);
            float d1 = 0.f, d2 = 0.f;
            for (int i = 0; i < 32; ++i) { d1 += P.in[8][l * 32 + i] * P.in[9][l * 32 + i]; d2 += P.in[10][l * 32 + i] * P.in[11][l * 32 + i]; }
            const float lam_init = 0.8f - 0.6f * expf(-0.3f * (float)l);
            const float lam = expf(d1) - expf(d2) + lam_init;
            for (int vg = blockIdx.x; vg < 256; vg += G) {
                const int seq = vg >> 3, j = vg & 7;
                diff_item(P, l, seq, 31 - j, lds, lam, 1.f - lam_init);
                diff_item(P, l, seq, 16 + j, lds, lam, 1.f - lam_init);
                diff_item(P, l, seq, 15 - j, lds, lam, 1.f - lam_init);
                diff_item(P, l, seq, j, lds, lam, 1.f - lam_init);
            }
        } PHASE_END
        PHASE_BEGIN(4) {
            for (int it = blockIdx.x; it < 2048; it += G) mlstm_c_item(P, l, it, lds);
        } PHASE_END
        PHASE_BEGIN(5) {
            pg8::Gemm g{(const bf16_t*)(P.ws + WS_CAT), (const bf16_t*)(wb + W_OUT), NTOK, DM, DM}; pg8::StaticOrder S; S.init(NTOK, DM, G, (int)blockIdx.x);
            pg8::EpiRow<0> E{(bf16_t*)(P.ws + WS_MIX), DM, nullptr};
            pg8::gemm_phase<pg8::EpiRow<0>, pg8::StaticOrder, true, true>(lds, g, S, E);
        } PHASE_END
        PHASE_BEGIN(6) resid_pass(P, l == 0 ? P.in[0] : P.out, P.in[17] + l * DM, true, G); PHASE_END
        PHASE_BEGIN(7) {
            pg8::Gemm g{XB, (const bf16_t*)(wb + W_UP), NTOK, FF, DM}; pg8::StaticOrder S; S.init(NTOK, FF, G, (int)blockIdx.x);
            pg8::EpiRow<1> E{(bf16_t*)(P.ws + WS_U), FF, RS};
            pg8::gemm_phase<pg8::EpiRow<1>, pg8::StaticOrder, true, true>(lds, g, S, E);
        } PHASE_END
        PHASE_BEGIN(8) {
            pg8::Gemm g{(const bf16_t*)(P.ws + WS_U), (const bf16_t*)(wb + W_DOWN), NTOK, DM, FF}; pg8::StaticOrder S; S.init(NTOK, DM, G, (int)blockIdx.x);
            pg8::EpiRow<0> E{(bf16_t*)(P.ws + WS_MIX), DM, nullptr};
            pg8::gemm_phase<pg8::EpiRow<0>, pg8::StaticOrder, true, true>(lds, g, S, E);
        } PHASE_END
        PHASE_BEGIN(9) resid_pass(P, P.out, P.in[19] + l * DM, l == 0, G); PHASE_END
    }
#undef PHASE_BEGIN
#undef PHASE_END
}

extern "C" void kernel_launch(void* const* d_in, const int* in_sizes, int n_in, void* d_out, int out_size, void* d_ws, size_t ws_size, hipStream_t stream) {
    static int grid = 0;
    if (grid == 0) {
        if (n_in != 20 || out_size != NTOK * DM || ws_size < WS_END) { fprintf(stderr, "kernel_launch: unexpected shapes (n_in %d out %d ws %zu)\n", n_in, out_size, ws_size); grid = -1; return; }
        int dev = 0, cus = 0, per_cu = 0;
        hipGetDevice(&dev); hipDeviceGetAttribute(&cus, hipDeviceAttributeMultiprocessorCount, dev);
        if (hipFuncSetAttribute((const void*)hybrid_fwd, hipFuncAttributeMaxDynamicSharedMemorySize, LDS_BYTES) != hipSuccess) { fprintf(stderr, "kernel_launch: hipFuncSetAttribute failed\n"); grid = -1; return; }
        if (hipOccupancyMaxActiveBlocksPerMultiprocessor(&per_cu, (const void*)hybrid_fwd, NTHREADS, LDS_BYTES) != hipSuccess || per_cu < 1) { fprintf(stderr, "kernel_launch: occupancy query says %d\n", per_cu); per_cu = 1; }
        (void)hipGetLastError();
        grid = cus;
    }
    if (grid < 0) return;
    Params p{};
    for (int i = 0; i < 20; ++i) p.in[i] = (const float*)d_in[i];
    p.out = (float*)d_out; p.ws = (unsigned char*)d_ws;
#if ONE_LAUNCH
    p.ph_lo = 0; p.ph_hi = N_PHASES;
    void* args[] = {&p};
    hipError_t e = hipLaunchCooperativeKernel((const void*)hybrid_fwd, dim3(grid), dim3(NTHREADS), args, LDS_BYTES, stream);
    if (e != hipSuccess) fprintf(stderr, "cooperative launch failed: %s (grid %d)\n", hipGetErrorString(e), grid);
#else
    for (int ph = 0; ph < N_PHASES; ++ph) {
        p.ph_lo = ph; p.ph_hi = ph + 1;
        hipLaunchKernelGGL(hybrid_fwd, dim3(grid), dim3(NTHREADS), LDS_BYTES, stream, p);
    }
#endif
}
```

```cpp
#include <hip/hip_runtime.h>
#include <hip/hip_cooperative_groups.h>
#include <cstdio>
#include <cstdint>
namespace cg = cooperative_groups;

#ifndef PH_MASK
#define PH_MASK 0x3ff
#endif
#ifndef REP_MASK
#define REP_MASK 0
#endif
#ifndef ONE_LAUNCH
#define ONE_LAUNCH 1
#endif

#define LAS __attribute__((address_space(3)))
typedef unsigned short bf16_t;
typedef short bf16x8 __attribute__((ext_vector_type(8)));
typedef short s16x4 __attribute__((ext_vector_type(4)));
typedef float f32x4 __attribute__((ext_vector_type(4)));
typedef float f32x2 __attribute__((ext_vector_type(2)));
typedef float f32x16 __attribute__((ext_vector_type(16)));
typedef unsigned u32x4 __attribute__((ext_vector_type(4)));
typedef unsigned u32x2 __attribute__((ext_vector_type(2)));
typedef __bf16 bf16x2_t __attribute__((ext_vector_type(2)));
typedef LAS unsigned char* lds_t;

constexpr int BATCH = 8, SEQ = 8192, DM = 1024, FF = 4096, NTOK = BATCH * SEQ;
constexpr int INW = 2568, ZP = 2816;
constexpr int ZC_MQ = 0, ZC_MK = 256, ZC_MV = 512, ZC_MO = 768, ZC_SQ = 1024, ZC_SK = 1536, ZC_SV = 1664, ZC_DQ = 1792, ZC_DK = 2048, ZC_DV = 2304, ZC_G = 2560;
constexpr float EPS = 1e-6f;
constexpr int NWAVES = 8, NTHREADS = 512;

constexpr size_t MiB = 1u << 20;
constexpr size_t WS_W = 2 * MiB;
constexpr size_t W_LAYER = 24 * MiB, W_IN = 0, W_OUT = 6 * MiB, W_UP = 8 * MiB, W_DOWN = 16 * MiB;
constexpr size_t WS_ROPE = 50 * MiB;
constexpr size_t WS_RS = 52 * MiB;
constexpr size_t WS_XB = 54 * MiB;
constexpr size_t WS_MIX = 182 * MiB;
constexpr size_t WS_U = 310 * MiB;
constexpr size_t WS_ZB = 310 * MiB;
constexpr size_t WS_CAT = 662 * MiB;
constexpr size_t WS_DC = 822 * MiB;
constexpr size_t WS_DN = 854 * MiB;
constexpr size_t WS_DEC = 855 * MiB;
constexpr size_t WS_CS = 856 * MiB;
constexpr size_t WS_NS = 872 * MiB;
constexpr size_t WS_END = 874 * MiB;

constexpr int LDS_BYTES = 147456;

struct Params {
    const float* in[20];
    float* out;
    unsigned char* ws;
    int ph_lo, ph_hi;
};

__device__ __forceinline__ unsigned pk2(float lo, float hi) { f32x2 v = {lo, hi}; bf16x2_t b = __builtin_convertvector(v, bf16x2_t); return __builtin_bit_cast(unsigned, b); }
__device__ __forceinline__ bf16_t f2bf(float f) { return (bf16_t)(pk2(f, 0.f) & 0xffffu); }
__device__ __forceinline__ float bf2f(unsigned u16) { return __uint_as_float(u16 << 16); }
__device__ __forceinline__ float bflo(unsigned w) { return __uint_as_float(w << 16); }
__device__ __forceinline__ float bfhi(unsigned w) { return __uint_as_float(w & 0xffff0000u); }
__device__ __forceinline__ int crow(int i, int h) { return (i & 3) + 8 * (i >> 2) + 4 * h; }
__device__ __forceinline__ float wave_sum(float v) {
#pragma unroll
    for (int o = 1; o < 64; o <<= 1) v += __shfl_xor(v, o);
    return v;
}
__device__ __forceinline__ float swap_add(float v) { auto rr = __builtin_amdgcn_permlane32_swap(__float_as_uint(v), __float_as_uint(v), false, false); return __uint_as_float(rr[0]) + __uint_as_float(rr[1]); }
__device__ __forceinline__ float swap_max(float v) { auto rr = __builtin_amdgcn_permlane32_swap(__float_as_uint(v), __float_as_uint(v), false, false); return fmaxf(__uint_as_float(rr[0]), __uint_as_float(rr[1])); }
#define MFMA32(a, b, c) __builtin_amdgcn_mfma_f32_32x32x16_bf16((a), (b), (c), 0, 0, 0)
__device__ __forceinline__ bf16x8 pack8(const f32x16& x, int s) {
    u32x4 p; p.x = pk2(x[8 * s], x[8 * s + 1]); p.y = pk2(x[8 * s + 2], x[8 * s + 3]); p.z = pk2(x[8 * s + 4], x[8 * s + 5]); p.w = pk2(x[8 * s + 6], x[8 * s + 7]);
    return __builtin_bit_cast(bf16x8, p);
}
__device__ __forceinline__ bf16x8 lds16(lds_t p) { return *(const LAS bf16x8*)p; }
__device__ __forceinline__ bf16x8 lds8x2(lds_t p0, lds_t p1) { s16x4 a = *(const LAS s16x4*)p0, b = *(const LAS s16x4*)p1; return __builtin_shufflevector(a, b, 0, 1, 2, 3, 4, 5, 6, 7); }
__device__ __forceinline__ float sigmoidf_(float x) { return 1.f / (1.f + __expf(-x)); }
__device__ __forceinline__ float logsigmoidf_(float x) { return fminf(x, 0.f) - log1pf(__expf(-fabsf(x))); }

__device__ __forceinline__ int otid() { int t = threadIdx.x; asm volatile("" : "+v"(t)); return t; }
template <class T> __device__ __forceinline__ T* optr(T* p) { asm volatile("" : "+s"(p)); return p; }
namespace pg8 {
constexpr int BM = 256, BK = 64, HALF = 128, HTB = HALF * BK * 2, STAGE_BYTES = 8 * HTB, NXCD = 8, WGM = 8;
__host__ __device__ __forceinline__ int lds_byte(int r, int c) { const int st = (r >> 4) * 2 + (c >> 5), rr = r & 15, cc = c & 31, ob = rr * 64 + cc * 2; return st * 1024 + (ob ^ (((ob >> 9) & 1) << 5)); }
__host__ __device__ __forceinline__ void stage_rc(int b, int& R, int& C) { const int st = b / 1024, sb = b % 1024, swz = sb ^ (((sb >> 9) & 1) << 5); R = (st >> 1) * 16 + swz / 64; C = (st & 1) * 32 + (swz % 64) / 2; }
__host__ __device__ __forceinline__ int perm32(int rho) { const int n = rho >> 4, i = rho & 15; return 8 * (i >> 2) + 4 * n + (i & 3); }
struct Unit { int pm, pn; };
struct Gemm { const bf16_t* A; const bf16_t* Bt; int M, N, K; };
struct StaticOrder {
    int nM, nN, nwg, G, c;
    __host__ __device__ void init(int M, int N, int G_, int c_) { nM = M / BM; nN = N / BM; nwg = nM * nN; G = G_; c = c_; }
    __host__ __device__ bool next(int i, Unit& u) const {
        const long L = (long)i * G + c; if (L >= nwg) return false;
        int wgid = (int)L; { const int q = nwg / NXCD, r = nwg % NXCD, xcd = wgid % NXCD, off = wgid / NXCD; wgid = (xcd < r ? xcd * (q + 1) : r * (q + 1) + (xcd - r) * q) + off; }
        const int nig = WGM * nN, gid = wgid / nig, fm = gid * WGM, gsz = (nM - fm) < WGM ? (nM - fm) : WGM;
        u.pm = fm + ((wgid % nig) % gsz); u.pn = (wgid % nig) / gsz; return true;
    }
    __device__ __forceinline__ void a_ready(const Unit&) const {}
    __device__ __forceinline__ void done(const Unit&) const {}
};

template <int ACT> struct EpiRow {
    static constexpr bool PERM = true, AFTER_DRAIN = false;
    bf16_t* O; int ldc; const float* rs;
    __device__ __forceinline__ void operator()(const f32x4 (&acc)[2][2][4][2], const Unit& u, int wr, int wc, int fr, int fq) const {
        const int row0 = u.pm * BM + wr * 64 + fr, col0 = u.pn * BM + wc * 32 + 8 * fq;
#pragma unroll
        for (int ai = 0; ai < 2; ++ai)
#pragma unroll
            for (int m = 0; m < 4; ++m) { const int row = row0 + ai * HALF + m * 16; const float s = rs ? rs[row] : 1.f; bf16_t* rowp = O + (size_t)row * ldc + col0;
#pragma unroll
                for (int bj = 0; bj < 2; ++bj) { f32x4 v0 = acc[ai][bj][m][0] * s, v1 = acc[ai][bj][m][1] * s;
                    if (ACT == 1) {
#pragma unroll
                        for (int i = 0; i < 4; ++i) { const float a = fmaxf(v0[i], 0.f), b = fmaxf(v1[i], 0.f); v0[i] = a * a; v1[i] = b * b; } }
                    u32x4 w; w.x = pk2(v0[0], v0[1]); w.y = pk2(v0[2], v0[3]); w.z = pk2(v1[0], v1[1]); w.w = pk2(v1[2], v1[3]);
                    *(u32x4*)(rowp + bj * HALF) = w; } }
    }
};
struct EpiInProj {
    static constexpr bool PERM = true, AFTER_DRAIN = false;
    bf16_t* O; const float* rs; const f32x2* rope;
    __device__ __forceinline__ void operator()(const f32x4 (&acc)[2][2][4][2], const Unit& u, int wr, int wc, int fr, int fq) const {
        const int row0 = u.pm * BM + wr * 64 + fr, col0 = u.pn * BM + wc * 32 + 8 * fq;
        const int pn = u.pn;
        const int j64 = 4 * (wc & 1) + fq;
#pragma unroll
        for (int ai = 0; ai < 2; ++ai)
#pragma unroll
            for (int m = 0; m < 4; ++m) { const int row = row0 + ai * HALF + m * 16; const float s = rs[row]; bf16_t* rowp = O + (size_t)row * ZP + col0;
                const f32x2* tb = rope + (size_t)(row & (SEQ - 1)) * 32;
#pragma unroll
                for (int bj = 0; bj < 2; ++bj) { f32x4 v0 = acc[ai][bj][m][0] * s, v1 = acc[ai][bj][m][1] * s;
                    const bool r64 = (pn == 4) || (pn == 5) || (pn == 6 && bj == 0), r32 = (pn == 7) || (pn == 8);
                    if (r64 || r32) {
                        f32x2 cs[4];
                        if (r64) { const f32x4 t0 = *(const f32x4*)(tb + 4 * j64), t1 = *(const f32x4*)(tb + 4 * j64 + 2); cs[0] = (f32x2){t0[0], t0[1]}; cs[1] = (f32x2){t0[2], t0[3]}; cs[2] = (f32x2){t1[0], t1[1]}; cs[3] = (f32x2){t1[2], t1[3]}; }
                        else {
#pragma unroll
                            for (int i = 0; i < 4; ++i) cs[i] = tb[8 * fq + 2 * i]; }
#pragma unroll
                        for (int i = 0; i < 4; ++i) { const float a = v0[i], b = v1[i]; v0[i] = a * cs[i].x - b * cs[i].y; v1[i] = b * cs[i].x + a * cs[i].y; }
                    }
                    u32x4 w; w.x = pk2(v0[0], v0[1]); w.y = pk2(v0[2], v0[3]); w.z = pk2(v1[0], v1[1]); w.w = pk2(v1[2], v1[3]);
                    *(u32x4*)(rowp + bj * HALF) = w; } }
    }
};

template <class Epi, class Sched, bool ALIGN_EPI = false, bool SP2 = false>
__device__ __forceinline__ void gemm_phase(lds_t lds, const Gemm g, const Sched& S, const Epi& E) {
    const int tid = otid(), wid = __builtin_amdgcn_readfirstlane(tid >> 6), lane = tid & 63, wr = wid >> 2, wc = wid & 3, fr = lane & 15, fq = lane >> 4;
    const int K = g.K, nt = K / BK;
    unsigned voffA[2], voffB[2];
#pragma unroll
    for (int i = 0; i < 2; ++i) { int R, C; stage_rc(tid * 16 + i * 8192, R, C); const int Rb = Epi::PERM ? ((R & ~31) + perm32(R & 31)) : R;
        voffA[i] = (unsigned)(R * K + C) * 2u; voffB[i] = (unsigned)(Rb * K + C) * 2u; }
    const size_t kstep = (size_t)(BK * 2);
    const size_t hstep = (size_t)HALF * K * 2;
    const size_t tstep = 2 * hstep;
    const unsigned ldsw = (unsigned)wid * 1024u;
    const int aoff = lds_byte(wr * 64 + fr, fq * 8), boff = lds_byte(wc * 32 + fr, fq * 8);
#define PG8_SA(b, h) (((b) * 2 + (h)) * HTB)
#define PG8_SB(b, h) ((4 + (b) * 2 + (h)) * HTB)
#define PG8_STAGE(bufoff, gbase, voff) do { _Pragma("unroll") for (int _i = 0; _i < 2; ++_i) \
        __builtin_amdgcn_global_load_lds((const unsigned*)((const char*)(gbase) + (voff)[_i]), (LAS unsigned*)(lds + (bufoff) + ldsw + _i * 8192), 16, 0, 0); } while (0)
#define PG8_LDA(dst, b, h) do { _Pragma("unroll") for (int m = 0; m < 4; ++m) _Pragma("unroll") for (int k = 0; k < 2; ++k) dst[m][k] = *(const LAS bf16x8*)(lds + PG8_SA(b, h) + aoff + m * 2048 + k * 1024); } while (0)
#define PG8_LDB(dst, b, h) do { _Pragma("unroll") for (int n = 0; n < 2; ++n) _Pragma("unroll") for (int k = 0; k < 2; ++k) dst[n][k] = *(const LAS bf16x8*)(lds + PG8_SB(b, h) + boff + n * 2048 + k * 1024); } while (0)
#define PG8_MMA(ai, bj, At, Bt) do { __builtin_amdgcn_s_setprio(1); _Pragma("unroll") for (int m = 0; m < 4; ++m) _Pragma("unroll") for (int n = 0; n < 2; ++n) _Pragma("unroll") for (int k = 0; k < 2; ++k) \
        acc[ai][bj][m][n] = __builtin_amdgcn_mfma_f32_16x16x32_bf16(Bt[n][k], At[m][k], acc[ai][bj][m][n], 0, 0, 0); __builtin_amdgcn_s_setprio(0); } while (0)
#define PG8_WAIT_V(n) asm volatile("s_waitcnt vmcnt(" #n ")" ::: "memory")
#define PG8_WAIT_L(n) asm volatile("s_waitcnt lgkmcnt(" #n ")" ::: "memory")
#define PG8_BAR __builtin_amdgcn_s_barrier()
#define PG8_SCHED __builtin_amdgcn_sched_barrier(0)
    Unit cur, nxt; int ui = 0;
    if (!S.next(0, cur)) return;
    f32x4 acc[2][2][4][2];
#pragma unroll
    for (int a = 0; a < 2; ++a)
#pragma unroll
        for (int b = 0; b < 2; ++b)
#pragma unroll
            for (int m = 0; m < 4; ++m)
#pragma unroll
                for (int n = 0; n < 2; ++n) acc[a][b][m][n] = (f32x4){0.f, 0.f, 0.f, 0.f};
    bf16x8 At[4][2], B0[2][2], B1[2][2];
    const char* cA = (const char*)g.A + (size_t)cur.pm * tstep; const char* cB = (const char*)g.Bt + (size_t)cur.pn * tstep;
    S.a_ready(cur);
    if constexpr (SP2) {
        PG8_STAGE(PG8_SB(0, 0), cB, voffB); PG8_STAGE(PG8_SB(0, 1), cB + hstep, voffB); PG8_STAGE(PG8_SA(0, 0), cA, voffA); PG8_STAGE(PG8_SA(0, 1), cA + hstep, voffA);
        if (wr == 1) PG8_BAR;
        PG8_WAIT_V(2); PG8_BAR;
        PG8_STAGE(PG8_SB(1, 0), cB + kstep, voffB); PG8_STAGE(PG8_SA(1, 0), cA + kstep, voffA); PG8_STAGE(PG8_SB(1, 1), cB + hstep + kstep, voffB);
        PG8_WAIT_V(6); PG8_BAR;
    } else {
        PG8_STAGE(PG8_SB(0, 0), cB, voffB); PG8_STAGE(PG8_SA(0, 0), cA, voffA); PG8_STAGE(PG8_SB(0, 1), cB + hstep, voffB); PG8_STAGE(PG8_SA(0, 1), cA + hstep, voffA);
        if (wr == 1) PG8_BAR;
        PG8_WAIT_V(4); PG8_BAR;
        PG8_STAGE(PG8_SB(1, 0), cB + kstep, voffB); PG8_STAGE(PG8_SA(1, 0), cA + kstep, voffA); PG8_STAGE(PG8_SB(1, 1), cB + hstep + kstep, voffB);
        PG8_WAIT_V(6); PG8_BAR;
    }
    for (;;) {
        const bool has_next = S.next(ui + 1, nxt);
        const char* nA = has_next ? (const char*)g.A + (size_t)nxt.pm * tstep : cA; const char* nB = has_next ? (const char*)g.Bt + (size_t)nxt.pn * tstep : cB;
        for (int t = 0; t < nt; t += 2) {
            const bool last = (t == nt - 2);
            const char* a1 = cA + (size_t)(t + 1) * kstep;
            const char* a2 = last ? nA : cA + (size_t)(t + 2) * kstep; const char* b2 = last ? nB : cB + (size_t)(t + 2) * kstep;
            const char* a3 = a2 + kstep; const char* b3 = b2 + kstep;
            if (last && has_next) S.a_ready(nxt);
            if constexpr (SP2) {
            PG8_LDB(B0, 0, 0); PG8_LDB(B1, 0, 1); PG8_SCHED; PG8_LDA(At, 0, 0); PG8_STAGE(PG8_SA(1, 1), a1 + hstep, voffA);
            PG8_WAIT_V(8); PG8_WAIT_L(0); PG8_BAR; PG8_MMA(0, 0, At, B0); PG8_MMA(0, 1, At, B1); PG8_BAR; PG8_SCHED;
            PG8_LDA(At, 0, 1); PG8_STAGE(PG8_SB(0, 0), b2, voffB); PG8_STAGE(PG8_SB(0, 1), b2 + hstep, voffB); PG8_STAGE(PG8_SA(0, 0), a2, voffA);
            PG8_WAIT_V(8); PG8_WAIT_L(0); PG8_BAR; PG8_MMA(1, 0, At, B0); PG8_MMA(1, 1, At, B1); PG8_BAR; PG8_SCHED;
            PG8_LDB(B0, 1, 0); PG8_LDB(B1, 1, 1); PG8_SCHED; PG8_LDA(At, 1, 0); PG8_STAGE(PG8_SA(0, 1), a2 + hstep, voffA);
            PG8_WAIT_V(8); PG8_WAIT_L(0); PG8_BAR; PG8_MMA(0, 0, At, B0); PG8_MMA(0, 1, At, B1); PG8_BAR; PG8_SCHED;
            PG8_LDA(At, 1, 1); PG8_STAGE(PG8_SB(1, 0), b3, voffB); PG8_STAGE(PG8_SB(1, 1), b3 + hstep, voffB); PG8_STAGE(PG8_SA(1, 0), a3, voffA);
            PG8_WAIT_V(8); PG8_WAIT_L(0); PG8_BAR; PG8_MMA(1, 0, At, B0); PG8_MMA(1, 1, At, B1); PG8_BAR; PG8_SCHED;
            } else {
            PG8_LDB(B0, 0, 0); PG8_SCHED; PG8_LDA(At, 0, 0); PG8_STAGE(PG8_SA(1, 1), a1 + hstep, voffA);
            PG8_WAIT_L(8); PG8_BAR; PG8_WAIT_L(0); PG8_MMA(0, 0, At, B0); PG8_BAR; PG8_SCHED;
            PG8_LDB(B1, 0, 1); PG8_STAGE(PG8_SB(0, 0), b2, voffB);
            PG8_BAR; PG8_WAIT_L(0); PG8_MMA(0, 1, At, B1); PG8_BAR;
            PG8_LDA(At, 0, 1); PG8_STAGE(PG8_SA(0, 0), a2, voffA);
            PG8_BAR; PG8_WAIT_L(0); PG8_MMA(1, 0, At, B0); PG8_BAR; PG8_SCHED;
            PG8_STAGE(PG8_SB(0, 1), b2 + hstep, voffB);
            PG8_WAIT_V(6); PG8_BAR; PG8_MMA(1, 1, At, B1); PG8_BAR;
            PG8_LDB(B0, 1, 0); PG8_SCHED; PG8_LDA(At, 1, 0); PG8_STAGE(PG8_SA(0, 1), a2 + hstep, voffA);
            PG8_WAIT_L(8); PG8_BAR; PG8_WAIT_L(0); PG8_MMA(0, 0, At, B0); PG8_BAR; PG8_SCHED;
            PG8_LDB(B1, 1, 1); PG8_STAGE(PG8_SB(1, 0), b3, voffB);
            PG8_BAR; PG8_WAIT_L(0); PG8_MMA(0, 1, At, B1); PG8_BAR;
            PG8_LDA(At, 1, 1); PG8_STAGE(PG8_SA(1, 0), a3, voffA);
            PG8_BAR; PG8_WAIT_L(0); PG8_MMA(1, 0, At, B0); PG8_BAR; PG8_SCHED;
            PG8_STAGE(PG8_SB(1, 1), b3 + hstep, voffB);
            PG8_WAIT_V(6); PG8_BAR; PG8_MMA(1, 1, At, B1); PG8_BAR;
            }
        }
        if constexpr (ALIGN_EPI) { if (wr == 0) PG8_BAR; }
        E(acc, cur, wr, wc, fr, fq); S.done(cur);
        if (!has_next) break;
#pragma unroll
        for (int a = 0; a < 2; ++a)
#pragma unroll
            for (int b = 0; b < 2; ++b)
#pragma unroll
                for (int m = 0; m < 4; ++m)
#pragma unroll
                    for (int n = 0; n < 2; ++n) acc[a][b][m][n] = (f32x4){0.f, 0.f, 0.f, 0.f};
        cur = nxt; cA = nA; cB = nB; ++ui;
        if constexpr (ALIGN_EPI) { if (wr == 1) PG8_BAR; }
    }
    PG8_WAIT_V(0);
    if constexpr (!ALIGN_EPI) { if (wr == 0) PG8_BAR; }
    PG8_BAR;
#undef PG8_SA
#undef PG8_SB
#undef PG8_STAGE
#undef PG8_LDA
#undef PG8_LDB
#undef PG8_MMA
#undef PG8_WAIT_V
#undef PG8_WAIT_L
#undef PG8_BAR
#undef PG8_SCHED
}
}

__device__ __forceinline__ int zsrc(int c) {
    if (c < 1024) return c;
    if (c < ZC_SK) { const int x = c - ZC_SQ, hh = x >> 6, p = x & 63, j = p >> 3, i = p & 7; return 1032 + hh * 64 + (i < 4 ? 4 * j + i : 32 + 4 * j + (i - 4)); }
    if (c < ZC_SV) { const int x = c - ZC_SK, hh = x >> 6, p = x & 63, j = p >> 3, i = p & 7; return 1544 + hh * 64 + (i < 4 ? 4 * j + i : 32 + 4 * j + (i - 4)); }
    if (c < ZC_DQ) return 1672 + (c - ZC_SV);
    if (c < ZC_DK) { const int x = c - ZC_DQ, hh = x >> 5, p = x & 31, j = p >> 3, i = p & 7; return 1800 + hh * 32 + (i < 4 ? 4 * j + i : 16 + 4 * j + (i - 4)); }
    if (c < ZC_DV) { const int x = c - ZC_DK, hh = x >> 5, p = x & 31, j = p >> 3, i = p & 7; return 2056 + hh * 32 + (i < 4 ? 4 * j + i : 16 + 4 * j + (i - 4)); }
    if (c < ZC_G) return 2312 + (c - ZC_DV);
    if (c < ZC_G + 8) return 1024 + (c - ZC_G);
    return -1;
}
template <bool MAPZ> __device__ __forceinline__ void transpose_item(const float* W, int K, int N, int Nst, const float* gk, bf16_t* WT, LAS float* scr, int item, int lane) {
    const int nblk = Nst / 32, kb = item / nblk, nb = item % nblk, k0 = 64 * kb, n0 = 32 * nb;
    const int nsrc = MAPZ ? zsrc(n0 + (lane & 31)) : (n0 + (lane & 31));
#pragma unroll 8
    for (int i = 0; i < 32; ++i) { const int kk = 2 * i + (lane >> 5); float v = 0.f; if (nsrc >= 0) v = W[(size_t)(k0 + kk) * N + nsrc]; if (gk) v *= gk[k0 + kk]; scr[kk * 33 + (lane & 31)] = v; }
    asm volatile("s_waitcnt lgkmcnt(0)" ::: "memory");
    const int c = lane & 7;
#pragma unroll
    for (int j = 0; j < 4; ++j) { const int n = (lane >> 3) + 8 * j; const LAS float* s = scr + (8 * c) * 33 + n;
        u32x4 o; o.x = pk2(s[0 * 33], s[1 * 33]); o.y = pk2(s[2 * 33], s[3 * 33]); o.z = pk2(s[4 * 33], s[5 * 33]); o.w = pk2(s[6 * 33], s[7 * 33]);
        *(u32x4*)(WT + (size_t)(n0 + n) * K + k0 + 8 * c) = o; }
    asm volatile("s_waitcnt lgkmcnt(0)" ::: "memory");
}
__device__ __forceinline__ void sincos_red(double x, float& c, float& s) {
    const double k = rint(x * 0.15915494309189535), r = x - k * 6.283185307179586, r2 = r * r;
    double sn = 1.0, cs = 1.0;
#pragma unroll
    for (int n = 14; n >= 1; --n) { sn = 1.0 - r2 * (1.0 / (double)((2 * n) * (2 * n + 1))) * sn; cs = 1.0 - r2 * (1.0 / (double)((2 * n - 1) * (2 * n))) * cs; }
    s = (float)(r * sn); c = (float)cs;
}
__device__ __forceinline__ void row_to_bf16(const float* xrow, bf16_t* orow, float* rs, int lane) {
    const f32x4* xr = (const f32x4*)xrow + lane;
    f32x4 v[4]; float s = 0.f;
#pragma unroll
    for (int j = 0; j < 4; ++j) { v[j] = xr[64 * j]; s += (v[j].x * v[j].x + v[j].y * v[j].y) + (v[j].z * v[j].z + v[j].w * v[j].w); }
    s = wave_sum(s);
    u32x2* o8 = (u32x2*)orow + lane;
#pragma unroll
    for (int j = 0; j < 4; ++j) o8[64 * j] = (u32x2){pk2(v[j].x, v[j].y), pk2(v[j].z, v[j].w)};
    if (lane == 0) *rs = 1.f / sqrtf(s * (1.f / DM) + EPS);
}
__device__ __forceinline__ void prologue(const Params& P, lds_t lds, int G) {
    const int tid = otid(), lane = tid & 63, wave = tid >> 6; unsigned char* const ws_ = optr(P.ws);
    LAS float* scr = (LAS float*)(lds + wave * 16384);
    const int gw = blockIdx.x * NWAVES + wave, NGW = G * NWAVES;
    constexpr int I_IN = (DM / 64) * (ZP / 32), I_OUT = (DM / 64) * (DM / 32), I_UP = (DM / 64) * (FF / 32), I_DN = (FF / 64) * (DM / 32), I_L = I_IN + I_OUT + I_UP + I_DN;
    for (int it = gw; it < 2 * I_L; it += NGW) {
        const int l = it / I_L; int r = it % I_L;
        unsigned char* wb = ws_ + WS_W + (size_t)l * W_LAYER;
        if (r < I_IN) { transpose_item<true>(P.in[1] + (size_t)l * DM * INW, DM, INW, ZP, P.in[16] + l * DM, (bf16_t*)(wb + W_IN), scr, r, lane); continue; } r -= I_IN;
        if (r < I_OUT) { transpose_item<false>(P.in[13] + (size_t)l * DM * DM, DM, DM, DM, nullptr, (bf16_t*)(wb + W_OUT), scr, r, lane); continue; } r -= I_OUT;
        if (r < I_UP) { transpose_item<false>(P.in[14] + (size_t)l * DM * FF, DM, FF, FF, P.in[18] + l * DM, (bf16_t*)(wb + W_UP), scr, r, lane); continue; } r -= I_UP;
        transpose_item<false>(P.in[15] + (size_t)l * FF * DM, FF, DM, DM, nullptr, (bf16_t*)(wb + W_DOWN), scr, r, lane);
    }
    f32x2* rope = (f32x2*)(ws_ + WS_ROPE);
    for (int e = blockIdx.x * NTHREADS + tid; e < SEQ * 32; e += G * NTHREADS) {
        const int pos = e >> 5, i = e & 31;
        const float inv = (float)exp(-(double)i * (9.210340371976184 / 32.0));
        const float ang = (float)pos * inv;
        float c, s; sincos_red((double)ang, c, s);
        rope[e] = (f32x2){c, s};
    }
    bf16_t* XB = (bf16_t*)(ws_ + WS_XB); float* RS = (float*)(ws_ + WS_RS);
    for (int m = gw; m < NTOK; m += NGW) row_to_bf16(P.in[0] + (size_t)m * DM, XB + (size_t)m * DM, RS + m, lane);
}

__device__ __forceinline__ void resid_pass(const Params& P, const float* gpost, bool last, int G) {
    const int tid = otid(), lane = tid & 63, wave = tid >> 6; unsigned char* const ws_ = optr(P.ws);
    const int gw = blockIdx.x * NWAVES + wave, NGW = G * NWAVES;
    const bf16_t* MIX = (const bf16_t*)(ws_ + WS_MIX); bf16_t* XB = (bf16_t*)(ws_ + WS_XB); float* RS = (float*)(ws_ + WS_RS);
    f32x4 gv[4];
#pragma unroll
    for (int j = 0; j < 4; ++j) gv[j] = ((const f32x4*)gpost)[lane + 64 * j];
    for (int m = gw; m < NTOK; m += NGW) {
        const u32x2* mr = (const u32x2*)(MIX + (size_t)m * DM) + lane;
        u32x2* xr = (u32x2*)(XB + (size_t)m * DM) + lane;
        f32x4 mv[4], bv[4]; float s = 0.f;
#pragma unroll
        for (int j = 0; j < 4; ++j) { const u32x2 w = mr[64 * j]; mv[j] = (f32x4){bflo(w.x), bfhi(w.x), bflo(w.y), bfhi(w.y)}; const u32x2 xw = xr[64 * j]; bv[j] = (f32x4){bflo(xw.x), bfhi(xw.x), bflo(xw.y), bfhi(xw.y)};
            s += (mv[j].x * mv[j].x + mv[j].y * mv[j].y) + (mv[j].z * mv[j].z + mv[j].w * mv[j].w); }
        s = wave_sum(s);
        const float r = 1.f / sqrtf(s * (1.f / DM) + EPS);
        float s2 = 0.f;
#pragma unroll
        for (int j = 0; j < 4; ++j) { bv[j] = bv[j] + mv[j] * r * gv[j]; s2 += (bv[j].x * bv[j].x + bv[j].y * bv[j].y) + (bv[j].z * bv[j].z + bv[j].w * bv[j].w); }
        if (last) {
            f32x4* orow = (f32x4*)(P.out + (size_t)m * DM) + lane;
#pragma unroll
            for (int j = 0; j < 4; ++j) orow[64 * j] = bv[j];
        } else {
            s2 = wave_sum(s2);
#pragma unroll
            for (int j = 0; j < 4; ++j) xr[64 * j] = (u32x2){pk2(bv[j].x, bv[j].y), pk2(bv[j].z, bv[j].w)};
            if (lane == 0) RS[m] = 1.f / sqrtf(s2 * (1.f / DM) + EPS);
        }
    }
}

__device__ __forceinline__ void mlstm_gates(const bf16_t* Z, size_t t0, int hh, float ib, float fb, LAS float* bc, LAS float* ig, int tid) {
    if (tid < 64) {
        const int lane = tid;
        const bf16_t* g0 = Z + (t0 + 2 * lane) * ZP + ZC_G; const bf16_t* g1 = g0 + ZP;
        const float i0 = bf2f(g0[hh]) + ib, i1 = bf2f(g1[hh]) + ib;
        const float l0 = logsigmoidf_(bf2f(g0[4 + hh]) + fb), l1 = logsigmoidf_(bf2f(g1[4 + hh]) + fb);
        float x = l0 + l1;
#pragma unroll
        for (int o = 1; o < 64; o <<= 1) { const float t = __shfl_up(x, o); if (lane >= o) x += t; }
        bc[2 * lane] = x - l1; bc[2 * lane + 1] = x; ig[2 * lane] = i0; ig[2 * lane + 1] = i1;
    }
}
__device__ __forceinline__ void conv8(const bf16_t* zp, int tseq, const float* cw, const float* cb, int ch, float scale, float (&y)[8]) {
    const f32x4 b0 = *(const f32x4*)(cb + ch), b1 = *(const f32x4*)(cb + ch + 4);
    y[0] = b0[0]; y[1] = b0[1]; y[2] = b0[2]; y[3] = b0[3]; y[4] = b1[0]; y[5] = b1[1]; y[6] = b1[2]; y[7] = b1[3];
#pragma unroll
    for (int j = 0; j < 4; ++j) {
        if (tseq - 3 + j >= 0) {
            const u32x4 w = *(const u32x4*)(zp - (size_t)(3 - j) * ZP);
            const f32x4 c0 = *(const f32x4*)(cw + j * 512 + ch), c1 = *(const f32x4*)(cw + j * 512 + ch + 4);
            y[0] += bflo(w.x) * c0[0]; y[1] += bfhi(w.x) * c0[1]; y[2] += bflo(w.y) * c0[2]; y[3] += bfhi(w.y) * c0[3];
            y[4] += bflo(w.z) * c1[0]; y[5] += bfhi(w.z) * c1[1]; y[6] += bflo(w.w) * c1[2]; y[7] += bfhi(w.w) * c1[3];
        }
    }
#pragma unroll
    for (int i = 0; i < 8; ++i) y[i] = y[i] * sigmoidf_(y[i]) * scale;
}
constexpr int TS128 = 264;
constexpr int RS64 = 144;
__device__ __forceinline__ void mlstm_a_item(const Params& P, int l, int item, lds_t lds) {
    const int tid = otid(), lane = tid & 63, w = tid >> 6, r = lane & 31, h = lane >> 5; unsigned char* const ws_ = optr(P.ws);
    const int c = item & 63, hh = (item >> 6) & 3, b = item >> 8;
    const size_t t0 = (size_t)b * SEQ + (size_t)c * 128;
    const bf16_t* Z = (const bf16_t*)(ws_ + WS_ZB);
    const float* cw = P.in[2] + l * 4 * 512; const float* cb = P.in[3] + l * 512;
    lds_t KT = lds, VT = lds + 64 * TS128; LAS float* bc = (LAS float*)(lds + 2 * 64 * TS128); LAS float* ig = bc + 128; LAS float* wst = ig + 128;
    mlstm_gates(Z, t0, hh, P.in[4][l * 4 + hh], P.in[5][l * 4 + hh], bc, ig, tid);
    __syncthreads();
    const float blast = bc[127];
    if (tid < 128) wst[tid] = __expf(blast - bc[tid] + ig[tid]);
    __syncthreads();
#pragma unroll
    for (int q = 0; q < 2; ++q) {
        const int e = tid + q * 512, s = e >> 3, ch = e & 7;
        float y[8];
        conv8(Z + (t0 + s) * ZP + ZC_MK + hh * 64 + 8 * ch, c * 128 + s, cw, cb, 256 + hh * 64 + 8 * ch, 0.125f, y);
#pragma unroll
        for (int i = 0; i < 8; ++i) *(LAS bf16_t*)(KT + (8 * ch + i) * TS128 + s * 2) = f2bf(y[i]);
        const u32x4 vw = *(const u32x4*)(Z + (t0 + s) * ZP + ZC_MV + hh * 64 + 8 * ch);
        const float ws_ = wst[s];
        const float vv[8] = {bflo(vw.x), bfhi(vw.x), bflo(vw.y), bfhi(vw.y), bflo(vw.z), bfhi(vw.z), bflo(vw.w), bfhi(vw.w)};
#pragma unroll
        for (int i = 0; i < 8; ++i) *(LAS bf16_t*)(VT + (8 * ch + i) * TS128 + s * 2) = f2bf(vv[i] * ws_);
    }
    __syncthreads();
    float* DC = (float*)(ws_ + WS_DC) + (size_t)item * 4096; float* DN = (float*)(ws_ + WS_DN) + (size_t)item * 64; float* DEC = (float*)(ws_ + WS_DEC);
    if (w < 4) {
        const int vt = w >> 1, kt = w & 1;
        f32x16 acc = {};
#pragma unroll
        for (int ks = 0; ks < 8; ++ks) {
            const bf16x8 a = lds16(VT + (32 * vt + r) * TS128 + (16 * ks + 8 * h) * 2);
            const bf16x8 bb = lds16(KT + (32 * kt + r) * TS128 + (16 * ks + 8 * h) * 2);
            acc = MFMA32(a, bb, acc);
        }
#pragma unroll
        for (int i = 0; i < 16; ++i) DC[(32 * vt + crow(i, h)) * 64 + 32 * kt + r] = acc[i];
    } else if (w == 4) {
        float sum = 0.f;
#pragma unroll 4
        for (int s8 = 0; s8 < 16; ++s8) {
            const u32x4 kw = *(const LAS u32x4*)(KT + lane * TS128 + s8 * 16);
            const f32x4 w0 = *(const LAS f32x4*)(wst + 8 * s8), w1 = *(const LAS f32x4*)(wst + 8 * s8 + 4);
            sum += bflo(kw.x) * w0[0] + bfhi(kw.x) * w0[1] + bflo(kw.y) * w0[2] + bfhi(kw.y) * w0[3] + bflo(kw.z) * w1[0] + bfhi(kw.z) * w1[1] + bflo(kw.w) * w1[2] + bfhi(kw.w) * w1[3];
        }
        DN[lane] = sum;
    } else if (w == 5 && lane == 0) DEC[item] = __expf(blast);
    __syncthreads();
}
__device__ __forceinline__ void mlstm_scan(const Params& P, int G) {
    unsigned char* const ws_ = optr(P.ws); const int tid = otid();
    const float* DC = (const float*)(ws_ + WS_DC); const float* DN = (const float*)(ws_ + WS_DN); const float* DEC = (const float*)(ws_ + WS_DEC);
    bf16_t* CS = (bf16_t*)(ws_ + WS_CS); float* NS = (float*)(ws_ + WS_NS);
    for (int ch = blockIdx.x * NTHREADS + tid; ch < 32 * 4160; ch += G * NTHREADS) {
        const int seq = ch / 4160, e = ch % 4160;
        float st = 0.f;
        if (e < 4096) {
#pragma unroll 8
            for (int c = 0; c < 64; ++c) { const int it = seq * 64 + c; CS[(size_t)it * 4096 + e] = f2bf(st); st = DEC[it] * st + DC[(size_t)it * 4096 + e]; }
        } else {
            const int k = e - 4096;
#pragma unroll 8
            for (int c = 0; c < 64; ++c) { const int it = seq * 64 + c; NS[it * 64 + k] = st; st = DEC[it] * st + DN[it * 64 + k]; }
        }
    }
}
__device__ __forceinline__ void mlstm_c_item(const Params& P, int l, int item, lds_t lds) {
    const int tid = otid(), lane = tid & 63, w = tid >> 6, r = lane & 31, h = lane >> 5; unsigned char* const ws_ = optr(P.ws);
    const int c = item & 63, hh = (item >> 6) & 3, b = item >> 8;
    const size_t t0 = (size_t)b * SEQ + (size_t)c * 128;
    const bf16_t* Z = (const bf16_t*)(ws_ + WS_ZB);
    const float* cw = P.in[2] + l * 4 * 512; const float* cb = P.in[3] + l * 512;
    lds_t Qs = lds, Ks = Qs + 128 * RS64, VT = Ks + 128 * RS64, Cs = VT + 64 * TS128, Hs = Cs + 64 * RS64;
    LAS float* bc = (LAS float*)(Hs + 128 * RS64); LAS float* ig = bc + 128; LAS float* ns = ig + 128;
    mlstm_gates(Z, t0, hh, P.in[4][l * 4 + hh], P.in[5][l * 4 + hh], bc, ig, tid);
#pragma unroll
    for (int q = 0; q < 2; ++q) {
        const int e = tid + q * 512, s = e >> 3, ch = e & 7;
        float y[8];
        conv8(Z + (t0 + s) * ZP + ZC_MQ + hh * 64 + 8 * ch, c * 128 + s, cw, cb, hh * 64 + 8 * ch, 1.f, y);
        *(LAS u32x4*)(Qs + s * RS64 + ch * 16) = (u32x4){pk2(y[0], y[1]), pk2(y[2], y[3]), pk2(y[4], y[5]), pk2(y[6], y[7])};
        conv8(Z + (t0 + s) * ZP + ZC_MK + hh * 64 + 8 * ch, c * 128 + s, cw, cb, 256 + hh * 64 + 8 * ch, 0.125f, y);
        *(LAS u32x4*)(Ks + s * RS64 + ch * 16) = (u32x4){pk2(y[0], y[1]), pk2(y[2], y[3]), pk2(y[4], y[5]), pk2(y[6], y[7])};
        const u32x4 vw = *(const u32x4*)(Z + (t0 + s) * ZP + ZC_MV + hh * 64 + 8 * ch);
        const unsigned vv[4] = {vw.x, vw.y, vw.z, vw.w};
#pragma unroll
        for (int i = 0; i < 4; ++i) { *(LAS bf16_t*)(VT + (8 * ch + 2 * i) * TS128 + s * 2) = (bf16_t)(vv[i] & 0xffffu); *(LAS bf16_t*)(VT + (8 * ch + 2 * i + 1) * TS128 + s * 2) = (bf16_t)(vv[i] >> 16); }
    }
    { const int v = tid >> 3, ch = tid & 7; *(LAS u32x4*)(Cs + v * RS64 + ch * 16) = *(const u32x4*)((const bf16_t*)(ws_ + WS_CS) + (size_t)item * 4096 + v * 64 + ch * 8); }
    if (tid < 64) ns[tid] = ((const float*)(ws_ + WS_NS))[item * 64 + tid];
    __syncthreads();
    if (w < 4) {
        const int tt = w, tl = 32 * tt + r;
        bf16x8 qf[4];
#pragma unroll
        for (int ks = 0; ks < 4; ++ks) qf[ks] = lds16(Qs + tl * RS64 + (16 * ks + 8 * h) * 2);
        f32x16 num[2] = {};
#pragma unroll
        for (int vt = 0; vt < 2; ++vt)
#pragma unroll
            for (int ks = 0; ks < 4; ++ks) num[vt] = MFMA32(lds16(Cs + (32 * vt + r) * RS64 + (16 * ks + 8 * h) * 2), qf[ks], num[vt]);
        float nq = 0.f;
#pragma unroll
        for (int ks = 0; ks < 4; ++ks) {
            const u32x4 qw = __builtin_bit_cast(u32x4, qf[ks]);
            const f32x4 n0 = *(const LAS f32x4*)(ns + 16 * ks + 8 * h), n1 = *(const LAS f32x4*)(ns + 16 * ks + 8 * h + 4);
            nq += bflo(qw.x) * n0[0] + bfhi(qw.x) * n0[1] + bflo(qw.y) * n0[2] + bfhi(qw.y) * n0[3] + bflo(qw.z) * n1[0] + bfhi(qw.z) * n1[1] + bflo(qw.w) * n1[2] + bfhi(qw.w) * n1[3];
        }
        nq = swap_add(nq);
        const float bt = bc[tl], eb = __expf(bt);
#pragma unroll
        for (int vt = 0; vt < 2; ++vt)
#pragma unroll
            for (int i = 0; i < 16; ++i) num[vt][i] *= eb;
        float den = 0.f;
        for (int st = 0; st <= tt; ++st) {
            f32x16 S = {};
#pragma unroll
            for (int ks = 0; ks < 4; ++ks) S = MFMA32(lds16(Ks + (32 * st + r) * RS64 + (16 * ks + 8 * h) * 2), qf[ks], S);
#pragma unroll
            for (int i = 0; i < 16; ++i) { const int s = 32 * st + crow(i, h); const float wgt = (s <= tl) ? __expf(bt - bc[s] + ig[s]) : 0.f; S[i] *= wgt; den += S[i]; }
#pragma unroll
            for (int s2 = 0; s2 < 2; ++s2) { const bf16x8 pf = pack8(S, s2);
#pragma unroll
                for (int vt = 0; vt < 2; ++vt) { lds_t vp = VT + (32 * vt + r) * TS128 + (32 * st + 16 * s2 + 4 * h) * 2; num[vt] = MFMA32(lds8x2(vp, vp + 16), pf, num[vt]); } }
        }
        den = swap_add(den) + eb * nq;
        const float dinv = 1.f / fmaxf(fabsf(den), 1.f);
        float ss = 0.f;
#pragma unroll
        for (int vt = 0; vt < 2; ++vt)
#pragma unroll
            for (int i = 0; i < 16; ++i) { num[vt][i] *= dinv; ss += num[vt][i] * num[vt][i]; }
        ss = swap_add(ss);
        const float rn = 1.f / sqrtf(ss * (1.f / 64.f) + EPS);
#pragma unroll
        for (int vt = 0; vt < 2; ++vt)
#pragma unroll
            for (int i = 0; i < 16; ++i) *(LAS bf16_t*)(Hs + tl * RS64 + (32 * vt + crow(i, h)) * 2) = f2bf(num[vt][i] * rn);
    }
    __syncthreads();
    bf16_t* CAT = (bf16_t*)(ws_ + WS_CAT);
    const float* mg = P.in[6] + l * 256 + hh * 64;
#pragma unroll
    for (int q = 0; q < 2; ++q) {
        const int e = tid + q * 512, t = e >> 3, ch = e & 7;
        const u32x4 hw = *(const LAS u32x4*)(Hs + t * RS64 + ch * 16);
        const u32x4 ow = *(const u32x4*)(Z + (t0 + t) * ZP + ZC_MO + hh * 64 + 8 * ch);
        const f32x4 g0 = *(const f32x4*)(mg + 8 * ch), g1 = *(const f32x4*)(mg + 8 * ch + 4);
        u32x4 o;
        o.x = pk2(bflo(hw.x) * g0[0] * sigmoidf_(bflo(ow.x)), bfhi(hw.x) * g0[1] * sigmoidf_(bfhi(ow.x)));
        o.y = pk2(bflo(hw.y) * g0[2] * sigmoidf_(bflo(ow.y)), bfhi(hw.y) * g0[3] * sigmoidf_(bfhi(ow.y)));
        o.z = pk2(bflo(hw.z) * g1[0] * sigmoidf_(bflo(ow.z)), bfhi(hw.z) * g1[1] * sigmoidf_(bfhi(ow.z)));
        o.w = pk2(bflo(hw.w) * g1[2] * sigmoidf_(bflo(ow.w)), bfhi(hw.w) * g1[3] * sigmoidf_(bfhi(ow.w)));
        *(u32x4*)(CAT + (t0 + t) * DM + hh * 64 + 8 * ch) = o;
    }
    __syncthreads();
}

constexpr int TS256 = 520;
__device__ __forceinline__ void swa_item(const Params& P, int l, int item, lds_t lds) {
    const int tid = otid(), lane = tid & 63, w = tid >> 6, r = lane & 31, h = lane >> 5; unsigned char* const ws_ = optr(P.ws);
    const int kvh = item & 1, nb = (item >> 1) & 63, b = item >> 7;
    const size_t t0 = (size_t)b * SEQ + (size_t)nb * 128;
    const bf16_t* Z = (const bf16_t*)(ws_ + WS_ZB);
    lds_t Ks = lds, VT = lds + 256 * RS64, Os = VT + 64 * TS256;
#pragma unroll
    for (int q = 0; q < 4; ++q) {
        const int e = tid + q * 512, kb = e >> 3, ch = e & 7;
        u32x4 kw = {0u, 0u, 0u, 0u}, vw = {0u, 0u, 0u, 0u};
        if (nb > 0 || kb >= 128) { const bf16_t* zr = Z + (t0 - 128 + kb) * ZP; kw = *(const u32x4*)(zr + ZC_SK + kvh * 64 + 8 * ch); vw = *(const u32x4*)(zr + ZC_SV + kvh * 64 + 8 * ch); }
        *(LAS u32x4*)(Ks + kb * RS64 + ch * 16) = kw;
        const unsigned vv[4] = {vw.x, vw.y, vw.z, vw.w};
#pragma unroll
        for (int i = 0; i < 4; ++i) { *(LAS bf16_t*)(VT + (8 * ch + 2 * i) * TS256 + kb * 2) = (bf16_t)(vv[i] & 0xffffu); *(LAS bf16_t*)(VT + (8 * ch + 2 * i + 1) * TS256 + kb * 2) = (bf16_t)(vv[i] >> 16); }
    }
    __syncthreads();
    bf16_t* CAT = (bf16_t*)(ws_ + WS_CAT);
    lds_t Ow = Os + w * 32 * RS64;
    for (int cc = w; cc < 16; cc += 8) {
        const int hq = cc >> 2, qt = cc & 3, hg = kvh * 4 + hq, ql = 32 * qt + r;
        const float sink = P.in[7][l * 8 + hg];
        const bf16_t* qp = Z + (t0 + ql) * ZP + ZC_SQ + hg * 64;
        bf16x8 qf[4];
#pragma unroll
        for (int ks = 0; ks < 4; ++ks) qf[ks] = *(const bf16x8*)(qp + 16 * ks + 8 * h);
        f32x16 S[5];
        float mx = sink;
#pragma unroll
        for (int k5 = 0; k5 < 5; ++k5) {
            const int kt = qt + k5;
            S[k5] = (f32x16){};
#pragma unroll
            for (int ks = 0; ks < 4; ++ks) S[k5] = MFMA32(lds16(Ks + (32 * kt + r) * RS64 + (16 * ks + 8 * h) * 2), qf[ks], S[k5]);
#pragma unroll
            for (int i = 0; i < 16; ++i) { const int kb = 32 * kt + crow(i, h); const bool ok = (kb > ql) && (kb <= ql + 128) && (nb > 0 || kb >= 128);
                S[k5][i] = ok ? S[k5][i] * 0.125f : -1e30f; mx = fmaxf(mx, S[k5][i]); }
        }
        mx = swap_max(mx);
        float sum = 0.f;
#pragma unroll
        for (int k5 = 0; k5 < 5; ++k5)
#pragma unroll
            for (int i = 0; i < 16; ++i) { S[k5][i] = __expf(S[k5][i] - mx); sum += S[k5][i]; }
        sum = swap_add(sum) + __expf(sink - mx);
        const float inv = 1.f / sum;
        f32x16 O[2] = {};
#pragma unroll
        for (int k5 = 0; k5 < 5; ++k5) {
            const int kt = qt + k5;
#pragma unroll
            for (int i = 0; i < 16; ++i) S[k5][i] *= inv;
#pragma unroll
            for (int s2 = 0; s2 < 2; ++s2) { const bf16x8 pf = pack8(S[k5], s2);
#pragma unroll
                for (int dt = 0; dt < 2; ++dt) { lds_t vp = VT + (32 * dt + r) * TS256 + (32 * kt + 16 * s2 + 4 * h) * 2; O[dt] = MFMA32(lds8x2(vp, vp + 16), pf, O[dt]); } }
        }
#pragma unroll
        for (int dt = 0; dt < 2; ++dt)
#pragma unroll
            for (int i = 0; i < 16; ++i) *(LAS bf16_t*)(Ow + r * RS64 + (32 * dt + crow(i, h)) * 2) = f2bf(O[dt][i]);
        asm volatile("s_waitcnt lgkmcnt(0)" ::: "memory");
#pragma unroll
        for (int it = 0; it < 4; ++it) { const int row = it * 8 + (lane >> 3), ch = lane & 7; const u32x4 v = *(const LAS u32x4*)(Ow + row * RS64 + ch * 16);
            *(u32x4*)(CAT + (t0 + 32 * qt + row) * DM + 256 + hg * 64 + 8 * ch) = v; }
        asm volatile("s_waitcnt lgkmcnt(0)" ::: "memory");
    }
    __syncthreads();
}

constexpr int DK_BYTES = 64 * RS64;
constexpr int TS64 = 136;
constexpr int DV_BYTES = 64 * TS64;
constexpr int DBUF = DK_BYTES + DV_BYTES;
__device__ __forceinline__ void diff_item(const Params& P, int l, int seq, int qb, lds_t lds, float lam, float oscale) {
    const int tid = otid(), lane = tid & 63, w = tid >> 6, r = lane & 31, h = lane >> 5; unsigned char* const ws_ = optr(P.ws);
    const int b = seq >> 2, hd = seq & 3;
    const size_t row0 = (size_t)b * SEQ;
    const bf16_t* Z = (const bf16_t*)(ws_ + WS_ZB);
    const int qrow = qb * 256 + w * 32 + r, wmin = qb * 256 + w * 32;
    const bf16_t* qp = Z + (row0 + qrow) * ZP + ZC_DQ + hd * 64;
    bf16x8 qf[2][2];
#pragma unroll
    for (int m = 0; m < 2; ++m)
#pragma unroll
        for (int ks = 0; ks < 2; ++ks) qf[m][ks] = *(const bf16x8*)(qp + 32 * m + 16 * ks + 8 * h);
    f32x16 O[2][2] = {};
    float mx[2] = {-1e30f, -1e30f}, ls[2] = {0.f, 0.f};
    const int NT = 4 * qb + 4;
    constexpr float C = 0.17677669529663687f * 1.4426950408889634f;
    const int skey = tid >> 3, sch = tid & 7;
    const bf16_t* kg = Z + (row0 + skey) * ZP + ZC_DK + hd * 64 + 8 * sch; const bf16_t* vg = Z + (row0 + skey) * ZP + ZC_DV + hd * 64 + 8 * sch;
    lds_t Os = lds + 2 * DBUF;
    u32x4 kreg = *(const u32x4*)kg, vreg = *(const u32x4*)vg;
    auto stage_write = [&](int buf) {
        lds_t Kb = lds + buf * DBUF, Vb = Kb + DK_BYTES;
        *(LAS u32x4*)(Kb + skey * RS64 + sch * 16) = kreg;
        const unsigned vv[4] = {vreg.x, vreg.y, vreg.z, vreg.w};
#pragma unroll
        for (int i = 0; i < 4; ++i) { *(LAS bf16_t*)(Vb + (8 * sch + 2 * i) * TS64 + skey * 2) = (bf16_t)(vv[i] & 0xffffu); *(LAS bf16_t*)(Vb + (8 * sch + 2 * i + 1) * TS64 + skey * 2) = (bf16_t)(vv[i] >> 16); }
    };
    stage_write(0);
    __syncthreads();
    for (int kt = 0; kt < NT; ++kt) {
        if (kt + 1 < NT) { kreg = *(const u32x4*)(kg + (size_t)(kt + 1) * 64 * ZP); vreg = *(const u32x4*)(vg + (size_t)(kt + 1) * 64 * ZP); }
        if (64 * kt <= wmin + 31) {
            lds_t Kb = lds + (kt & 1) * DBUF, Vb = Kb + DK_BYTES;
            const bool needmask = (64 * kt + 63 > wmin);
            f32x16 S[2][2];
#pragma unroll
            for (int m = 0; m < 2; ++m)
#pragma unroll
                for (int kh = 0; kh < 2; ++kh) { S[m][kh] = (f32x16){};
#pragma unroll
                    for (int ks = 0; ks < 2; ++ks) S[m][kh] = MFMA32(lds16(Kb + (32 * kh + r) * RS64 + (32 * m + 16 * ks + 8 * h) * 2), qf[m][ks], S[m][kh]); }
            if (needmask) {
#pragma unroll
                for (int kh = 0; kh < 2; ++kh)
#pragma unroll
                    for (int i = 0; i < 16; ++i) { const int key = 64 * kt + 32 * kh + crow(i, h); if (key > qrow) { S[0][kh][i] = -1e30f; S[1][kh][i] = -1e30f; } }
            }
            bf16x8 pf[2][2][2];
#pragma unroll
            for (int m = 0; m < 2; ++m) {
                float tm = S[m][0][0];
#pragma unroll
                for (int kh = 0; kh < 2; ++kh)
#pragma unroll
                    for (int i = 0; i < 16; ++i) tm = fmaxf(tm, S[m][kh][i]);
                const float mnew = fmaxf(mx[m], swap_max(tm));
                if (__any(mnew > mx[m])) {
                    const float alpha = __builtin_amdgcn_exp2f((mx[m] - mnew) * C);
                    ls[m] *= alpha;
#pragma unroll
                    for (int dt = 0; dt < 2; ++dt)
#pragma unroll
                        for (int i = 0; i < 16; ++i) O[m][dt][i] *= alpha;
                    mx[m] = mnew;
                }
                const float nb = -mx[m] * C;
                float sum = 0.f;
#pragma unroll
                for (int kh = 0; kh < 2; ++kh)
#pragma unroll
                    for (int i = 0; i < 16; ++i) { const float p = __builtin_amdgcn_exp2f(fmaf(S[m][kh][i], C, nb)); S[m][kh][i] = p; sum += p; }
                ls[m] += sum;
#pragma unroll
                for (int kh = 0; kh < 2; ++kh)
#pragma unroll
                    for (int s2 = 0; s2 < 2; ++s2) pf[m][kh][s2] = pack8(S[m][kh], s2);
            }
#pragma unroll
            for (int dt = 0; dt < 2; ++dt)
#pragma unroll
                for (int kh = 0; kh < 2; ++kh)
#pragma unroll
                    for (int s2 = 0; s2 < 2; ++s2) { lds_t vp = Vb + (32 * dt + r) * TS64 + (32 * kh + 16 * s2 + 4 * h) * 2; const bf16x8 vf = lds8x2(vp, vp + 16);
                        O[0][dt] = MFMA32(vf, pf[0][kh][s2], O[0][dt]); O[1][dt] = MFMA32(vf, pf[1][kh][s2], O[1][dt]); }
        }
        if (kt + 1 < NT) stage_write((kt + 1) & 1);
        __syncthreads();
    }
    const float i1 = 1.f / swap_add(ls[0]), i2 = lam / swap_add(ls[1]);
    float ss = 0.f;
#pragma unroll
    for (int dt = 0; dt < 2; ++dt)
#pragma unroll
        for (int i = 0; i < 16; ++i) { const float o = O[0][dt][i] * i1 - O[1][dt][i] * i2; O[0][dt][i] = o; ss += o * o; }
    ss = swap_add(ss);
    const float rn = oscale / sqrtf(ss * (1.f / 64.f) + EPS);
    lds_t Ow = Os + w * 32 * RS64;
#pragma unroll
    for (int dt = 0; dt < 2; ++dt)
#pragma unroll
        for (int i = 0; i < 16; ++i) *(LAS bf16_t*)(Ow + r * RS64 + (32 * dt + crow(i, h)) * 2) = f2bf(O[0][dt][i] * rn);
    asm volatile("s_waitcnt lgkmcnt(0)" ::: "memory");
    bf16_t* CAT = (bf16_t*)(ws_ + WS_CAT);
    const float* sg = P.in[12] + l * 64;
#pragma unroll
    for (int it = 0; it < 4; ++it) { const int row = it * 8 + (lane >> 3), ch = lane & 7; const u32x4 v = *(const LAS u32x4*)(Ow + row * RS64 + ch * 16);
        const f32x4 g0 = *(const f32x4*)(sg + 8 * ch), g1 = *(const f32x4*)(sg + 8 * ch + 4);
        u32x4 o; o.x = pk2(bflo(v.x) * g0[0], bfhi(v.x) * g0[1]); o.y = pk2(bflo(v.y) * g0[2], bfhi(v.y) * g0[3]); o.z = pk2(bflo(v.z) * g1[0], bfhi(v.z) * g1[1]); o.w = pk2(bflo(v.w) * g1[2], bfhi(v.w) * g1[3]);
        *(u32x4*)(CAT + (row0 + wmin + row) * DM + 768 + hd * 64 + 8 * ch) = o; }
    __syncthreads();
}

constexpr int N_PHASES = 19;
__global__ void __launch_bounds__(NTHREADS, 2) hybrid_fwd(Params P) {
    extern __shared__ __attribute__((aligned(16))) unsigned char lds_raw[];
    lds_t lds = (lds_t)lds_raw;
    cg::grid_group grid = cg::this_grid();
    const int G = gridDim.x, lo = P.ph_lo, hi = P.ph_hi;
    int ph = 0;
#define PHASE_BEGIN(k) if (((PH_MASK >> (k)) & 1) && lo <= ph && ph < hi) { for (int rep_ = 0; rep_ <= ((REP_MASK >> (k)) & 1); ++rep_) { if (rep_) grid.sync();
#define PHASE_END   } if (ph + 1 < hi) grid.sync(); } ++ph;
    PHASE_BEGIN(0) prologue(P, lds, G); PHASE_END
    for (int l = 0; l < 2; ++l) {
        unsigned char* wb = P.ws + WS_W + (size_t)l * W_LAYER;
        bf16_t* XB = (bf16_t*)(P.ws + WS_XB); float* RS = (float*)(P.ws + WS_RS);
        PHASE_BEGIN(1) {
            pg8::Gemm g{XB, (const bf16_t*)(wb + W_IN), NTOK, ZP, DM}; pg8::StaticOrder S; S.init(NTOK, ZP, G, (int)blockIdx.x);
            pg8::EpiInProj E{(bf16_t*)(P.ws + WS_ZB), RS, (const f32x2*)(P.ws + WS_ROPE)};
            pg8::gemm_phase<pg8::EpiInProj, pg8::StaticOrder, true, true>(lds, g, S, E);
        } PHASE_END
        PHASE_BEGIN(2) {
            for (int it = blockIdx.x; it < 2048; it += G) mlstm_a_item(P, l, it, lds);
            for (int it = blockIdx.x; it < 1024; it += G) swa_item(P, l, it, lds);
        } PHASE_END
        PHASE_BEGIN(3) {
            mlstm_scan(P, G);
            float d1 = 0.f, d2 = 0.f;
            for (int i = 0; i < 32; ++i) { d1 += P.in[8][l * 32 + i] * P.in[9][l * 32 + i]; d2 += P.in[10][l * 32 + i] * P.in[11][l * 32 + i]; }
            const float lam_init = 0.8f - 0.6f * expf(-0.3f * (float)l);
            const float lam = expf(d1) - expf(d2) + lam_init;
            for (int vg = blockIdx.x; vg < 256; vg += G) {
                const int seq = vg >> 3, j = vg & 7;
                diff_item(P, l, seq, 31 - j, lds, lam, 1.f - lam_init);
                diff_item(P, l, seq, 16 + j, lds, lam, 1.f - lam_init);
                diff_item(P, l, seq, 15 - j, lds, lam, 1.f - lam_init);
                diff_item(P, l, seq, j, lds, lam, 1.f - lam_init);
            }
        } PHASE_END
        PHASE_BEGIN(4) {
            for (int it = blockIdx.x; it < 2048; it += G) mlstm_c_item(P, l, it, lds);
        } PHASE_END
        PHASE_BEGIN(5) {
            pg8::Gemm g{(const bf16_t*)(P.ws + WS_CAT), (const bf16_t*)(wb + W_OUT), NTOK, DM, DM}; pg8::StaticOrder S; S.init(NTOK, DM, G, (int)blockIdx.x);
            pg8::EpiRow<0> E{(bf16_t*)(P.ws + WS_MIX), DM, nullptr};
            pg8::gemm_phase<pg8::EpiRow<0>, pg8::StaticOrder, true, true>(lds, g, S, E);
        } PHASE_END
        PHASE_BEGIN(6) resid_pass(P, P.in[17] + l * DM, false, G); PHASE_END
        PHASE_BEGIN(7) {
            pg8::Gemm g{XB, (const bf16_t*)(wb + W_UP), NTOK, FF, DM}; pg8::StaticOrder S; S.init(NTOK, FF, G, (int)blockIdx.x);
            pg8::EpiRow<1> E{(bf16_t*)(P.ws + WS_U), FF, RS};
            pg8::gemm_phase<pg8::EpiRow<1>, pg8::StaticOrder, true, true>(lds, g, S, E);
        } PHASE_END
        PHASE_BEGIN(8) {
            pg8::Gemm g{(const bf16_t*)(P.ws + WS_U), (const bf16_t*)(wb + W_DOWN), NTOK, DM, FF}; pg8::StaticOrder S; S.init(NTOK, DM, G, (int)blockIdx.x);
            pg8::EpiRow<0> E{(bf16_t*)(P.ws + WS_MIX), DM, nullptr};
            pg8::gemm_phase<pg8::EpiRow<0>, pg8::StaticOrder, true, true>(lds, g, S, E);
        } PHASE_END
        PHASE_BEGIN(9) resid_pass(P, P.in[19] + l * DM, l == 1, G); PHASE_END
    }
#undef PHASE_BEGIN
#undef PHASE_END
}

extern "C" void kernel_launch(void* const* d_in, const int* in_sizes, int n_in, void* d_out, int out_size, void* d_ws, size_t ws_size, hipStream_t stream) {
    static int grid = 0;
    if (grid == 0) {
        if (n_in != 20 || out_size != NTOK * DM || ws_size < WS_END) { fprintf(stderr, "kernel_launch: unexpected shapes (n_in %d out %d ws %zu)\n", n_in, out_size, ws_size); grid = -1; return; }
        int dev = 0, cus = 0, per_cu = 0;
        hipGetDevice(&dev); hipDeviceGetAttribute(&cus, hipDeviceAttributeMultiprocessorCount, dev);
        if (hipFuncSetAttribute((const void*)hybrid_fwd, hipFuncAttributeMaxDynamicSharedMemorySize, LDS_BYTES) != hipSuccess) { fprintf(stderr, "kernel_launch: hipFuncSetAttribute failed\n"); grid = -1; return; }
        if (hipOccupancyMaxActiveBlocksPerMultiprocessor(&per_cu, (const void*)hybrid_fwd, NTHREADS, LDS_BYTES) != hipSuccess || per_cu < 1) { fprintf(stderr, "kernel_launch: occupancy query says %d\n", per_cu); per_cu = 1; }
        (void)hipGetLastError();
        grid = cus;
    }
    if (grid < 0) return;
    Params p{};
    for (int i = 0; i < 20; ++i) p.in[i] = (const float*)d_in[i];
    p.out = (float*)d_out; p.ws = (unsigned char*)d_ws;
#if ONE_LAUNCH
    p.ph_lo = 0; p.ph_hi = N_PHASES;
    void* args[] = {&p};
    hipError_t e = hipLaunchCooperativeKernel((const void*)hybrid_fwd, dim3(grid), dim3(NTHREADS), args, LDS_BYTES, stream);
    if (e != hipSuccess) fprintf(stderr, "cooperative launch failed: %s (grid %d)\n", hipGetErrorString(e), grid);
#else
    for (int ph = 0; ph < N_PHASES; ++ph) {
        p.ph_lo = ph; p.ph_hi = ph + 1;
        hipLaunchKernelGGL(hybrid_fwd, dim3(grid), dim3(NTHREADS), LDS_BYTES, stream, p);
    }
#endif
}
```

```cpp
#include <hip/hip_runtime.h>
#include <hip/hip_cooperative_groups.h>
#include <cstdio>
#include <cstdint>
namespace cg = cooperative_groups;

#ifndef PH_MASK
#define PH_MASK 0x3ff
#endif
#ifndef REP_MASK
#define REP_MASK 0
#endif
#ifndef ONE_LAUNCH
#define ONE_LAUNCH 1
#endif

#define LAS __attribute__((address_space(3)))
typedef unsigned short bf16_t;
typedef short bf16x8 __attribute__((ext_vector_type(8)));
typedef short s16x4 __attribute__((ext_vector_type(4)));
typedef float f32x4 __attribute__((ext_vector_type(4)));
typedef float f32x2 __attribute__((ext_vector_type(2)));
typedef float f32x16 __attribute__((ext_vector_type(16)));
typedef unsigned u32x4 __attribute__((ext_vector_type(4)));
typedef unsigned u32x2 __attribute__((ext_vector_type(2)));
typedef __bf16 bf16x2_t __attribute__((ext_vector_type(2)));
typedef LAS unsigned char* lds_t;

constexpr int BATCH = 8, SEQ = 8192, DM = 1024, FF = 4096, NTOK = BATCH * SEQ;
constexpr int INW = 2568, ZP = 2816;
constexpr int ZC_MQ = 0, ZC_MK = 256, ZC_MV = 512, ZC_MO = 768, ZC_SQ = 1024, ZC_SK = 1536, ZC_SV = 1664, ZC_DQ = 1792, ZC_DK = 2048, ZC_DV = 2304, ZC_G = 2560;
constexpr float EPS = 1e-6f;
constexpr float DQ_SCALE = 0.17677669529663687f * 1.4426950408889634f;
constexpr int NWAVES = 8, NTHREADS = 512;

constexpr size_t MiB = 1u << 20;
constexpr size_t WS_W = 2 * MiB;
constexpr size_t W_LAYER = 24 * MiB, W_IN = 0, W_OUT = 6 * MiB, W_UP = 8 * MiB, W_DOWN = 16 * MiB;
constexpr size_t WS_ROPE = 50 * MiB;
constexpr size_t WS_RS = 52 * MiB;
constexpr size_t WS_XB = 54 * MiB;
constexpr size_t WS_MIX = 182 * MiB;
constexpr size_t WS_U = 310 * MiB;
constexpr size_t WS_ZB = 310 * MiB;
constexpr size_t WS_CAT = 662 * MiB;
constexpr size_t WS_DC = 822 * MiB;
constexpr size_t WS_DN = 854 * MiB;
constexpr size_t WS_DEC = 855 * MiB;
constexpr size_t WS_CS = 856 * MiB;
constexpr size_t WS_NS = 872 * MiB;
constexpr size_t WS_END = 874 * MiB;

constexpr int LDS_BYTES = 147456;

struct Params {
    const float* in[20];
    float* out;
    unsigned char* ws;
    int ph_lo, ph_hi;
};

__device__ __forceinline__ unsigned pk2(float lo, float hi) { f32x2 v = {lo, hi}; bf16x2_t b = __builtin_convertvector(v, bf16x2_t); return __builtin_bit_cast(unsigned, b); }
__device__ __forceinline__ bf16_t f2bf(float f) { return (bf16_t)(pk2(f, 0.f) & 0xffffu); }
__device__ __forceinline__ float bf2f(unsigned u16) { return __uint_as_float(u16 << 16); }
__device__ __forceinline__ float bflo(unsigned w) { return __uint_as_float(w << 16); }
__device__ __forceinline__ float bfhi(unsigned w) { return __uint_as_float(w & 0xffff0000u); }
__device__ __forceinline__ int crow(int i, int h) { return (i & 3) + 8 * (i >> 2) + 4 * h; }
__device__ __forceinline__ float wave_sum(float v) {
#pragma unroll
    for (int o = 1; o < 64; o <<= 1) v += __shfl_xor(v, o);
    return v;
}
__device__ __forceinline__ float swap_add(float v) { auto rr = __builtin_amdgcn_permlane32_swap(__float_as_uint(v), __float_as_uint(v), false, false); return __uint_as_float(rr[0]) + __uint_as_float(rr[1]); }
__device__ __forceinline__ float swap_max(float v) { auto rr = __builtin_amdgcn_permlane32_swap(__float_as_uint(v), __float_as_uint(v), false, false); return fmaxf(__uint_as_float(rr[0]), __uint_as_float(rr[1])); }
#define MFMA32(a, b, c) __builtin_amdgcn_mfma_f32_32x32x16_bf16((a), (b), (c), 0, 0, 0)
__device__ __forceinline__ bf16x8 pack8(const f32x16& x, int s) {
    u32x4 p; p.x = pk2(x[8 * s], x[8 * s + 1]); p.y = pk2(x[8 * s + 2], x[8 * s + 3]); p.z = pk2(x[8 * s + 4], x[8 * s + 5]); p.w = pk2(x[8 * s + 6], x[8 * s + 7]);
    return __builtin_bit_cast(bf16x8, p);
}
__device__ __forceinline__ bf16x8 lds16(lds_t p) { return *(const LAS bf16x8*)p; }
__device__ __forceinline__ bf16x8 lds8x2(lds_t p0, lds_t p1) { s16x4 a = *(const LAS s16x4*)p0, b = *(const LAS s16x4*)p1; return __builtin_shufflevector(a, b, 0, 1, 2, 3, 4, 5, 6, 7); }
__device__ __forceinline__ float sigmoidf_(float x) { return 1.f / (1.f + __expf(-x)); }
__device__ __forceinline__ float logsigmoidf_(float x) { return fminf(x, 0.f) - log1pf(__expf(-fabsf(x))); }

__device__ __forceinline__ int otid() { int t = threadIdx.x; asm volatile("" : "+v"(t)); return t; }
template <class T> __device__ __forceinline__ T* optr(T* p) { asm volatile("" : "+s"(p)); return p; }
namespace pg8 {
constexpr int BM = 256, BK = 64, HALF = 128, HTB = HALF * BK * 2, STAGE_BYTES = 8 * HTB, NXCD = 8, WGM = 8;
__host__ __device__ __forceinline__ int lds_byte(int r, int c) { const int st = (r >> 4) * 2 + (c >> 5), rr = r & 15, cc = c & 31, ob = rr * 64 + cc * 2; return st * 1024 + (ob ^ (((ob >> 9) & 1) << 5)); }
__host__ __device__ __forceinline__ void stage_rc(int b, int& R, int& C) { const int st = b / 1024, sb = b % 1024, swz = sb ^ (((sb >> 9) & 1) << 5); R = (st >> 1) * 16 + swz / 64; C = (st & 1) * 32 + (swz % 64) / 2; }
__host__ __device__ __forceinline__ int perm32(int rho) { const int n = rho >> 4, i = rho & 15; return 8 * (i >> 2) + 4 * n + (i & 3); }
struct Unit { int pm, pn; };
struct Gemm { const bf16_t* A; const bf16_t* Bt; int M, N, K; };
struct StaticOrder {
    int nM, nN, nwg, G, c;
    __host__ __device__ void init(int M, int N, int G_, int c_) { nM = M / BM; nN = N / BM; nwg = nM * nN; G = G_; c = c_; }
    __host__ __device__ bool next(int i, Unit& u) const {
        const long L = (long)i * G + c; if (L >= nwg) return false;
        int wgid = (int)L; { const int q = nwg / NXCD, r = nwg % NXCD, xcd = wgid % NXCD, off = wgid / NXCD; wgid = (xcd < r ? xcd * (q + 1) : r * (q + 1) + (xcd - r) * q) + off; }
        const int nig = WGM * nN, gid = wgid / nig, fm = gid * WGM, gsz = (nM - fm) < WGM ? (nM - fm) : WGM;
        u.pm = fm + ((wgid % nig) % gsz); u.pn = (wgid % nig) / gsz; return true;
    }
    __device__ __forceinline__ void a_ready(const Unit&) const {}
    __device__ __forceinline__ void done(const Unit&) const {}
};

template <int ACT> struct EpiRow {
    static constexpr bool PERM = true, AFTER_DRAIN = false;
    bf16_t* O; int ldc; const float* rs;
    __device__ __forceinline__ void operator()(const f32x4 (&acc)[2][2][4][2], const Unit& u, int wr, int wc, int fr, int fq) const {
        const int row0 = u.pm * BM + wr * 64 + fr, col0 = u.pn * BM + wc * 32 + 8 * fq;
#pragma unroll
        for (int ai = 0; ai < 2; ++ai)
#pragma unroll
            for (int m = 0; m < 4; ++m) { const int row = row0 + ai * HALF + m * 16; const float s = rs ? rs[row] : 1.f; bf16_t* rowp = O + (size_t)row * ldc + col0;
#pragma unroll
                for (int bj = 0; bj < 2; ++bj) { f32x4 v0 = acc[ai][bj][m][0] * s, v1 = acc[ai][bj][m][1] * s;
                    if (ACT == 1) {
#pragma unroll
                        for (int i = 0; i < 4; ++i) { const float a = fmaxf(v0[i], 0.f), b = fmaxf(v1[i], 0.f); v0[i] = a * a; v1[i] = b * b; } }
                    u32x4 w; w.x = pk2(v0[0], v0[1]); w.y = pk2(v0[2], v0[3]); w.z = pk2(v1[0], v1[1]); w.w = pk2(v1[2], v1[3]);
                    *(u32x4*)(rowp + bj * HALF) = w; } }
    }
};
struct EpiInProj {
    static constexpr bool PERM = true, AFTER_DRAIN = false;
    bf16_t* O; const float* rs; const f32x2* rope;
    __device__ __forceinline__ void operator()(const f32x4 (&acc)[2][2][4][2], const Unit& u, int wr, int wc, int fr, int fq) const {
        const int row0 = u.pm * BM + wr * 64 + fr, col0 = u.pn * BM + wc * 32 + 8 * fq;
        const int pn = u.pn;
        const int j64 = 4 * (wc & 1) + fq;
#pragma unroll
        for (int ai = 0; ai < 2; ++ai)
#pragma unroll
            for (int m = 0; m < 4; ++m) { const int row = row0 + ai * HALF + m * 16; const float s = rs[row]; bf16_t* rowp = O + (size_t)row * ZP + col0;
                const f32x2* tb = rope + (size_t)(row & (SEQ - 1)) * 32;
#pragma unroll
                for (int bj = 0; bj < 2; ++bj) { f32x4 v0 = acc[ai][bj][m][0] * s, v1 = acc[ai][bj][m][1] * s;
                    const bool r64 = (pn == 4) || (pn == 5) || (pn == 6 && bj == 0), r32 = (pn == 7) || (pn == 8);
                    if (r64 || r32) {
                        f32x2 cs[4];
                        if (r64) { const f32x4 t0 = *(const f32x4*)(tb + 4 * j64), t1 = *(const f32x4*)(tb + 4 * j64 + 2); cs[0] = (f32x2){t0[0], t0[1]}; cs[1] = (f32x2){t0[2], t0[3]}; cs[2] = (f32x2){t1[0], t1[1]}; cs[3] = (f32x2){t1[2], t1[3]}; }
                        else {
#pragma unroll
                            for (int i = 0; i < 4; ++i) cs[i] = tb[8 * fq + 2 * i]; }
#pragma unroll
                        for (int i = 0; i < 4; ++i) { const float a = v0[i], b = v1[i]; v0[i] = a * cs[i].x - b * cs[i].y; v1[i] = b * cs[i].x + a * cs[i].y; }
                        if (pn == 7) { v0 = v0 * DQ_SCALE; v1 = v1 * DQ_SCALE; }
                    }
                    u32x4 w; w.x = pk2(v0[0], v0[1]); w.y = pk2(v0[2], v0[3]); w.z = pk2(v1[0], v1[1]); w.w = pk2(v1[2], v1[3]);
                    *(u32x4*)(rowp + bj * HALF) = w; } }
    }
};

template <class Epi, class Sched, bool ALIGN_EPI = false, bool SP2 = false>
__device__ __forceinline__ void gemm_phase(lds_t lds, const Gemm g, const Sched& S, const Epi& E) {
    const int tid = otid(), wid = __builtin_amdgcn_readfirstlane(tid >> 6), lane = tid & 63, wr = wid >> 2, wc = wid & 3, fr = lane & 15, fq = lane >> 4;
    const int K = g.K, nt = K / BK;
    unsigned voffA[2], voffB[2];
#pragma unroll
    for (int i = 0; i < 2; ++i) { int R, C; stage_rc(tid * 16 + i * 8192, R, C); const int Rb = Epi::PERM ? ((R & ~31) + perm32(R & 31)) : R;
        voffA[i] = (unsigned)(R * K + C) * 2u; voffB[i] = (unsigned)(Rb * K + C) * 2u; }
    const size_t kstep = (size_t)(BK * 2);
    const size_t hstep = (size_t)HALF * K * 2;
    const size_t tstep = 2 * hstep;
    const unsigned ldsw = (unsigned)wid * 1024u;
    const int aoff = lds_byte(wr * 64 + fr, fq * 8), boff = lds_byte(wc * 32 + fr, fq * 8);
#define PG8_SA(b, h) (((b) * 2 + (h)) * HTB)
#define PG8_SB(b, h) ((4 + (b) * 2 + (h)) * HTB)
#define PG8_STAGE(bufoff, gbase, voff) do { _Pragma("unroll") for (int _i = 0; _i < 2; ++_i) \
        __builtin_amdgcn_global_load_lds((const unsigned*)((const char*)(gbase) + (voff)[_i]), (LAS unsigned*)(lds + (bufoff) + ldsw + _i * 8192), 16, 0, 0); } while (0)
#define PG8_LDA(dst, b, h) do { _Pragma("unroll") for (int m = 0; m < 4; ++m) _Pragma("unroll") for (int k = 0; k < 2; ++k) dst[m][k] = *(const LAS bf16x8*)(lds + PG8_SA(b, h) + aoff + m * 2048 + k * 1024); } while (0)
#define PG8_LDB(dst, b, h) do { _Pragma("unroll") for (int n = 0; n < 2; ++n) _Pragma("unroll") for (int k = 0; k < 2; ++k) dst[n][k] = *(const LAS bf16x8*)(lds + PG8_SB(b, h) + boff + n * 2048 + k * 1024); } while (0)
#define PG8_MMA(ai, bj, At, Bt) do { __builtin_amdgcn_s_setprio(1); _Pragma("unroll") for (int m = 0; m < 4; ++m) _Pragma("unroll") for (int n = 0; n < 2; ++n) _Pragma("unroll") for (int k = 0; k < 2; ++k) \
        acc[ai][bj][m][n] = __builtin_amdgcn_mfma_f32_16x16x32_bf16(Bt[n][k], At[m][k], acc[ai][bj][m][n], 0, 0, 0); __builtin_amdgcn_s_setprio(0); } while (0)
#define PG8_WAIT_V(n) asm volatile("s_waitcnt vmcnt(" #n ")" ::: "memory")
#define PG8_WAIT_L(n) asm volatile("s_waitcnt lgkmcnt(" #n ")" ::: "memory")
#define PG8_BAR __builtin_amdgcn_s_barrier()
#define PG8_SCHED __builtin_amdgcn_sched_barrier(0)
    Unit cur, nxt; int ui = 0;
    if (!S.next(0, cur)) return;
    f32x4 acc[2][2][4][2];
#pragma unroll
    for (int a = 0; a < 2; ++a)
#pragma unroll
        for (int b = 0; b < 2; ++b)
#pragma unroll
            for (int m = 0; m < 4; ++m)
#pragma unroll
                for (int n = 0; n < 2; ++n) acc[a][b][m][n] = (f32x4){0.f, 0.f, 0.f, 0.f};
    bf16x8 At[4][2], B0[2][2], B1[2][2];
    const char* cA = (const char*)g.A + (size_t)cur.pm * tstep; const char* cB = (const char*)g.Bt + (size_t)cur.pn * tstep;
    S.a_ready(cur);
    if constexpr (SP2) {
        PG8_STAGE(PG8_SB(0, 0), cB, voffB); PG8_STAGE(PG8_SB(0, 1), cB + hstep, voffB); PG8_STAGE(PG8_SA(0, 0), cA, voffA); PG8_STAGE(PG8_SA(0, 1), cA + hstep, voffA);
        if (wr == 1) PG8_BAR;
        PG8_WAIT_V(2); PG8_BAR;
        PG8_STAGE(PG8_SB(1, 0), cB + kstep, voffB); PG8_STAGE(PG8_SA(1, 0), cA + kstep, voffA); PG8_STAGE(PG8_SB(1, 1), cB + hstep + kstep, voffB);
        PG8_WAIT_V(6); PG8_BAR;
    } else {
        PG8_STAGE(PG8_SB(0, 0), cB, voffB); PG8_STAGE(PG8_SA(0, 0), cA, voffA); PG8_STAGE(PG8_SB(0, 1), cB + hstep, voffB); PG8_STAGE(PG8_SA(0, 1), cA + hstep, voffA);
        if (wr == 1) PG8_BAR;
        PG8_WAIT_V(4); PG8_BAR;
        PG8_STAGE(PG8_SB(1, 0), cB + kstep, voffB); PG8_STAGE(PG8_SA(1, 0), cA + kstep, voffA); PG8_STAGE(PG8_SB(1, 1), cB + hstep + kstep, voffB);
        PG8_WAIT_V(6); PG8_BAR;
    }
    for (;;) {
        const bool has_next = S.next(ui + 1, nxt);
        const char* nA = has_next ? (const char*)g.A + (size_t)nxt.pm * tstep : cA; const char* nB = has_next ? (const char*)g.Bt + (size_t)nxt.pn * tstep : cB;
        for (int t = 0; t < nt; t += 2) {
            const bool last = (t == nt - 2);
            const char* a1 = cA + (size_t)(t + 1) * kstep;
            const char* a2 = last ? nA : cA + (size_t)(t + 2) * kstep; const char* b2 = last ? nB : cB + (size_t)(t + 2) * kstep;
            const char* a3 = a2 + kstep; const char* b3 = b2 + kstep;
            if (last && has_next) S.a_ready(nxt);
            if constexpr (SP2) {
            PG8_LDB(B0, 0, 0); PG8_LDB(B1, 0, 1); PG8_SCHED; PG8_LDA(At, 0, 0); PG8_STAGE(PG8_SA(1, 1), a1 + hstep, voffA);
            PG8_WAIT_V(8); PG8_WAIT_L(0); PG8_BAR; PG8_MMA(0, 0, At, B0); PG8_MMA(0, 1, At, B1); PG8_BAR; PG8_SCHED;
            PG8_LDA(At, 0, 1); PG8_STAGE(PG8_SB(0, 0), b2, voffB); PG8_STAGE(PG8_SB(0, 1), b2 + hstep, voffB); PG8_STAGE(PG8_SA(0, 0), a2, voffA);
            PG8_WAIT_V(8); PG8_WAIT_L(0); PG8_BAR; PG8_MMA(1, 0, At, B0); PG8_MMA(1, 1, At, B1); PG8_BAR; PG8_SCHED;
            PG8_LDB(B0, 1, 0); PG8_LDB(B1, 1, 1); PG8_SCHED; PG8_LDA(At, 1, 0); PG8_STAGE(PG8_SA(0, 1), a2 + hstep, voffA);
            PG8_WAIT_V(8); PG8_WAIT_L(0); PG8_BAR; PG8_MMA(0, 0, At, B0); PG8_MMA(0, 1, At, B1); PG8_BAR; PG8_SCHED;
            PG8_LDA(At, 1, 1); PG8_STAGE(PG8_SB(1, 0), b3, voffB); PG8_STAGE(PG8_SB(1, 1), b3 + hstep, voffB); PG8_STAGE(PG8_SA(1, 0), a3, voffA);
            PG8_WAIT_V(8); PG8_WAIT_L(0); PG8_BAR; PG8_MMA(1, 0, At, B0); PG8_MMA(1, 1, At, B1); PG8_BAR; PG8_SCHED;
            } else {
            PG8_LDB(B0, 0, 0); PG8_SCHED; PG8_LDA(At, 0, 0); PG8_STAGE(PG8_SA(1, 1), a1 + hstep, voffA);
            PG8_WAIT_L(8); PG8_BAR; PG8_WAIT_L(0); PG8_MMA(0, 0, At, B0); PG8_BAR; PG8_SCHED;
            PG8_LDB(B1, 0, 1); PG8_STAGE(PG8_SB(0, 0), b2, voffB);
            PG8_BAR; PG8_WAIT_L(0); PG8_MMA(0, 1, At, B1); PG8_BAR;
            PG8_LDA(At, 0, 1); PG8_STAGE(PG8_SA(0, 0), a2, voffA);
            PG8_BAR; PG8_WAIT_L(0); PG8_MMA(1, 0, At, B0); PG8_BAR; PG8_SCHED;
            PG8_STAGE(PG8_SB(0, 1), b2 + hstep, voffB);
            PG8_WAIT_V(6); PG8_BAR; PG8_MMA(1, 1, At, B1); PG8_BAR;
            PG8_LDB(B0, 1, 0); PG8_SCHED; PG8_LDA(At, 1, 0); PG8_STAGE(PG8_SA(0, 1), a2 + hstep, voffA);
            PG8_WAIT_L(8); PG8_BAR; PG8_WAIT_L(0); PG8_MMA(0, 0, At, B0); PG8_BAR; PG8_SCHED;
            PG8_LDB(B1, 1, 1); PG8_STAGE(PG8_SB(1, 0), b3, voffB);
            PG8_BAR; PG8_WAIT_L(0); PG8_MMA(0, 1, At, B1); PG8_BAR;
            PG8_LDA(At, 1, 1); PG8_STAGE(PG8_SA(1, 0), a3, voffA);
            PG8_BAR; PG8_WAIT_L(0); PG8_MMA(1, 0, At, B0); PG8_BAR; PG8_SCHED;
            PG8_STAGE(PG8_SB(1, 1), b3 + hstep, voffB);
            PG8_WAIT_V(6); PG8_BAR; PG8_MMA(1, 1, At, B1); PG8_BAR;
            }
        }
        if constexpr (ALIGN_EPI) { if (wr == 0) PG8_BAR; }
        E(acc, cur, wr, wc, fr, fq); S.done(cur);
        if (!has_next) break;
#pragma unroll
        for (int a = 0; a < 2; ++a)
#pragma unroll
            for (int b = 0; b < 2; ++b)
#pragma unroll
                for (int m = 0; m < 4; ++m)
#pragma unroll
                    for (int n = 0; n < 2; ++n) acc[a][b][m][n] = (f32x4){0.f, 0.f, 0.f, 0.f};
        cur = nxt; cA = nA; cB = nB; ++ui;
        if constexpr (ALIGN_EPI) { if (wr == 1) PG8_BAR; }
    }
    PG8_WAIT_V(0);
    if constexpr (!ALIGN_EPI) { if (wr == 0) PG8_BAR; }
    PG8_BAR;
#undef PG8_SA
#undef PG8_SB
#undef PG8_STAGE
#undef PG8_LDA
#undef PG8_LDB
#undef PG8_MMA
#undef PG8_WAIT_V
#undef PG8_WAIT_L
#undef PG8_BAR
#undef PG8_SCHED
}
}

__device__ __forceinline__ int zsrc(int c) {
    if (c < 1024) return c;
    if (c < ZC_SK) { const int x = c - ZC_SQ, hh = x >> 6, p = x & 63, j = p >> 3, i = p & 7; return 1032 + hh * 64 + (i < 4 ? 4 * j + i : 32 + 4 * j + (i - 4)); }
    if (c < ZC_SV) { const int x = c - ZC_SK, hh = x >> 6, p = x & 63, j = p >> 3, i = p & 7; return 1544 + hh * 64 + (i < 4 ? 4 * j + i : 32 + 4 * j + (i - 4)); }
    if (c < ZC_DQ) return 1672 + (c - ZC_SV);
    if (c < ZC_DK) { const int x = c - ZC_DQ, hh = x >> 5, p = x & 31, j = p >> 3, i = p & 7; return 1800 + hh * 32 + (i < 4 ? 4 * j + i : 16 + 4 * j + (i - 4)); }
    if (c < ZC_DV) { const int x = c - ZC_DK, hh = x >> 5, p = x & 31, j = p >> 3, i = p & 7; return 2056 + hh * 32 + (i < 4 ? 4 * j + i : 16 + 4 * j + (i - 4)); }
    if (c < ZC_G) return 2312 + (c - ZC_DV);
    if (c < ZC_G + 8) return 1024 + (c - ZC_G);
    return -1;
}
template <bool MAPZ> __device__ __forceinline__ void transpose_item(const float* W, int K, int N, int Nst, const float* gk, bf16_t* WT, LAS float* scr, int item, int lane) {
    const int nblk = Nst / 32, kb = item / nblk, nb = item % nblk, k0 = 64 * kb, n0 = 32 * nb;
    const int nsrc = MAPZ ? zsrc(n0 + (lane & 31)) : (n0 + (lane & 31));
#pragma unroll 8
    for (int i = 0; i < 32; ++i) { const int kk = 2 * i + (lane >> 5); float v = 0.f; if (nsrc >= 0) v = W[(size_t)(k0 + kk) * N + nsrc]; if (gk) v *= gk[k0 + kk]; scr[kk * 33 + (lane & 31)] = v; }
    asm volatile("s_waitcnt lgkmcnt(0)" ::: "memory");
    const int c = lane & 7;
#pragma unroll
    for (int j = 0; j < 4; ++j) { const int n = (lane >> 3) + 8 * j; const LAS float* s = scr + (8 * c) * 33 + n;
        u32x4 o; o.x = pk2(s[0 * 33], s[1 * 33]); o.y = pk2(s[2 * 33], s[3 * 33]); o.z = pk2(s[4 * 33], s[5 * 33]); o.w = pk2(s[6 * 33], s[7 * 33]);
        *(u32x4*)(WT + (size_t)(n0 + n) * K + k0 + 8 * c) = o; }
    asm volatile("s_waitcnt lgkmcnt(0)" ::: "memory");
}
__device__ __forceinline__ void sincos_red(double x, float& c, float& s) {
    const double k = rint(x * 0.15915494309189535), r = x - k * 6.283185307179586, r2 = r * r;
    double sn = 1.0, cs = 1.0;
#pragma unroll
    for (int n = 14; n >= 1; --n) { sn = 1.0 - r2 * (1.0 / (double)((2 * n) * (2 * n + 1))) * sn; cs = 1.0 - r2 * (1.0 / (double)((2 * n - 1) * (2 * n))) * cs; }
    s = (float)(r * sn); c = (float)cs;
}
__device__ __forceinline__ void row_to_bf16(const float* xrow, bf16_t* orow, float* rs, int lane) {
    const f32x4* xr = (const f32x4*)xrow + lane;
    f32x4 v[4]; float s = 0.f;
#pragma unroll
    for (int j = 0; j < 4; ++j) { v[j] = xr[64 * j]; s += (v[j].x * v[j].x + v[j].y * v[j].y) + (v[j].z * v[j].z + v[j].w * v[j].w); }
    s = wave_sum(s);
    u32x2* o8 = (u32x2*)orow + lane;
#pragma unroll
    for (int j = 0; j < 4; ++j) o8[64 * j] = (u32x2){pk2(v[j].x, v[j].y), pk2(v[j].z, v[j].w)};
    if (lane == 0) *rs = 1.f / sqrtf(s * (1.f / DM) + EPS);
}
__device__ __forceinline__ void prologue(const Params& P, lds_t lds, int G) {
    const int tid = otid(), lane = tid & 63, wave = tid >> 6; unsigned char* const ws_ = optr(P.ws);
    LAS float* scr = (LAS float*)(lds + wave * 16384);
    const int gw = blockIdx.x * NWAVES + wave, NGW = G * NWAVES;
    constexpr int I_IN = (DM / 64) * (ZP / 32), I_OUT = (DM / 64) * (DM / 32), I_UP = (DM / 64) * (FF / 32), I_DN = (FF / 64) * (DM / 32), I_L = I_IN + I_OUT + I_UP + I_DN;
    for (int it = gw; it < 2 * I_L; it += NGW) {
        const int l = it / I_L; int r = it % I_L;
        unsigned char* wb = ws_ + WS_W + (size_t)l * W_LAYER;
        if (r < I_IN) { transpose_item<true>(P.in[1] + (size_t)l * DM * INW, DM, INW, ZP, P.in[16] + l * DM, (bf16_t*)(wb + W_IN), scr, r, lane); continue; } r -= I_IN;
        if (r < I_OUT) { transpose_item<false>(P.in[13] + (size_t)l * DM * DM, DM, DM, DM, nullptr, (bf16_t*)(wb + W_OUT), scr, r, lane); continue; } r -= I_OUT;
        if (r < I_UP) { transpose_item<false>(P.in[14] + (size_t)l * DM * FF, DM, FF, FF, P.in[18] + l * DM, (bf16_t*)(wb + W_UP), scr, r, lane); continue; } r -= I_UP;
        transpose_item<false>(P.in[15] + (size_t)l * FF * DM, FF, DM, DM, nullptr, (bf16_t*)(wb + W_DOWN), scr, r, lane);
    }
    f32x2* rope = (f32x2*)(ws_ + WS_ROPE);
    for (int e = blockIdx.x * NTHREADS + tid; e < SEQ * 32; e += G * NTHREADS) {
        const int pos = e >> 5, i = e & 31;
        const float inv = (float)exp(-(double)i * (9.210340371976184 / 32.0));
        const float ang = (float)pos * inv;
        float c, s; sincos_red((double)ang, c, s);
        rope[e] = (f32x2){c, s};
    }
    bf16_t* XB = (bf16_t*)(ws_ + WS_XB); float* RS = (float*)(ws_ + WS_RS);
    for (int m = gw; m < NTOK; m += NGW) row_to_bf16(P.in[0] + (size_t)m * DM, XB + (size_t)m * DM, RS + m, lane);
}

__device__ __forceinline__ void resid_pass(const Params& P, const float* gpost, bool last, int G) {
    const int tid = otid(), lane = tid & 63, wave = tid >> 6; unsigned char* const ws_ = optr(P.ws);
    const int gw = blockIdx.x * NWAVES + wave, NGW = G * NWAVES;
    const bf16_t* MIX = (const bf16_t*)(ws_ + WS_MIX); bf16_t* XB = (bf16_t*)(ws_ + WS_XB); float* RS = (float*)(ws_ + WS_RS);
    f32x4 gv[4];
#pragma unroll
    for (int j = 0; j < 4; ++j) gv[j] = ((const f32x4*)gpost)[lane + 64 * j];
    for (int m = gw; m < NTOK; m += NGW) {
        const u32x2* mr = (const u32x2*)(MIX + (size_t)m * DM) + lane;
        u32x2* xr = (u32x2*)(XB + (size_t)m * DM) + lane;
        f32x4 mv[4], bv[4]; float s = 0.f;
#pragma unroll
        for (int j = 0; j < 4; ++j) { const u32x2 w = mr[64 * j]; mv[j] = (f32x4){bflo(w.x), bfhi(w.x), bflo(w.y), bfhi(w.y)}; const u32x2 xw = xr[64 * j]; bv[j] = (f32x4){bflo(xw.x), bfhi(xw.x), bflo(xw.y), bfhi(xw.y)};
            s += (mv[j].x * mv[j].x + mv[j].y * mv[j].y) + (mv[j].z * mv[j].z + mv[j].w * mv[j].w); }
        s = wave_sum(s);
        const float r = 1.f / sqrtf(s * (1.f / DM) + EPS);
        float s2 = 0.f;
#pragma unroll
        for (int j = 0; j < 4; ++j) { bv[j] = bv[j] + mv[j] * r * gv[j]; s2 += (bv[j].x * bv[j].x + bv[j].y * bv[j].y) + (bv[j].z * bv[j].z + bv[j].w * bv[j].w); }
        if (last) {
            f32x4* orow = (f32x4*)(P.out + (size_t)m * DM) + lane;
#pragma unroll
            for (int j = 0; j < 4; ++j) orow[64 * j] = bv[j];
        } else {
            s2 = wave_sum(s2);
#pragma unroll
            for (int j = 0; j < 4; ++j) xr[64 * j] = (u32x2){pk2(bv[j].x, bv[j].y), pk2(bv[j].z, bv[j].w)};
            if (lane == 0) RS[m] = 1.f / sqrtf(s2 * (1.f / DM) + EPS);
        }
    }
}

__device__ __forceinline__ void mlstm_gates(const bf16_t* Z, size_t t0, int hh, float ib, float fb, LAS float* bc, LAS float* ig, int tid) {
    if (tid < 64) {
        const int lane = tid;
        const bf16_t* g0 = Z + (t0 + 2 * lane) * ZP + ZC_G; const bf16_t* g1 = g0 + ZP;
        const float i0 = bf2f(g0[hh]) + ib, i1 = bf2f(g1[hh]) + ib;
        const float l0 = logsigmoidf_(bf2f(g0[4 + hh]) + fb), l1 = logsigmoidf_(bf2f(g1[4 + hh]) + fb);
        float x = l0 + l1;
#pragma unroll
        for (int o = 1; o < 64; o <<= 1) { const float t = __shfl_up(x, o); if (lane >= o) x += t; }
        bc[2 * lane] = x - l1; bc[2 * lane + 1] = x; ig[2 * lane] = i0; ig[2 * lane + 1] = i1;
    }
}
__device__ __forceinline__ void conv8(const bf16_t* zp, int tseq, const float* cw, const float* cb, int ch, float scale, float (&y)[8]) {
    const f32x4 b0 = *(const f32x4*)(cb + ch), b1 = *(const f32x4*)(cb + ch + 4);
    y[0] = b0[0]; y[1] = b0[1]; y[2] = b0[2]; y[3] = b0[3]; y[4] = b1[0]; y[5] = b1[1]; y[6] = b1[2]; y[7] = b1[3];
#pragma unroll
    for (int j = 0; j < 4; ++j) {
        if (tseq - 3 + j >= 0) {
            const u32x4 w = *(const u32x4*)(zp - (size_t)(3 - j) * ZP);
            const f32x4 c0 = *(const f32x4*)(cw + j * 512 + ch), c1 = *(const f32x4*)(cw + j * 512 + ch + 4);
            y[0] += bflo(w.x) * c0[0]; y[1] += bfhi(w.x) * c0[1]; y[2] += bflo(w.y) * c0[2]; y[3] += bfhi(w.y) * c0[3];
            y[4] += bflo(w.z) * c1[0]; y[5] += bfhi(w.z) * c1[1]; y[6] += bflo(w.w) * c1[2]; y[7] += bfhi(w.w) * c1[3];
        }
    }
#pragma unroll
    for (int i = 0; i < 8; ++i) y[i] = y[i] * sigmoidf_(y[i]) * scale;
}
constexpr int TS128 = 264;
constexpr int RS64 = 144;
__device__ __forceinline__ void mlstm_a_item(const Params& P, int l, int item, lds_t lds) {
    const int tid = otid(), lane = tid & 63, w = tid >> 6, r = lane & 31, h = lane >> 5; unsigned char* const ws_ = optr(P.ws);
    const int c = item & 63, hh = (item >> 6) & 3, b = item >> 8;
    const size_t t0 = (size_t)b * SEQ + (size_t)c * 128;
    const bf16_t* Z = (const bf16_t*)(ws_ + WS_ZB);
    const float* cw = P.in[2] + l * 4 * 512; const float* cb = P.in[3] + l * 512;
    lds_t KT = lds, VT = lds + 64 * TS128; LAS float* bc = (LAS float*)(lds + 2 * 64 * TS128); LAS float* ig = bc + 128; LAS float* wst = ig + 128;
    mlstm_gates(Z, t0, hh, P.in[4][l * 4 + hh], P.in[5][l * 4 + hh], bc, ig, tid);
    __syncthreads();
    const float blast = bc[127];
    if (tid < 128) wst[tid] = __expf(blast - bc[tid] + ig[tid]);
    __syncthreads();
#pragma unroll
    for (int q = 0; q < 2; ++q) {
        const int e = tid + q * 512, s = e >> 3, ch = e & 7;
        float y[8];
        conv8(Z + (t0 + s) * ZP + ZC_MK + hh * 64 + 8 * ch, c * 128 + s, cw, cb, 256 + hh * 64 + 8 * ch, 0.125f, y);
#pragma unroll
        for (int i = 0; i < 8; ++i) *(LAS bf16_t*)(KT + (8 * ch + i) * TS128 + s * 2) = f2bf(y[i]);
        const u32x4 vw = *(const u32x4*)(Z + (t0 + s) * ZP + ZC_MV + hh * 64 + 8 * ch);
        const float ws_ = wst[s];
        const float vv[8] = {bflo(vw.x), bfhi(vw.x), bflo(vw.y), bfhi(vw.y), bflo(vw.z), bfhi(vw.z), bflo(vw.w), bfhi(vw.w)};
#pragma unroll
        for (int i = 0; i < 8; ++i) *(LAS bf16_t*)(VT + (8 * ch + i) * TS128 + s * 2) = f2bf(vv[i] * ws_);
    }
    __syncthreads();
    float* DC = (float*)(ws_ + WS_DC) + (size_t)item * 4096; float* DN = (float*)(ws_ + WS_DN) + (size_t)item * 64; float* DEC = (float*)(ws_ + WS_DEC);
    if (w < 4) {
        const int vt = w >> 1, kt = w & 1;
        f32x16 acc = {};
#pragma unroll
        for (int ks = 0; ks < 8; ++ks) {
            const bf16x8 a = lds16(VT + (32 * vt + r) * TS128 + (16 * ks + 8 * h) * 2);
            const bf16x8 bb = lds16(KT + (32 * kt + r) * TS128 + (16 * ks + 8 * h) * 2);
            acc = MFMA32(a, bb, acc);
        }
#pragma unroll
        for (int i = 0; i < 16; ++i) DC[(32 * vt + crow(i, h)) * 64 + 32 * kt + r] = acc[i];
    } else if (w == 4) {
        float sum = 0.f;
#pragma unroll 4
        for (int s8 = 0; s8 < 16; ++s8) {
            const u32x4 kw = *(const LAS u32x4*)(KT + lane * TS128 + s8 * 16);
            const f32x4 w0 = *(const LAS f32x4*)(wst + 8 * s8), w1 = *(const LAS f32x4*)(wst + 8 * s8 + 4);
            sum += bflo(kw.x) * w0[0] + bfhi(kw.x) * w0[1] + bflo(kw.y) * w0[2] + bfhi(kw.y) * w0[3] + bflo(kw.z) * w1[0] + bfhi(kw.z) * w1[1] + bflo(kw.w) * w1[2] + bfhi(kw.w) * w1[3];
        }
        DN[lane] = sum;
    } else if (w == 5 && lane == 0) DEC[item] = __expf(blast);
    __syncthreads();
}
__device__ __forceinline__ void mlstm_scan(const Params& P, int G) {
    unsigned char* const ws_ = optr(P.ws); const int tid = otid();
    const float* DC = (const float*)(ws_ + WS_DC); const float* DN = (const float*)(ws_ + WS_DN); const float* DEC = (const float*)(ws_ + WS_DEC);
    bf16_t* CS = (bf16_t*)(ws_ + WS_CS); float* NS = (float*)(ws_ + WS_NS);
    for (int ch = blockIdx.x * NTHREADS + tid; ch < 32 * 4160; ch += G * NTHREADS) {
        const int seq = ch / 4160, e = ch % 4160;
        float st = 0.f;
        if (e < 4096) {
#pragma unroll 8
            for (int c = 0; c < 64; ++c) { const int it = seq * 64 + c; CS[(size_t)it * 4096 + e] = f2bf(st); st = DEC[it] * st + DC[(size_t)it * 4096 + e]; }
        } else {
            const int k = e - 4096;
#pragma unroll 8
            for (int c = 0; c < 64; ++c) { const int it = seq * 64 + c; NS[it * 64 + k] = st; st = DEC[it] * st + DN[it * 64 + k]; }
        }
    }
}
__device__ __forceinline__ void mlstm_c_item(const Params& P, int l, int item, lds_t lds) {
    const int tid = otid(), lane = tid & 63, w = tid >> 6, r = lane & 31, h = lane >> 5; unsigned char* const ws_ = optr(P.ws);
    const int c = item & 63, hh = (item >> 6) & 3, b = item >> 8;
    const size_t t0 = (size_t)b * SEQ + (size_t)c * 128;
    const bf16_t* Z = (const bf16_t*)(ws_ + WS_ZB);
    const float* cw = P.in[2] + l * 4 * 512; const float* cb = P.in[3] + l * 512;
    lds_t Qs = lds, Ks = Qs + 128 * RS64, VT = Ks + 128 * RS64, Cs = VT + 64 * TS128, Hs = Cs + 64 * RS64;
    LAS float* bc = (LAS float*)(Hs + 128 * RS64); LAS float* ig = bc + 128; LAS float* ns = ig + 128;
    mlstm_gates(Z, t0, hh, P.in[4][l * 4 + hh], P.in[5][l * 4 + hh], bc, ig, tid);
#pragma unroll
    for (int q = 0; q < 2; ++q) {
        const int e = tid + q * 512, s = e >> 3, ch = e & 7;
        float y[8];
        conv8(Z + (t0 + s) * ZP + ZC_MQ + hh * 64 + 8 * ch, c * 128 + s, cw, cb, hh * 64 + 8 * ch, 1.f, y);
        *(LAS u32x4*)(Qs + s * RS64 + ch * 16) = (u32x4){pk2(y[0], y[1]), pk2(y[2], y[3]), pk2(y[4], y[5]), pk2(y[6], y[7])};
        conv8(Z + (t0 + s) * ZP + ZC_MK + hh * 64 + 8 * ch, c * 128 + s, cw, cb, 256 + hh * 64 + 8 * ch, 0.125f, y);
        *(LAS u32x4*)(Ks + s * RS64 + ch * 16) = (u32x4){pk2(y[0], y[1]), pk2(y[2], y[3]), pk2(y[4], y[5]), pk2(y[6], y[7])};
        const u32x4 vw = *(const u32x4*)(Z + (t0 + s) * ZP + ZC_MV + hh * 64 + 8 * ch);
        const unsigned vv[4] = {vw.x, vw.y, vw.z, vw.w};
#pragma unroll
        for (int i = 0; i < 4; ++i) { *(LAS bf16_t*)(VT + (8 * ch + 2 * i) * TS128 + s * 2) = (bf16_t)(vv[i] & 0xffffu); *(LAS bf16_t*)(VT + (8 * ch + 2 * i + 1) * TS128 + s * 2) = (bf16_t)(vv[i] >> 16); }
    }
    { const int v = tid >> 3, ch = tid & 7; *(LAS u32x4*)(Cs + v * RS64 + ch * 16) = *(const u32x4*)((const bf16_t*)(ws_ + WS_CS) + (size_t)item * 4096 + v * 64 + ch * 8); }
    if (tid < 64) ns[tid] = ((const float*)(ws_ + WS_NS))[item * 64 + tid];
    __syncthreads();
    if (w < 4) {
        const int tt = w, tl = 32 * tt + r;
        bf16x8 qf[4];
#pragma unroll
        for (int ks = 0; ks < 4; ++ks) qf[ks] = lds16(Qs + tl * RS64 + (16 * ks + 8 * h) * 2);
        f32x16 num[2] = {};
#pragma unroll
        for (int vt = 0; vt < 2; ++vt)
#pragma unroll
            for (int ks = 0; ks < 4; ++ks) num[vt] = MFMA32(lds16(Cs + (32 * vt + r) * RS64 + (16 * ks + 8 * h) * 2), qf[ks], num[vt]);
        float nq = 0.f;
#pragma unroll
        for (int ks = 0; ks < 4; ++ks) {
            const u32x4 qw = __builtin_bit_cast(u32x4, qf[ks]);
            const f32x4 n0 = *(const LAS f32x4*)(ns + 16 * ks + 8 * h), n1 = *(const LAS f32x4*)(ns + 16 * ks + 8 * h + 4);
            nq += bflo(qw.x) * n0[0] + bfhi(qw.x) * n0[1] + bflo(qw.y) * n0[2] + bfhi(qw.y) * n0[3] + bflo(qw.z) * n1[0] + bfhi(qw.z) * n1[1] + bflo(qw.w) * n1[2] + bfhi(qw.w) * n1[3];
        }
        nq = swap_add(nq);
        const float bt = bc[tl], eb = __expf(bt);
#pragma unroll
        for (int vt = 0; vt < 2; ++vt)
#pragma unroll
            for (int i = 0; i < 16; ++i) num[vt][i] *= eb;
        float den = 0.f;
        for (int st = 0; st <= tt; ++st) {
            f32x16 S = {};
#pragma unroll
            for (int ks = 0; ks < 4; ++ks) S = MFMA32(lds16(Ks + (32 * st + r) * RS64 + (16 * ks + 8 * h) * 2), qf[ks], S);
#pragma unroll
            for (int i = 0; i < 16; ++i) { const int s = 32 * st + crow(i, h); const float wgt = (s <= tl) ? __expf(bt - bc[s] + ig[s]) : 0.f; S[i] *= wgt; den += S[i]; }
#pragma unroll
            for (int s2 = 0; s2 < 2; ++s2) { const bf16x8 pf = pack8(S, s2);
#pragma unroll
                for (int vt = 0; vt < 2; ++vt) { lds_t vp = VT + (32 * vt + r) * TS128 + (32 * st + 16 * s2 + 4 * h) * 2; num[vt] = MFMA32(lds8x2(vp, vp + 16), pf, num[vt]); } }
        }
        den = swap_add(den) + eb * nq;
        const float dinv = 1.f / fmaxf(fabsf(den), 1.f);
        float ss = 0.f;
#pragma unroll
        for (int vt = 0; vt < 2; ++vt)
#pragma unroll
            for (int i = 0; i < 16; ++i) { num[vt][i] *= dinv; ss += num[vt][i] * num[vt][i]; }
        ss = swap_add(ss);
        const float rn = 1.f / sqrtf(ss * (1.f / 64.f) + EPS);
#pragma unroll
        for (int vt = 0; vt < 2; ++vt)
#pragma unroll
            for (int i = 0; i < 16; ++i) *(LAS bf16_t*)(Hs + tl * RS64 + (32 * vt + crow(i, h)) * 2) = f2bf(num[vt][i] * rn);
    }
    __syncthreads();
    bf16_t* CAT = (bf16_t*)(ws_ + WS_CAT);
    const float* mg = P.in[6] + l * 256 + hh * 64;
#pragma unroll
    for (int q = 0; q < 2; ++q) {
        const int e = tid + q * 512, t = e >> 3, ch = e & 7;
        const u32x4 hw = *(const LAS u32x4*)(Hs + t * RS64 + ch * 16);
        const u32x4 ow = *(const u32x4*)(Z + (t0 + t) * ZP + ZC_MO + hh * 64 + 8 * ch);
        const f32x4 g0 = *(const f32x4*)(mg + 8 * ch), g1 = *(const f32x4*)(mg + 8 * ch + 4);
        u32x4 o;
        o.x = pk2(bflo(hw.x) * g0[0] * sigmoidf_(bflo(ow.x)), bfhi(hw.x) * g0[1] * sigmoidf_(bfhi(ow.x)));
        o.y = pk2(bflo(hw.y) * g0[2] * sigmoidf_(bflo(ow.y)), bfhi(hw.y) * g0[3] * sigmoidf_(bfhi(ow.y)));
        o.z = pk2(bflo(hw.z) * g1[0] * sigmoidf_(bflo(ow.z)), bfhi(hw.z) * g1[1] * sigmoidf_(bfhi(ow.z)));
        o.w = pk2(bflo(hw.w) * g1[2] * sigmoidf_(bflo(ow.w)), bfhi(hw.w) * g1[3] * sigmoidf_(bfhi(ow.w)));
        *(u32x4*)(CAT + (t0 + t) * DM + hh * 64 + 8 * ch) = o;
    }
    __syncthreads();
}

constexpr int TS256 = 520;
__device__ __forceinline__ void swa_item(const Params& P, int l, int item, lds_t lds) {
    const int tid = otid(), lane = tid & 63, w = tid >> 6, r = lane & 31, h = lane >> 5; unsigned char* const ws_ = optr(P.ws);
    const int kvh = item & 1, nb = (item >> 1) & 63, b = item >> 7;
    const size_t t0 = (size_t)b * SEQ + (size_t)nb * 128;
    const bf16_t* Z = (const bf16_t*)(ws_ + WS_ZB);
    lds_t Ks = lds, VT = lds + 256 * RS64, Os = VT + 64 * TS256;
#pragma unroll
    for (int q = 0; q < 4; ++q) {
        const int e = tid + q * 512, kb = e >> 3, ch = e & 7;
        u32x4 kw = {0u, 0u, 0u, 0u}, vw = {0u, 0u, 0u, 0u};
        if (nb > 0 || kb >= 128) { const bf16_t* zr = Z + (t0 - 128 + kb) * ZP; kw = *(const u32x4*)(zr + ZC_SK + kvh * 64 + 8 * ch); vw = *(const u32x4*)(zr + ZC_SV + kvh * 64 + 8 * ch); }
        *(LAS u32x4*)(Ks + kb * RS64 + ch * 16) = kw;
        const unsigned vv[4] = {vw.x, vw.y, vw.z, vw.w};
#pragma unroll
        for (int i = 0; i < 4; ++i) { *(LAS bf16_t*)(VT + (8 * ch + 2 * i) * TS256 + kb * 2) = (bf16_t)(vv[i] & 0xffffu); *(LAS bf16_t*)(VT + (8 * ch + 2 * i + 1) * TS256 + kb * 2) = (bf16_t)(vv[i] >> 16); }
    }
    __syncthreads();
    bf16_t* CAT = (bf16_t*)(ws_ + WS_CAT);
    lds_t Ow = Os + w * 32 * RS64;
    for (int cc = w; cc < 16; cc += 8) {
        const int hq = cc >> 2, qt = cc & 3, hg = kvh * 4 + hq, ql = 32 * qt + r;
        const float sink = P.in[7][l * 8 + hg];
        const bf16_t* qp = Z + (t0 + ql) * ZP + ZC_SQ + hg * 64;
        bf16x8 qf[4];
#pragma unroll
        for (int ks = 0; ks < 4; ++ks) qf[ks] = *(const bf16x8*)(qp + 16 * ks + 8 * h);
        f32x16 S[5];
        float mx = sink;
#pragma unroll
        for (int k5 = 0; k5 < 5; ++k5) {
            const int kt = qt + k5;
            S[k5] = (f32x16){};
#pragma unroll
            for (int ks = 0; ks < 4; ++ks) S[k5] = MFMA32(lds16(Ks + (32 * kt + r) * RS64 + (16 * ks + 8 * h) * 2), qf[ks], S[k5]);
#pragma unroll
            for (int i = 0; i < 16; ++i) { const int kb = 32 * kt + crow(i, h); const bool ok = (kb > ql) && (kb <= ql + 128) && (nb > 0 || kb >= 128);
                S[k5][i] = ok ? S[k5][i] * 0.125f : -1e30f; mx = fmaxf(mx, S[k5][i]); }
        }
        mx = swap_max(mx);
        float sum = 0.f;
#pragma unroll
        for (int k5 = 0; k5 < 5; ++k5)
#pragma unroll
            for (int i = 0; i < 16; ++i) { S[k5][i] = __expf(S[k5][i] - mx); sum += S[k5][i]; }
        sum = swap_add(sum) + __expf(sink - mx);
        const float inv = 1.f / sum;
        f32x16 O[2] = {};
#pragma unroll
        for (int k5 = 0; k5 < 5; ++k5) {
            const int kt = qt + k5;
#pragma unroll
            for (int i = 0; i < 16; ++i) S[k5][i] *= inv;
#pragma unroll
            for (int s2 = 0; s2 < 2; ++s2) { const bf16x8 pf = pack8(S[k5], s2);
#pragma unroll
                for (int dt = 0; dt < 2; ++dt) { lds_t vp = VT + (32 * dt + r) * TS256 + (32 * kt + 16 * s2 + 4 * h) * 2; O[dt] = MFMA32(lds8x2(vp, vp + 16), pf, O[dt]); } }
        }
#pragma unroll
        for (int dt = 0; dt < 2; ++dt)
#pragma unroll
            for (int i = 0; i < 16; ++i) *(LAS bf16_t*)(Ow + r * RS64 + (32 * dt + crow(i, h)) * 2) = f2bf(O[dt][i]);
        asm volatile("s_waitcnt lgkmcnt(0)" ::: "memory");
#pragma unroll
        for (int it = 0; it < 4; ++it) { const int row = it * 8 + (lane >> 3), ch = lane & 7; const u32x4 v = *(const LAS u32x4*)(Ow + row * RS64 + ch * 16);
            *(u32x4*)(CAT + (t0 + 32 * qt + row) * DM + 256 + hg * 64 + 8 * ch) = v; }
        asm volatile("s_waitcnt lgkmcnt(0)" ::: "memory");
    }
    __syncthreads();
}

typedef short v4i16_t __attribute__((ext_vector_type(4)));
__device__ __forceinline__ s16x4 vtr(lds_t p) { return __builtin_bit_cast(s16x4, __builtin_amdgcn_ds_read_tr16_b64_v4i16((LAS v4i16_t*)p)); }
constexpr int DKS = 144, DVS = 192;
constexpr int DK_BYTES = 64 * DKS, DV_BYTES = 64 * DVS, DBUF = DK_BYTES + DV_BYTES;
__device__ __forceinline__ void diff_item(const Params& P, int l, int seq, int qb, lds_t lds, float lam, float oscale) {
    const int tid = otid(), lane = tid & 63, w = tid >> 6, r = lane & 31, h = lane >> 5; unsigned char* const ws_ = optr(P.ws);
    const int b = seq >> 2, hd = seq & 3;
    const size_t row0 = (size_t)b * SEQ;
    const bf16_t* Z = (const bf16_t*)(ws_ + WS_ZB);
    const int qrow = qb * 256 + w * 32 + r, wmin = qb * 256 + w * 32;
    const bf16_t* qp = Z + (row0 + qrow) * ZP + ZC_DQ + hd * 64;
    bf16x8 qf[2][2];
#pragma unroll
    for (int m = 0; m < 2; ++m)
#pragma unroll
        for (int ks = 0; ks < 2; ++ks) qf[m][ks] = *(const bf16x8*)(qp + 32 * m + 16 * ks + 8 * h);
    f32x16 O[2][2] = {};
    f32x16 negm[2] = {};
    float mx[2] = {0.f, 0.f}, ls[2] = {0.f, 0.f};
    const int NT = 4 * qb + 4;
    const int skey = tid >> 3, sch = tid & 7;
    const bf16_t* kg = Z + (row0 + skey) * ZP + ZC_DK + hd * 64 + 8 * sch; const bf16_t* vg = Z + (row0 + skey) * ZP + ZC_DV + hd * 64 + 8 * sch;
    lds_t Os = lds + 2 * DBUF;
    u32x4 kreg = *(const u32x4*)kg, vreg = *(const u32x4*)vg;
    const int soffk = skey * DKS + sch * 16, soffv = DK_BYTES + skey * DVS + sch * 16;
    const int koff = r * DKS + 16 * h, voff = DK_BYTES + (((lane & 15) >> 2) + 4 * h) * DVS + (16 * ((lane >> 4) & 1) + 4 * (lane & 3)) * 2;
    *(LAS u32x4*)(lds + soffk) = kreg; *(LAS u32x4*)(lds + soffv) = vreg;
    __syncthreads();
    for (int kt = 0; kt < NT; ++kt) {
        if (kt + 1 < NT) { kreg = *(const u32x4*)(kg + (size_t)(kt + 1) * 64 * ZP); vreg = *(const u32x4*)(vg + (size_t)(kt + 1) * 64 * ZP); }
        if (64 * kt <= wmin + 31) {
            lds_t Tb = lds + (kt & 1) * DBUF;
            const bool needmask = (64 * kt + 63 > wmin);
            bf16x8 pf[2][2][2];
#pragma unroll
            for (int m = 0; m < 2; ++m) {
                f32x16 S0 = negm[m], S1 = negm[m];
#pragma unroll
                for (int ks = 0; ks < 2; ++ks) { S0 = MFMA32(lds16(Tb + koff + (32 * m + 16 * ks) * 2), qf[m][ks], S0); S1 = MFMA32(lds16(Tb + koff + 32 * DKS + (32 * m + 16 * ks) * 2), qf[m][ks], S1); }
                if (needmask) {
#pragma unroll
                    for (int i = 0; i < 16; ++i) { const int key = 64 * kt + crow(i, h); if (key > qrow) S0[i] = -1e30f; if (key + 32 > qrow) S1[i] = -1e30f; }
                }
                float ta = fmaxf(fmaxf(S0[0], S0[1]), S1[0]), tb = fmaxf(fmaxf(S0[2], S0[3]), S1[1]); ta = fmaxf(fmaxf(ta, S1[2]), S1[3]);
#pragma unroll
                for (int i = 4; i < 16; i += 4) { ta = fmaxf(fmaxf(ta, S0[i]), S0[i + 1]); tb = fmaxf(fmaxf(tb, S0[i + 2]), S0[i + 3]); ta = fmaxf(fmaxf(ta, S1[i]), S1[i + 1]); tb = fmaxf(fmaxf(tb, S1[i + 2]), S1[i + 3]); }
                const float tm = swap_max(fmaxf(ta, tb));
                if (kt == 0 || __any(tm > 8.f)) {
                    const float dl = (kt == 0) ? tm : fmaxf(tm, 0.f);
                    mx[m] += dl;
                    const float alpha = (kt == 0) ? 1.f : __builtin_amdgcn_exp2f(-dl);
                    ls[m] *= alpha;
#pragma unroll
                    for (int i = 0; i < 16; ++i) { S0[i] -= dl; S1[i] -= dl; O[m][0][i] *= alpha; O[m][1][i] *= alpha; negm[m][i] = -mx[m]; }
                }
                float sa = 0.f, sb = 0.f;
#pragma unroll
                for (int i = 0; i < 16; ++i) { S0[i] = __builtin_amdgcn_exp2f(S0[i]); S1[i] = __builtin_amdgcn_exp2f(S1[i]); sa += S0[i]; sb += S1[i]; }
                ls[m] += sa + sb;
                pf[m][0][0] = pack8(S0, 0); pf[m][0][1] = pack8(S0, 1); pf[m][1][0] = pack8(S1, 0); pf[m][1][1] = pack8(S1, 1);
            }
#pragma unroll
            for (int dt = 0; dt < 2; ++dt)
#pragma unroll
                for (int kh = 0; kh < 2; ++kh)
#pragma unroll
                    for (int s2 = 0; s2 < 2; ++s2) { lds_t vp = Tb + voff + (32 * kh + 16 * s2) * DVS + 64 * dt; const s16x4 lo = vtr(vp), hi = vtr(vp + 8 * DVS);
                        const bf16x8 vf = __builtin_shufflevector(lo, hi, 0, 1, 2, 3, 4, 5, 6, 7);
                        O[0][dt] = MFMA32(vf, pf[0][kh][s2], O[0][dt]); O[1][dt] = MFMA32(vf, pf[1][kh][s2], O[1][dt]); }
        }
        if (kt + 1 < NT) { lds_t Nb = lds + ((kt + 1) & 1) * DBUF; *(LAS u32x4*)(Nb + soffk) = kreg; *(LAS u32x4*)(Nb + soffv) = vreg; }
        __syncthreads();
    }
    const float i1 = 1.f / swap_add(ls[0]), i2 = lam / swap_add(ls[1]);
    float ss = 0.f;
#pragma unroll
    for (int dt = 0; dt < 2; ++dt)
#pragma unroll
        for (int i = 0; i < 16; ++i) { const float o = O[0][dt][i] * i1 - O[1][dt][i] * i2; O[0][dt][i] = o; ss += o * o; }
    ss = swap_add(ss);
    const float rn = oscale / sqrtf(ss * (1.f / 64.f) + EPS);
    lds_t Ow = Os + w * 32 * RS64;
#pragma unroll
    for (int dt = 0; dt < 2; ++dt)
#pragma unroll
        for (int i = 0; i < 16; ++i) *(LAS bf16_t*)(Ow + r * RS64 + (32 * dt + crow(i, h)) * 2) = f2bf(O[0][dt][i] * rn);
    asm volatile("s_waitcnt lgkmcnt(0)" ::: "memory");
    bf16_t* CAT = (bf16_t*)(ws_ + WS_CAT);
    const float* sg = P.in[12] + l * 64;
#pragma unroll
    for (int it = 0; it < 4; ++it) { const int row = it * 8 + (lane >> 3), ch = lane & 7; const u32x4 v = *(const LAS u32x4*)(Ow + row * RS64 + ch * 16);
        const f32x4 g0 = *(const f32x4*)(sg + 8 * ch), g1 = *(const f32x4*)(sg + 8 * ch + 4);
        u32x4 o; o.x = pk2(bflo(v.x) * g0[0], bfhi(v.x) * g0[1]); o.y = pk2(bflo(v.y) * g0[2], bfhi(v.y) * g0[3]); o.z = pk2(bflo(v.z) * g1[0], bfhi(v.z) * g1[1]); o.w = pk2(bflo(v.w) * g1[2], bfhi(v.w) * g1[3]);
        *(u32x4*)(CAT + (row0 + wmin + row) * DM + 768 + hd * 64 + 8 * ch) = o; }
    __syncthreads();
}

constexpr int N_PHASES = 19;
__global__ void __launch_bounds__(NTHREADS, 2) hybrid_fwd(Params P) {
    extern __shared__ __attribute__((aligned(16))) unsigned char lds_raw[];
    lds_t lds = (lds_t)lds_raw;
    cg::grid_group grid = cg::this_grid();
    const int G = gridDim.x, lo = P.ph_lo, hi = P.ph_hi;
    int ph = 0;
#define PHASE_BEGIN(k) if (((PH_MASK >> (k)) & 1) && lo <= ph && ph < hi) { for (int rep_ = 0; rep_ <= ((REP_MASK >> (k)) & 1); ++rep_) { if (rep_) grid.sync();
#define PHASE_END   } if (ph + 1 < hi) grid.sync(); } ++ph;
    PHASE_BEGIN(0) prologue(P, lds, G); PHASE_END
    for (int l = 0; l < 2; ++l) {
        unsigned char* wb = P.ws + WS_W + (size_t)l * W_LAYER;
        bf16_t* XB = (bf16_t*)(P.ws + WS_XB); float* RS = (float*)(P.ws + WS_RS);
        PHASE_BEGIN(1) {
            pg8::Gemm g{XB, (const bf16_t*)(wb + W_IN), NTOK, ZP, DM}; pg8::StaticOrder S; S.init(NTOK, ZP, G, (int)blockIdx.x);
            pg8::EpiInProj E{(bf16_t*)(P.ws + WS_ZB), RS, (const f32x2*)(P.ws + WS_ROPE)};
            pg8::gemm_phase<pg8::EpiInProj, pg8::StaticOrder, true, true>(lds, g, S, E);
        } PHASE_END
        PHASE_BEGIN(2) {
            for (int it = blockIdx.x; it < 2048; it += G) mlstm_a_item(P, l, it, lds);
            for (int it = blockIdx.x; it < 1024; it += G) swa_item(P, l, it, lds);
        } PHASE_END
        PHASE_BEGIN(3) {
            mlstm_scan(P, G);
            float d1 = 0.f, d2 = 0.f;
            for (int i = 0; i < 32; ++i) { d1 += P.in[8][l * 32 + i] * P.in[9][l * 32 + i]; d2 += P.in[10][l * 32 + i] * P.in[11][l * 32 + i]; }
            const float lam_init = 0.8f - 0.6f * expf(-0.3f * (float)l);
            const float lam = expf(d1) - expf(d2) + lam_init;
            for (int vg = blockIdx.x; vg < 256; vg += G) {
                const int seq = vg >> 3, j = vg & 7;
                diff_item(P, l, seq, 31 - j, lds, lam, 1.f - lam_init);
                diff_item(P, l, seq, 16 + j, lds, lam, 1.f - lam_init);
                diff_item(P, l, seq, 15 - j, lds, lam, 1.f - lam_init);
                diff_item(P, l, seq, j, lds, lam, 1.f - lam_init);
            }
        } PHASE_END
        PHASE_BEGIN(4) {
            for (int it = blockIdx.x; it < 2048; it += G) mlstm_c_item(P, l, it, lds);
        } PHASE_END
        PHASE_BEGIN(5) {
            pg8::Gemm g{(const bf16_t*)(P.ws + WS_CAT), (const bf16_t*)(wb + W_OUT), NTOK, DM, DM}; pg8::StaticOrder S; S.init(NTOK, DM, G, (int)blockIdx.x);
            pg8::EpiRow<0> E{(bf16_t*)(P.ws + WS_MIX), DM, nullptr};
            pg8::gemm_phase<pg8::EpiRow<0>, pg8::StaticOrder, true, true>(lds, g, S, E);
        } PHASE_END
        PHASE_BEGIN(6) resid_pass(P, P.in[17] + l * DM, false, G); PHASE_END
        PHASE_BEGIN(7) {
            pg8::Gemm g{XB, (const bf16_t*)(wb + W_UP), NTOK, FF, DM}; pg8::StaticOrder S; S.init(NTOK, FF, G, (int)blockIdx.x);
            pg8::EpiRow<1> E{(bf16_t*)(P.ws + WS_U), FF, RS};
            pg8::gemm_phase<pg8::EpiRow<1>, pg8::StaticOrder, true, true>(lds, g, S, E);
        } PHASE_END
        PHASE_BEGIN(8) {
            pg8::Gemm g{(const bf16_t*)(P.ws + WS_U), (const bf16_t*)(wb + W_DOWN), NTOK, DM, FF}; pg8::StaticOrder S; S.init(NTOK, DM, G, (int)blockIdx.x);
            pg8::EpiRow<0> E{(bf16_t*)(P.ws + WS_MIX), DM, nullptr};
            pg8::gemm_phase<pg8::EpiRow<0>, pg8::StaticOrder, true, true>(lds, g, S, E);
        } PHASE_END
        PHASE_BEGIN(9) resid_pass(P, P.in[19] + l * DM, l == 1, G); PHASE_END
    }
#undef PHASE_BEGIN
#undef PHASE_END
}

extern "C" void kernel_launch(void* const* d_in, const int* in_sizes, int n_in, void* d_out, int out_size, void* d_ws, size_t ws_size, hipStream_t stream) {
    static int grid = 0;
    if (grid == 0) {
        if (n_in != 20 || out_size != NTOK * DM || ws_size < WS_END) { fprintf(stderr, "kernel_launch: unexpected shapes (n_in %d out %d ws %zu)\n", n_in, out_size, ws_size); grid = -1; return; }
        int dev = 0, cus = 0, per_cu = 0;
        hipGetDevice(&dev); hipDeviceGetAttribute(&cus, hipDeviceAttributeMultiprocessorCount, dev);
        if (hipFuncSetAttribute((const void*)hybrid_fwd, hipFuncAttributeMaxDynamicSharedMemorySize, LDS_BYTES) != hipSuccess) { fprintf(stderr, "kernel_launch: hipFuncSetAttribute failed\n"); grid = -1; return; }
        if (hipOccupancyMaxActiveBlocksPerMultiprocessor(&per_cu, (const void*)hybrid_fwd, NTHREADS, LDS_BYTES) != hipSuccess || per_cu < 1) { fprintf(stderr, "kernel_launch: occupancy query says %d\n", per_cu); per_cu = 1; }
        (void)hipGetLastError();
        grid = cus;
    }
    if (grid < 0) return;
    Params p{};
    for (int i = 0; i < 20; ++i) p.in[i] = (const float*)d_in[i];
    p.out = (float*)d_out; p.ws = (unsigned char*)d_ws;
#if ONE_LAUNCH
    p.ph_lo = 0; p.ph_hi = N_PHASES;
    void* args[] = {&p};
    hipError_t e = hipLaunchCooperativeKernel((const void*)hybrid_fwd, dim3(grid), dim3(NTHREADS), args, LDS_BYTES, stream);
    if (e != hipSuccess) fprintf(stderr, "cooperative launch failed: %s (grid %d)\n", hipGetErrorString(e), grid);
#else
    for (int ph = 0; ph < N_PHASES; ++ph) {
        p.ph_lo = ph; p.ph_hi = ph + 1;
        hipLaunchKernelGGL(hybrid_fwd, dim3(grid), dim3(NTHREADS), LDS_BYTES, stream, p);
    }
#endif
}
```

```cpp
#include <hip/hip_runtime.h>
#include <hip/hip_cooperative_groups.h>
#include <cstdio>
#include <cstdint>
namespace cg = cooperative_groups;

#ifndef PH_MASK
#define PH_MASK 0x3ff
#endif
#ifndef REP_MASK
#define REP_MASK 0
#endif
#ifndef ONE_LAUNCH
#define ONE_LAUNCH 1
#endif

#define LAS __attribute__((address_space(3)))
typedef unsigned short bf16_t;
typedef short bf16x8 __attribute__((ext_vector_type(8)));
typedef short s16x4 __attribute__((ext_vector_type(4)));
typedef float f32x4 __attribute__((ext_vector_type(4)));
typedef float f32x2 __attribute__((ext_vector_type(2)));
typedef float f32x16 __attribute__((ext_vector_type(16)));
typedef unsigned u32x4 __attribute__((ext_vector_type(4)));
typedef unsigned u32x2 __attribute__((ext_vector_type(2)));
typedef __bf16 bf16x2_t __attribute__((ext_vector_type(2)));
typedef LAS unsigned char* lds_t;

constexpr int BATCH = 8, SEQ = 8192, DM = 1024, FF = 4096, NTOK = BATCH * SEQ;
constexpr int INW = 2568, ZP = 2816;
constexpr int ZC_MQ = 0, ZC_MK = 256, ZC_MV = 512, ZC_MO = 768, ZC_SQ = 1024, ZC_SK = 1536, ZC_SV = 1664, ZC_DQ = 1792, ZC_DK = 2048, ZC_DV = 2304, ZC_G = 2560;
constexpr float EPS = 1e-6f;
constexpr float DQ_SCALE = 0.17677669529663687f * 1.4426950408889634f;
constexpr int NWAVES = 8, NTHREADS = 512;

constexpr size_t MiB = 1u << 20;
constexpr size_t WS_W = 2 * MiB;
constexpr size_t W_LAYER = 24 * MiB, W_IN = 0, W_OUT = 6 * MiB, W_UP = 8 * MiB, W_DOWN = 16 * MiB;
constexpr size_t WS_ROPE = 50 * MiB;
constexpr size_t WS_RS = 52 * MiB;
constexpr size_t WS_XB = 54 * MiB;
constexpr size_t WS_MIX = 182 * MiB;
constexpr size_t WS_U = 310 * MiB;
constexpr size_t WS_ZB = 310 * MiB;
constexpr size_t WS_CAT = 662 * MiB;
constexpr size_t WS_DC = 822 * MiB;
constexpr size_t WS_DN = 854 * MiB;
constexpr size_t WS_DEC = 855 * MiB;
constexpr size_t WS_CS = 856 * MiB;
constexpr size_t WS_NS = 872 * MiB;
constexpr size_t WS_END = 874 * MiB;

constexpr int LDS_BYTES = 147456;

struct Params {
    const float* in[20];
    float* out;
    unsigned char* ws;
    int ph_lo, ph_hi;
};

__device__ __forceinline__ unsigned pk2(float lo, float hi) { f32x2 v = {lo, hi}; bf16x2_t b = __builtin_convertvector(v, bf16x2_t); return __builtin_bit_cast(unsigned, b); }
__device__ __forceinline__ bf16_t f2bf(float f) { return (bf16_t)(pk2(f, 0.f) & 0xffffu); }
__device__ __forceinline__ float bf2f(unsigned u16) { return __uint_as_float(u16 << 16); }
__device__ __forceinline__ float bflo(unsigned w) { return __uint_as_float(w << 16); }
__device__ __forceinline__ float bfhi(unsigned w) { return __uint_as_float(w & 0xffff0000u); }
__device__ __forceinline__ int crow(int i, int h) { return (i & 3) + 8 * (i >> 2) + 4 * h; }
__device__ __forceinline__ float wave_sum(float v) {
#pragma unroll
    for (int o = 1; o < 64; o <<= 1) v += __shfl_xor(v, o);
    return v;
}
__device__ __forceinline__ float swap_add(float v) { auto rr = __builtin_amdgcn_permlane32_swap(__float_as_uint(v), __float_as_uint(v), false, false); return __uint_as_float(rr[0]) + __uint_as_float(rr[1]); }
__device__ __forceinline__ float swap_max(float v) { auto rr = __builtin_amdgcn_permlane32_swap(__float_as_uint(v), __float_as_uint(v), false, false); return fmaxf(__uint_as_float(rr[0]), __uint_as_float(rr[1])); }
#define MFMA32(a, b, c) __builtin_amdgcn_mfma_f32_32x32x16_bf16((a), (b), (c), 0, 0, 0)
__device__ __forceinline__ bf16x8 pack8(const f32x16& x, int s) {
    u32x4 p; p.x = pk2(x[8 * s], x[8 * s + 1]); p.y = pk2(x[8 * s + 2], x[8 * s + 3]); p.z = pk2(x[8 * s + 4], x[8 * s + 5]); p.w = pk2(x[8 * s + 6], x[8 * s + 7]);
    return __builtin_bit_cast(bf16x8, p);
}
__device__ __forceinline__ bf16x8 lds16(lds_t p) { return *(const LAS bf16x8*)p; }
__device__ __forceinline__ bf16x8 lds8x2(lds_t p0, lds_t p1) { s16x4 a = *(const LAS s16x4*)p0, b = *(const LAS s16x4*)p1; return __builtin_shufflevector(a, b, 0, 1, 2, 3, 4, 5, 6, 7); }
__device__ __forceinline__ float sigmoidf_(float x) { return 1.f / (1.f + __expf(-x)); }
__device__ __forceinline__ float logsigmoidf_(float x) { return fminf(x, 0.f) - log1pf(__expf(-fabsf(x))); }

__device__ __forceinline__ int otid() { int t = threadIdx.x; asm volatile("" : "+v"(t)); return t; }
__device__ __forceinline__ size_t ozero() { unsigned z = 0; asm volatile("" : "+s"(z)); return (size_t)z; }
template <class T> __device__ __forceinline__ T* optr(T* p) { return p + ozero(); }
namespace pg8 {
constexpr int BM = 256, BK = 64, HALF = 128, HTB = HALF * BK * 2, STAGE_BYTES = 8 * HTB, NXCD = 8, WGM = 8;
__host__ __device__ __forceinline__ int lds_byte(int r, int c) { const int st = (r >> 4) * 2 + (c >> 5), rr = r & 15, cc = c & 31, ob = rr * 64 + cc * 2; return st * 1024 + (ob ^ (((ob >> 9) & 1) << 5)); }
__host__ __device__ __forceinline__ void stage_rc(int b, int& R, int& C) { const int st = b / 1024, sb = b % 1024, swz = sb ^ (((sb >> 9) & 1) << 5); R = (st >> 1) * 16 + swz / 64; C = (st & 1) * 32 + (swz % 64) / 2; }
__host__ __device__ __forceinline__ int perm32(int rho) { const int n = rho >> 4, i = rho & 15; return 8 * (i >> 2) + 4 * n + (i & 3); }
struct Unit { int pm, pn; };
struct Gemm { const bf16_t* A; const bf16_t* Bt; int M, N, K; };
struct StaticOrder {
    int nM, nN, nwg, G, c;
    __host__ __device__ void init(int M, int N, int G_, int c_) { nM = M / BM; nN = N / BM; nwg = nM * nN; G = G_; c = c_; }
    __host__ __device__ bool next(int i, Unit& u) const {
        const long L = (long)i * G + c; if (L >= nwg) return false;
        int wgid = (int)L; { const int q = nwg / NXCD, r = nwg % NXCD, xcd = wgid % NXCD, off = wgid / NXCD; wgid = (xcd < r ? xcd * (q + 1) : r * (q + 1) + (xcd - r) * q) + off; }
        const int nig = WGM * nN, gid = wgid / nig, fm = gid * WGM, gsz = (nM - fm) < WGM ? (nM - fm) : WGM;
        u.pm = fm + ((wgid % nig) % gsz); u.pn = (wgid % nig) / gsz; return true;
    }
    __device__ __forceinline__ void a_ready(const Unit&) const {}
    __device__ __forceinline__ void done(const Unit&) const {}
};

template <int ACT> struct EpiRow {
    static constexpr bool PERM = true, AFTER_DRAIN = false;
    bf16_t* O; int ldc; const float* rs;
    __device__ __forceinline__ void operator()(const f32x4 (&acc)[2][2][4][2], const Unit& u, int wr, int wc, int fr, int fq) const {
        const int row0 = u.pm * BM + wr * 64 + fr, col0 = u.pn * BM + wc * 32 + 8 * fq;
#pragma unroll
        for (int ai = 0; ai < 2; ++ai)
#pragma unroll
            for (int m = 0; m < 4; ++m) { const int row = row0 + ai * HALF + m * 16; const float s = rs ? rs[row] : 1.f; bf16_t* rowp = O + (size_t)row * ldc + col0;
#pragma unroll
                for (int bj = 0; bj < 2; ++bj) { f32x4 v0 = acc[ai][bj][m][0] * s, v1 = acc[ai][bj][m][1] * s;
                    if (ACT == 1) {
#pragma unroll
                        for (int i = 0; i < 4; ++i) { const float a = fmaxf(v0[i], 0.f), b = fmaxf(v1[i], 0.f); v0[i] = a * a; v1[i] = b * b; } }
                    u32x4 w; w.x = pk2(v0[0], v0[1]); w.y = pk2(v0[2], v0[3]); w.z = pk2(v1[0], v1[1]); w.w = pk2(v1[2], v1[3]);
                    *(u32x4*)(rowp + bj * HALF) = w; } }
    }
};
struct EpiInProj {
    static constexpr bool PERM = true, AFTER_DRAIN = false;
    bf16_t* O; const float* rs; const f32x2* rope;
    __device__ __forceinline__ void operator()(const f32x4 (&acc)[2][2][4][2], const Unit& u, int wr, int wc, int fr, int fq) const {
        const int row0 = u.pm * BM + wr * 64 + fr, col0 = u.pn * BM + wc * 32 + 8 * fq;
        const int pn = u.pn;
        const int j64 = 4 * (wc & 1) + fq;
#pragma unroll
        for (int ai = 0; ai < 2; ++ai)
#pragma unroll
            for (int m = 0; m < 4; ++m) { const int row = row0 + ai * HALF + m * 16; const float s = rs[row]; bf16_t* rowp = O + (size_t)row * ZP + col0;
                const f32x2* tb = rope + (size_t)(row & (SEQ - 1)) * 32;
#pragma unroll
                for (int bj = 0; bj < 2; ++bj) { f32x4 v0 = acc[ai][bj][m][0] * s, v1 = acc[ai][bj][m][1] * s;
                    const bool r64 = (pn == 4) || (pn == 5) || (pn == 6 && bj == 0), r32 = (pn == 7) || (pn == 8);
                    if (r64 || r32) {
                        f32x2 cs[4];
                        if (r64) { const f32x4 t0 = *(const f32x4*)(tb + 4 * j64), t1 = *(const f32x4*)(tb + 4 * j64 + 2); cs[0] = (f32x2){t0[0], t0[1]}; cs[1] = (f32x2){t0[2], t0[3]}; cs[2] = (f32x2){t1[0], t1[1]}; cs[3] = (f32x2){t1[2], t1[3]}; }
                        else {
#pragma unroll
                            for (int i = 0; i < 4; ++i) cs[i] = tb[8 * fq + 2 * i]; }
#pragma unroll
                        for (int i = 0; i < 4; ++i) { const float a = v0[i], b = v1[i]; v0[i] = a * cs[i].x - b * cs[i].y; v1[i] = b * cs[i].x + a * cs[i].y; }
                        if (pn == 7) { v0 = v0 * DQ_SCALE; v1 = v1 * DQ_SCALE; }
                    }
                    u32x4 w; w.x = pk2(v0[0], v0[1]); w.y = pk2(v0[2], v0[3]); w.z = pk2(v1[0], v1[1]); w.w = pk2(v1[2], v1[3]);
                    *(u32x4*)(rowp + bj * HALF) = w; } }
    }
};

template <class Epi, class Sched, bool ALIGN_EPI = false, bool SP2 = false>
__device__ __forceinline__ void gemm_phase(lds_t lds, const Gemm g, const Sched& S, const Epi& E) {
    const int tid = otid(), wid = __builtin_amdgcn_readfirstlane(tid >> 6), lane = tid & 63, wr = wid >> 2, wc = wid & 3, fr = lane & 15, fq = lane >> 4;
    const int K = g.K, nt = K / BK;
    unsigned voffA[2], voffB[2];
#pragma unroll
    for (int i = 0; i < 2; ++i) { int R, C; stage_rc(tid * 16 + i * 8192, R, C); const int Rb = Epi::PERM ? ((R & ~31) + perm32(R & 31)) : R;
        voffA[i] = (unsigned)(R * K + C) * 2u; voffB[i] = (unsigned)(Rb * K + C) * 2u; }
    const size_t kstep = (size_t)(BK * 2);
    const size_t hstep = (size_t)HALF * K * 2;
    const size_t tstep = 2 * hstep;
    const unsigned ldsw = (unsigned)wid * 1024u;
    const int aoff = lds_byte(wr * 64 + fr, fq * 8), boff = lds_byte(wc * 32 + fr, fq * 8);
#define PG8_SA(b, h) (((b) * 2 + (h)) * HTB)
#define PG8_SB(b, h) ((4 + (b) * 2 + (h)) * HTB)
#define PG8_STAGE(bufoff, gbase, voff) do { _Pragma("unroll") for (int _i = 0; _i < 2; ++_i) \
        __builtin_amdgcn_global_load_lds((const unsigned*)((const char*)(gbase) + (voff)[_i]), (LAS unsigned*)(lds + (bufoff) + ldsw + _i * 8192), 16, 0, 0); } while (0)
#define PG8_LDA(dst, b, h) do { _Pragma("unroll") for (int m = 0; m < 4; ++m) _Pragma("unroll") for (int k = 0; k < 2; ++k) dst[m][k] = *(const LAS bf16x8*)(lds + PG8_SA(b, h) + aoff + m * 2048 + k * 1024); } while (0)
#define PG8_LDB(dst, b, h) do { _Pragma("unroll") for (int n = 0; n < 2; ++n) _Pragma("unroll") for (int k = 0; k < 2; ++k) dst[n][k] = *(const LAS bf16x8*)(lds + PG8_SB(b, h) + boff + n * 2048 + k * 1024); } while (0)
#define PG8_MMA(ai, bj, At, Bt) do { __builtin_amdgcn_s_setprio(1); _Pragma("unroll") for (int m = 0; m < 4; ++m) _Pragma("unroll") for (int n = 0; n < 2; ++n) _Pragma("unroll") for (int k = 0; k < 2; ++k) \
        acc[ai][bj][m][n] = __builtin_amdgcn_mfma_f32_16x16x32_bf16(Bt[n][k], At[m][k], acc[ai][bj][m][n], 0, 0, 0); __builtin_amdgcn_s_setprio(0); } while (0)
#define PG8_WAIT_V(n) asm volatile("s_waitcnt vmcnt(" #n ")" ::: "memory")
#define PG8_WAIT_L(n) asm volatile("s_waitcnt lgkmcnt(" #n ")" ::: "memory")
#define PG8_BAR __builtin_amdgcn_s_barrier()
#define PG8_SCHED __builtin_amdgcn_sched_barrier(0)
    Unit cur, nxt; int ui = 0;
    if (!S.next(0, cur)) return;
    f32x4 acc[2][2][4][2];
#pragma unroll
    for (int a = 0; a < 2; ++a)
#pragma unroll
        for (int b = 0; b < 2; ++b)
#pragma unroll
            for (int m = 0; m < 4; ++m)
#pragma unroll
                for (int n = 0; n < 2; ++n) acc[a][b][m][n] = (f32x4){0.f, 0.f, 0.f, 0.f};
    bf16x8 At[4][2], B0[2][2], B1[2][2];
    const char* cA = (const char*)g.A + (size_t)cur.pm * tstep; const char* cB = (const char*)g.Bt + (size_t)cur.pn * tstep;
    S.a_ready(cur);
    if constexpr (SP2) {
        PG8_STAGE(PG8_SB(0, 0), cB, voffB); PG8_STAGE(PG8_SB(0, 1), cB + hstep, voffB); PG8_STAGE(PG8_SA(0, 0), cA, voffA); PG8_STAGE(PG8_SA(0, 1), cA + hstep, voffA);
        if (wr == 1) PG8_BAR;
        PG8_WAIT_V(2); PG8_BAR;
        PG8_STAGE(PG8_SB(1, 0), cB + kstep, voffB); PG8_STAGE(PG8_SA(1, 0), cA + kstep, voffA); PG8_STAGE(PG8_SB(1, 1), cB + hstep + kstep, voffB);
        PG8_WAIT_V(6); PG8_BAR;
    } else {
        PG8_STAGE(PG8_SB(0, 0), cB, voffB); PG8_STAGE(PG8_SA(0, 0), cA, voffA); PG8_STAGE(PG8_SB(0, 1), cB + hstep, voffB); PG8_STAGE(PG8_SA(0, 1), cA + hstep, voffA);
        if (wr == 1) PG8_BAR;
        PG8_WAIT_V(4); PG8_BAR;
        PG8_STAGE(PG8_SB(1, 0), cB + kstep, voffB); PG8_STAGE(PG8_SA(1, 0), cA + kstep, voffA); PG8_STAGE(PG8_SB(1, 1), cB + hstep + kstep, voffB);
        PG8_WAIT_V(6); PG8_BAR;
    }
    for (;;) {
        const bool has_next = S.next(ui + 1, nxt);
        const char* nA = has_next ? (const char*)g.A + (size_t)nxt.pm * tstep : cA; const char* nB = has_next ? (const char*)g.Bt + (size_t)nxt.pn * tstep : cB;
        for (int t = 0; t < nt; t += 2) {
            const bool last = (t == nt - 2);
            const char* a1 = cA + (size_t)(t + 1) * kstep;
            const char* a2 = last ? nA : cA + (size_t)(t + 2) * kstep; const char* b2 = last ? nB : cB + (size_t)(t + 2) * kstep;
            const char* a3 = a2 + kstep; const char* b3 = b2 + kstep;
            if (last && has_next) S.a_ready(nxt);
            if constexpr (SP2) {
            PG8_LDB(B0, 0, 0); PG8_LDB(B1, 0, 1); PG8_SCHED; PG8_LDA(At, 0, 0); PG8_STAGE(PG8_SA(1, 1), a1 + hstep, voffA);
            PG8_WAIT_V(8); PG8_WAIT_L(0); PG8_BAR; PG8_MMA(0, 0, At, B0); PG8_MMA(0, 1, At, B1); PG8_BAR; PG8_SCHED;
            PG8_LDA(At, 0, 1); PG8_STAGE(PG8_SB(0, 0), b2, voffB); PG8_STAGE(PG8_SB(0, 1), b2 + hstep, voffB); PG8_STAGE(PG8_SA(0, 0), a2, voffA);
            PG8_WAIT_V(8); PG8_WAIT_L(0); PG8_BAR; PG8_MMA(1, 0, At, B0); PG8_MMA(1, 1, At, B1); PG8_BAR; PG8_SCHED;
            PG8_LDB(B0, 1, 0); PG8_LDB(B1, 1, 1); PG8_SCHED; PG8_LDA(At, 1, 0); PG8_STAGE(PG8_SA(0, 1), a2 + hstep, voffA);
            PG8_WAIT_V(8); PG8_WAIT_L(0); PG8_BAR; PG8_MMA(0, 0, At, B0); PG8_MMA(0, 1, At, B1); PG8_BAR; PG8_SCHED;
            PG8_LDA(At, 1, 1); PG8_STAGE(PG8_SB(1, 0), b3, voffB); PG8_STAGE(PG8_SB(1, 1), b3 + hstep, voffB); PG8_STAGE(PG8_SA(1, 0), a3, voffA);
            PG8_WAIT_V(8); PG8_WAIT_L(0); PG8_BAR; PG8_MMA(1, 0, At, B0); PG8_MMA(1, 1, At, B1); PG8_BAR; PG8_SCHED;
            } else {
            PG8_LDB(B0, 0, 0); PG8_SCHED; PG8_LDA(At, 0, 0); PG8_STAGE(PG8_SA(1, 1), a1 + hstep, voffA);
            PG8_WAIT_L(8); PG8_BAR; PG8_WAIT_L(0); PG8_MMA(0, 0, At, B0); PG8_BAR; PG8_SCHED;
            PG8_LDB(B1, 0, 1); PG8_STAGE(PG8_SB(0, 0), b2, voffB);
            PG8_BAR; PG8_WAIT_L(0); PG8_MMA(0, 1, At, B1); PG8_BAR;
            PG8_LDA(At, 0, 1); PG8_STAGE(PG8_SA(0, 0), a2, voffA);
            PG8_BAR; PG8_WAIT_L(0); PG8_MMA(1, 0, At, B0); PG8_BAR; PG8_SCHED;
            PG8_STAGE(PG8_SB(0, 1), b2 + hstep, voffB);
            PG8_WAIT_V(6); PG8_BAR; PG8_MMA(1, 1, At, B1); PG8_BAR;
            PG8_LDB(B0, 1, 0); PG8_SCHED; PG8_LDA(At, 1, 0); PG8_STAGE(PG8_SA(0, 1), a2 + hstep, voffA);
            PG8_WAIT_L(8); PG8_BAR; PG8_WAIT_L(0); PG8_MMA(0, 0, At, B0); PG8_BAR; PG8_SCHED;
            PG8_LDB(B1, 1, 1); PG8_STAGE(PG8_SB(1, 0), b3, voffB);
            PG8_BAR; PG8_WAIT_L(0); PG8_MMA(0, 1, At, B1); PG8_BAR;
            PG8_LDA(At, 1, 1); PG8_STAGE(PG8_SA(1, 0), a3, voffA);
            PG8_BAR; PG8_WAIT_L(0); PG8_MMA(1, 0, At, B0); PG8_BAR; PG8_SCHED;
            PG8_STAGE(PG8_SB(1, 1), b3 + hstep, voffB);
            PG8_WAIT_V(6); PG8_BAR; PG8_MMA(1, 1, At, B1); PG8_BAR;
            }
        }
        if constexpr (ALIGN_EPI) { if (wr == 0) PG8_BAR; }
        E(acc, cur, wr, wc, fr, fq); S.done(cur);
        if (!has_next) break;
#pragma unroll
        for (int a = 0; a < 2; ++a)
#pragma unroll
            for (int b = 0; b < 2; ++b)
#pragma unroll
                for (int m = 0; m < 4; ++m)
#pragma unroll
                    for (int n = 0; n < 2; ++n) acc[a][b][m][n] = (f32x4){0.f, 0.f, 0.f, 0.f};
        cur = nxt; cA = nA; cB = nB; ++ui;
        if constexpr (ALIGN_EPI) { if (wr == 1) PG8_BAR; }
    }
    PG8_WAIT_V(0);
    if constexpr (!ALIGN_EPI) { if (wr == 0) PG8_BAR; }
    PG8_BAR;
#undef PG8_SA
#undef PG8_SB
#undef PG8_STAGE
#undef PG8_LDA
#undef PG8_LDB
#undef PG8_MMA
#undef PG8_WAIT_V
#undef PG8_WAIT_L
#undef PG8_BAR
#undef PG8_SCHED
}
}

__device__ __forceinline__ int zsrc(int c) {
    if (c < 1024) return c;
    if (c < ZC_SK) { const int x = c - ZC_SQ, hh = x >> 6, p = x & 63, j = p >> 3, i = p & 7; return 1032 + hh * 64 + (i < 4 ? 4 * j + i : 32 + 4 * j + (i - 4)); }
    if (c < ZC_SV) { const int x = c - ZC_SK, hh = x >> 6, p = x & 63, j = p >> 3, i = p & 7; return 1544 + hh * 64 + (i < 4 ? 4 * j + i : 32 + 4 * j + (i - 4)); }
    if (c < ZC_DQ) return 1672 + (c - ZC_SV);
    if (c < ZC_DK) { const int x = c - ZC_DQ, hh = x >> 5, p = x & 31, j = p >> 3, i = p & 7; return 1800 + hh * 32 + (i < 4 ? 4 * j + i : 16 + 4 * j + (i - 4)); }
    if (c < ZC_DV) { const int x = c - ZC_DK, hh = x >> 5, p = x & 31, j = p >> 3, i = p & 7; return 2056 + hh * 32 + (i < 4 ? 4 * j + i : 16 + 4 * j + (i - 4)); }
    if (c < ZC_G) return 2312 + (c - ZC_DV);
    if (c < ZC_G + 8) return 1024 + (c - ZC_G);
    return -1;
}
template <bool MAPZ> __device__ __forceinline__ void transpose_item(const float* W, int K, int N, int Nst, const float* gk, bf16_t* WT, LAS float* scr, int item, int lane) {
    const int nblk = Nst / 32, kb = item / nblk, nb = item % nblk, k0 = 64 * kb, n0 = 32 * nb;
    const int nsrc = MAPZ ? zsrc(n0 + (lane & 31)) : (n0 + (lane & 31));
#pragma unroll 8
    for (int i = 0; i < 32; ++i) { const int kk = 2 * i + (lane >> 5); float v = 0.f; if (nsrc >= 0) v = W[(size_t)(k0 + kk) * N + nsrc]; if (gk) v *= gk[k0 + kk]; scr[kk * 33 + (lane & 31)] = v; }
    asm volatile("s_waitcnt lgkmcnt(0)" ::: "memory");
    const int c = lane & 7;
#pragma unroll
    for (int j = 0; j < 4; ++j) { const int n = (lane >> 3) + 8 * j; const LAS float* s = scr + (8 * c) * 33 + n;
        u32x4 o; o.x = pk2(s[0 * 33], s[1 * 33]); o.y = pk2(s[2 * 33], s[3 * 33]); o.z = pk2(s[4 * 33], s[5 * 33]); o.w = pk2(s[6 * 33], s[7 * 33]);
        *(u32x4*)(WT + (size_t)(n0 + n) * K + k0 + 8 * c) = o; }
    asm volatile("s_waitcnt lgkmcnt(0)" ::: "memory");
}
__device__ __forceinline__ void sincos_red(double x, float& c, float& s) {
    const double k = rint(x * 0.15915494309189535), r = x - k * 6.283185307179586, r2 = r * r;
    double sn = 1.0, cs = 1.0;
#pragma unroll
    for (int n = 14; n >= 1; --n) { sn = 1.0 - r2 * (1.0 / (double)((2 * n) * (2 * n + 1))) * sn; cs = 1.0 - r2 * (1.0 / (double)((2 * n - 1) * (2 * n))) * cs; }
    s = (float)(r * sn); c = (float)cs;
}
__device__ __forceinline__ void row_to_bf16(const float* xrow, bf16_t* orow, float* rs, int lane) {
    const f32x4* xr = (const f32x4*)xrow + lane;
    f32x4 v[4]; float s = 0.f;
#pragma unroll
    for (int j = 0; j < 4; ++j) { v[j] = xr[64 * j]; s += (v[j].x * v[j].x + v[j].y * v[j].y) + (v[j].z * v[j].z + v[j].w * v[j].w); }
    s = wave_sum(s);
    u32x2* o8 = (u32x2*)orow + lane;
#pragma unroll
    for (int j = 0; j < 4; ++j) o8[64 * j] = (u32x2){pk2(v[j].x, v[j].y), pk2(v[j].z, v[j].w)};
    if (lane == 0) *rs = 1.f / sqrtf(s * (1.f / DM) + EPS);
}
__device__ __forceinline__ void prologue(const Params& P, lds_t lds, int G) {
    const int tid = otid(), lane = tid & 63, wave = tid >> 6; unsigned char* const ws_ = optr(P.ws);
    LAS float* scr = (LAS float*)(lds + wave * 16384);
    const int gw = blockIdx.x * NWAVES + wave, NGW = G * NWAVES;
    constexpr int I_IN = (DM / 64) * (ZP / 32), I_OUT = (DM / 64) * (DM / 32), I_UP = (DM / 64) * (FF / 32), I_DN = (FF / 64) * (DM / 32), I_L = I_IN + I_OUT + I_UP + I_DN;
    for (int it = gw; it < 2 * I_L; it += NGW) {
        const int l = it / I_L; int r = it % I_L;
        unsigned char* wb = ws_ + WS_W + (size_t)l * W_LAYER;
        if (r < I_IN) { transpose_item<true>(P.in[1] + (size_t)l * DM * INW, DM, INW, ZP, P.in[16] + l * DM, (bf16_t*)(wb + W_IN), scr, r, lane); continue; } r -= I_IN;
        if (r < I_OUT) { transpose_item<false>(P.in[13] + (size_t)l * DM * DM, DM, DM, DM, nullptr, (bf16_t*)(wb + W_OUT), scr, r, lane); continue; } r -= I_OUT;
        if (r < I_UP) { transpose_item<false>(P.in[14] + (size_t)l * DM * FF, DM, FF, FF, P.in[18] + l * DM, (bf16_t*)(wb + W_UP), scr, r, lane); continue; } r -= I_UP;
        transpose_item<false>(P.in[15] + (size_t)l * FF * DM, FF, DM, DM, nullptr, (bf16_t*)(wb + W_DOWN), scr, r, lane);
    }
    f32x2* rope = (f32x2*)(ws_ + WS_ROPE);
    for (int e = blockIdx.x * NTHREADS + tid; e < SEQ * 32; e += G * NTHREADS) {
        const int pos = e >> 5, i = e & 31;
        const float inv = (float)exp(-(double)i * (9.210340371976184 / 32.0));
        const float ang = (float)pos * inv;
        float c, s; sincos_red((double)ang, c, s);
        rope[e] = (f32x2){c, s};
    }
    bf16_t* XB = (bf16_t*)(ws_ + WS_XB); float* RS = (float*)(ws_ + WS_RS);
    for (int m = gw; m < NTOK; m += NGW) row_to_bf16(P.in[0] + (size_t)m * DM, XB + (size_t)m * DM, RS + m, lane);
}

__device__ __forceinline__ void resid_pass(const Params& P, const float* gpost, bool last, int G) {
    const int tid = otid(), lane = tid & 63, wave = tid >> 6; unsigned char* const ws_ = optr(P.ws);
    const int gw = blockIdx.x * NWAVES + wave, NGW = G * NWAVES;
    const bf16_t* MIX = (const bf16_t*)(ws_ + WS_MIX); bf16_t* XB = (bf16_t*)(ws_ + WS_XB); float* RS = (float*)(ws_ + WS_RS);
    f32x4 gv[2][2];
#pragma unroll
    for (int j = 0; j < 2; ++j) { gv[j][0] = *(const f32x4*)(gpost + 512 * j + 8 * lane); gv[j][1] = *(const f32x4*)(gpost + 512 * j + 8 * lane + 4); }
    for (int m0 = gw; m0 < NTOK; m0 += 2 * NGW) {
        u32x4 mw[2][2], xw[2][2];
#pragma unroll
        for (int q = 0; q < 2; ++q) { const int m = m0 + q * NGW; if (m < NTOK) {
#pragma unroll
            for (int j = 0; j < 2; ++j) { mw[q][j] = *(const u32x4*)(MIX + (size_t)m * DM + 512 * j + 8 * lane); xw[q][j] = *(const u32x4*)(XB + (size_t)m * DM + 512 * j + 8 * lane); } } }
#pragma unroll
        for (int q = 0; q < 2; ++q) { const int m = m0 + q * NGW; if (m < NTOK) {
            f32x4 mv[2][2], bv[2][2]; float s = 0.f;
#pragma unroll
            for (int j = 0; j < 2; ++j) { const u32x4 w = mw[q][j], x = xw[q][j];
                mv[j][0] = (f32x4){bflo(w.x), bfhi(w.x), bflo(w.y), bfhi(w.y)}; mv[j][1] = (f32x4){bflo(w.z), bfhi(w.z), bflo(w.w), bfhi(w.w)};
                bv[j][0] = (f32x4){bflo(x.x), bfhi(x.x), bflo(x.y), bfhi(x.y)}; bv[j][1] = (f32x4){bflo(x.z), bfhi(x.z), bflo(x.w), bfhi(x.w)};
#pragma unroll
                for (int k = 0; k < 2; ++k) s += (mv[j][k].x * mv[j][k].x + mv[j][k].y * mv[j][k].y) + (mv[j][k].z * mv[j][k].z + mv[j][k].w * mv[j][k].w); }
            s = wave_sum(s);
            const float r = 1.f / sqrtf(s * (1.f / DM) + EPS);
            float s2 = 0.f;
#pragma unroll
            for (int j = 0; j < 2; ++j)
#pragma unroll
                for (int k = 0; k < 2; ++k) { bv[j][k] = bv[j][k] + mv[j][k] * r * gv[j][k]; s2 += (bv[j][k].x * bv[j][k].x + bv[j][k].y * bv[j][k].y) + (bv[j][k].z * bv[j][k].z + bv[j][k].w * bv[j][k].w); }
            if (last) {
#pragma unroll
                for (int j = 0; j < 2; ++j) { f32x4* o = (f32x4*)(P.out + (size_t)m * DM + 512 * j + 8 * lane); o[0] = bv[j][0]; o[1] = bv[j][1]; }
            } else {
                s2 = wave_sum(s2);
#pragma unroll
                for (int j = 0; j < 2; ++j) *(u32x4*)(XB + (size_t)m * DM + 512 * j + 8 * lane) = (u32x4){pk2(bv[j][0].x, bv[j][0].y), pk2(bv[j][0].z, bv[j][0].w), pk2(bv[j][1].x, bv[j][1].y), pk2(bv[j][1].z, bv[j][1].w)};
                if (lane == 0) RS[m] = 1.f / sqrtf(s2 * (1.f / DM) + EPS);
            }
        } }
    }
}

__device__ __forceinline__ void mlstm_gates(const bf16_t* Z, size_t t0, int hh, float ib, float fb, LAS float* bc, LAS float* ig, int tid) {
    if (tid < 64) {
        const int lane = tid;
        const bf16_t* g0 = Z + (t0 + 2 * lane) * ZP + ZC_G; const bf16_t* g1 = g0 + ZP;
        const float i0 = bf2f(g0[hh]) + ib, i1 = bf2f(g1[hh]) + ib;
        const float l0 = logsigmoidf_(bf2f(g0[4 + hh]) + fb), l1 = logsigmoidf_(bf2f(g1[4 + hh]) + fb);
        float x = l0 + l1;
#pragma unroll
        for (int o = 1; o < 64; o <<= 1) { const float t = __shfl_up(x, o); if (lane >= o) x += t; }
        bc[2 * lane] = x - l1; bc[2 * lane + 1] = x; ig[2 * lane] = i0; ig[2 * lane + 1] = i1;
    }
}
__device__ __forceinline__ void conv8(const bf16_t* zp, int tseq, const float* cw, const float* cb, int ch, float scale, float (&y)[8]) {
    const f32x4 b0 = *(const f32x4*)(cb + ch), b1 = *(const f32x4*)(cb + ch + 4);
    y[0] = b0[0]; y[1] = b0[1]; y[2] = b0[2]; y[3] = b0[3]; y[4] = b1[0]; y[5] = b1[1]; y[6] = b1[2]; y[7] = b1[3];
#pragma unroll
    for (int j = 0; j < 4; ++j) {
        if (tseq - 3 + j >= 0) {
            const u32x4 w = *(const u32x4*)(zp - (size_t)(3 - j) * ZP);
            const f32x4 c0 = *(const f32x4*)(cw + j * 512 + ch), c1 = *(const f32x4*)(cw + j * 512 + ch + 4);
            y[0] += bflo(w.x) * c0[0]; y[1] += bfhi(w.x) * c0[1]; y[2] += bflo(w.y) * c0[2]; y[3] += bfhi(w.y) * c0[3];
            y[4] += bflo(w.z) * c1[0]; y[5] += bfhi(w.z) * c1[1]; y[6] += bflo(w.w) * c1[2]; y[7] += bfhi(w.w) * c1[3];
        }
    }
#pragma unroll
    for (int i = 0; i < 8; ++i) y[i] = y[i] * sigmoidf_(y[i]) * scale;
}
constexpr int TS128 = 264;
constexpr int RS64 = 144;
__device__ __forceinline__ void mlstm_a_item(const Params& P, int l, int item, lds_t lds) {
    const int tid = otid(), lane = tid & 63, w = tid >> 6, r = lane & 31, h = lane >> 5; unsigned char* const ws_ = optr(P.ws);
    const int c = item & 63, hh = (item >> 6) & 3, b = item >> 8;
    const size_t t0 = (size_t)b * SEQ + (size_t)c * 128;
    const bf16_t* Z = (const bf16_t*)(ws_ + WS_ZB);
    const float* cw = P.in[2] + l * 4 * 512; const float* cb = P.in[3] + l * 512;
    lds_t KT = lds, VT = lds + 64 * TS128; LAS float* bc = (LAS float*)(lds + 2 * 64 * TS128); LAS float* ig = bc + 128; LAS float* wst = ig + 128;
    mlstm_gates(Z, t0, hh, P.in[4][l * 4 + hh], P.in[5][l * 4 + hh], bc, ig, tid);
    __syncthreads();
    const float blast = bc[127];
    if (tid < 128) wst[tid] = __expf(blast - bc[tid] + ig[tid]);
    __syncthreads();
#pragma unroll
    for (int q = 0; q < 2; ++q) {
        const int e = tid + q * 512, s = e >> 3, ch = e & 7;
        float y[8];
        conv8(Z + (t0 + s) * ZP + ZC_MK + hh * 64 + 8 * ch, c * 128 + s, cw, cb, 256 + hh * 64 + 8 * ch, 0.125f, y);
#pragma unroll
        for (int i = 0; i < 8; ++i) *(LAS bf16_t*)(KT + (8 * ch + i) * TS128 + s * 2) = f2bf(y[i]);
        const u32x4 vw = *(const u32x4*)(Z + (t0 + s) * ZP + ZC_MV + hh * 64 + 8 * ch);
        const float ws_ = wst[s];
        const float vv[8] = {bflo(vw.x), bfhi(vw.x), bflo(vw.y), bfhi(vw.y), bflo(vw.z), bfhi(vw.z), bflo(vw.w), bfhi(vw.w)};
#pragma unroll
        for (int i = 0; i < 8; ++i) *(LAS bf16_t*)(VT + (8 * ch + i) * TS128 + s * 2) = f2bf(vv[i] * ws_);
    }
    __syncthreads();
    float* DC = (float*)(ws_ + WS_DC) + (size_t)item * 4096; float* DN = (float*)(ws_ + WS_DN) + (size_t)item * 64; float* DEC = (float*)(ws_ + WS_DEC);
    if (w < 4) {
        const int vt = w >> 1, kt = w & 1;
        f32x16 acc = {};
#pragma unroll
        for (int ks = 0; ks < 8; ++ks) {
            const bf16x8 a = lds16(VT + (32 * vt + r) * TS128 + (16 * ks + 8 * h) * 2);
            const bf16x8 bb = lds16(KT + (32 * kt + r) * TS128 + (16 * ks + 8 * h) * 2);
            acc = MFMA32(a, bb, acc);
        }
#pragma unroll
        for (int i = 0; i < 16; ++i) DC[(32 * vt + crow(i, h)) * 64 + 32 * kt + r] = acc[i];
    } else if (w == 4) {
        float sum = 0.f;
#pragma unroll 4
        for (int s8 = 0; s8 < 16; ++s8) {
            const u32x4 kw = *(const LAS u32x4*)(KT + lane * TS128 + s8 * 16);
            const f32x4 w0 = *(const LAS f32x4*)(wst + 8 * s8), w1 = *(const LAS f32x4*)(wst + 8 * s8 + 4);
            sum += bflo(kw.x) * w0[0] + bfhi(kw.x) * w0[1] + bflo(kw.y) * w0[2] + bfhi(kw.y) * w0[3] + bflo(kw.z) * w1[0] + bfhi(kw.z) * w1[1] + bflo(kw.w) * w1[2] + bfhi(kw.w) * w1[3];
        }
        DN[lane] = sum;
    } else if (w == 5 && lane == 0) DEC[item] = __expf(blast);
    __syncthreads();
}
__device__ __forceinline__ void mlstm_scan(const Params& P, int G) {
    unsigned char* const ws_ = optr(P.ws); const int tid = otid();
    const float* DC = (const float*)(ws_ + WS_DC); const float* DN = (const float*)(ws_ + WS_DN); const float* DEC = (const float*)(ws_ + WS_DEC);
    bf16_t* CS = (bf16_t*)(ws_ + WS_CS); float* NS = (float*)(ws_ + WS_NS);
    for (int ch = blockIdx.x * NTHREADS + tid; ch < 32 * 4160; ch += G * NTHREADS) {
        const int seq = ch / 4160, e = ch % 4160;
        const bool isc = e < 4096; const int k = e - 4096;
        float st = 0.f;
        for (int c0 = 0; c0 < 64; c0 += 16) {
            float dv[16], de[16];
#pragma unroll
            for (int j = 0; j < 16; ++j) { const int it = seq * 64 + c0 + j; de[j] = DEC[it]; dv[j] = isc ? DC[(size_t)it * 4096 + e] : DN[it * 64 + k]; }
#pragma unroll
            for (int j = 0; j < 16; ++j) { const int it = seq * 64 + c0 + j; if (isc) CS[(size_t)it * 4096 + e] = f2bf(st); else NS[it * 64 + k] = st; st = de[j] * st + dv[j]; }
        }
    }
}
__device__ __forceinline__ void mlstm_c_item(const Params& P, int l, int item, lds_t lds) {
    const int tid = otid(), lane = tid & 63, w = tid >> 6, r = lane & 31, h = lane >> 5; unsigned char* const ws_ = optr(P.ws);
    const int c = item & 63, hh = (item >> 6) & 3, b = item >> 8;
    const size_t t0 = (size_t)b * SEQ + (size_t)c * 128;
    const bf16_t* Z = (const bf16_t*)(ws_ + WS_ZB);
    const float* cw = P.in[2] + l * 4 * 512; const float* cb = P.in[3] + l * 512;
    lds_t Qs = lds, Ks = Qs + 128 * RS64, VT = Ks + 128 * RS64, Cs = VT + 64 * TS128, Hs = Cs + 64 * RS64;
    LAS float* bc = (LAS float*)(Hs + 128 * RS64); LAS float* ig = bc + 128; LAS float* ns = ig + 128;
    mlstm_gates(Z, t0, hh, P.in[4][l * 4 + hh], P.in[5][l * 4 + hh], bc, ig, tid);
#pragma unroll
    for (int q = 0; q < 2; ++q) {
        const int e = tid + q * 512, s = e >> 3, ch = e & 7;
        float y[8];
        conv8(Z + (t0 + s) * ZP + ZC_MQ + hh * 64 + 8 * ch, c * 128 + s, cw, cb, hh * 64 + 8 * ch, 1.f, y);
        *(LAS u32x4*)(Qs + s * RS64 + ch * 16) = (u32x4){pk2(y[0], y[1]), pk2(y[2], y[3]), pk2(y[4], y[5]), pk2(y[6], y[7])};
        conv8(Z + (t0 + s) * ZP + ZC_MK + hh * 64 + 8 * ch, c * 128 + s, cw, cb, 256 + hh * 64 + 8 * ch, 0.125f, y);
        *(LAS u32x4*)(Ks + s * RS64 + ch * 16) = (u32x4){pk2(y[0], y[1]), pk2(y[2], y[3]), pk2(y[4], y[5]), pk2(y[6], y[7])};
        const u32x4 vw = *(const u32x4*)(Z + (t0 + s) * ZP + ZC_MV + hh * 64 + 8 * ch);
        const unsigned vv[4] = {vw.x, vw.y, vw.z, vw.w};
#pragma unroll
        for (int i = 0; i < 4; ++i) { *(LAS bf16_t*)(VT + (8 * ch + 2 * i) * TS128 + s * 2) = (bf16_t)(vv[i] & 0xffffu); *(LAS bf16_t*)(VT + (8 * ch + 2 * i + 1) * TS128 + s * 2) = (bf16_t)(vv[i] >> 16); }
    }
    { const int v = tid >> 3, ch = tid & 7; *(LAS u32x4*)(Cs + v * RS64 + ch * 16) = *(const u32x4*)((const bf16_t*)(ws_ + WS_CS) + (size_t)item * 4096 + v * 64 + ch * 8); }
    if (tid < 64) ns[tid] = ((const float*)(ws_ + WS_NS))[item * 64 + tid];
    __syncthreads();
    if (w < 4) {
        const int tt = w, tl = 32 * tt + r;
        bf16x8 qf[4];
#pragma unroll
        for (int ks = 0; ks < 4; ++ks) qf[ks] = lds16(Qs + tl * RS64 + (16 * ks + 8 * h) * 2);
        f32x16 num[2] = {};
#pragma unroll
        for (int vt = 0; vt < 2; ++vt)
#pragma unroll
            for (int ks = 0; ks < 4; ++ks) num[vt] = MFMA32(lds16(Cs + (32 * vt + r) * RS64 + (16 * ks + 8 * h) * 2), qf[ks], num[vt]);
        float nq = 0.f;
#pragma unroll
        for (int ks = 0; ks < 4; ++ks) {
            const u32x4 qw = __builtin_bit_cast(u32x4, qf[ks]);
            const f32x4 n0 = *(const LAS f32x4*)(ns + 16 * ks + 8 * h), n1 = *(const LAS f32x4*)(ns + 16 * ks + 8 * h + 4);
            nq += bflo(qw.x) * n0[0] + bfhi(qw.x) * n0[1] + bflo(qw.y) * n0[2] + bfhi(qw.y) * n0[3] + bflo(qw.z) * n1[0] + bfhi(qw.z) * n1[1] + bflo(qw.w) * n1[2] + bfhi(qw.w) * n1[3];
        }
        nq = swap_add(nq);
        const float bt = bc[tl], eb = __expf(bt);
#pragma unroll
        for (int vt = 0; vt < 2; ++vt)
#pragma unroll
            for (int i = 0; i < 16; ++i) num[vt][i] *= eb;
        float den = 0.f;
        for (int st = 0; st <= tt; ++st) {
            f32x16 S = {};
#pragma unroll
            for (int ks = 0; ks < 4; ++ks) S = MFMA32(lds16(Ks + (32 * st + r) * RS64 + (16 * ks + 8 * h) * 2), qf[ks], S);
#pragma unroll
            for (int i = 0; i < 16; ++i) { const int s = 32 * st + crow(i, h); const float wgt = (s <= tl) ? __expf(bt - bc[s] + ig[s]) : 0.f; S[i] *= wgt; den += S[i]; }
#pragma unroll
            for (int s2 = 0; s2 < 2; ++s2) { const bf16x8 pf = pack8(S, s2);
#pragma unroll
                for (int vt = 0; vt < 2; ++vt) { lds_t vp = VT + (32 * vt + r) * TS128 + (32 * st + 16 * s2 + 4 * h) * 2; num[vt] = MFMA32(lds8x2(vp, vp + 16), pf, num[vt]); } }
        }
        den = swap_add(den) + eb * nq;
        const float dinv = 1.f / fmaxf(fabsf(den), 1.f);
        float ss = 0.f;
#pragma unroll
        for (int vt = 0; vt < 2; ++vt)
#pragma unroll
            for (int i = 0; i < 16; ++i) { num[vt][i] *= dinv; ss += num[vt][i] * num[vt][i]; }
        ss = swap_add(ss);
        const float rn = 1.f / sqrtf(ss * (1.f / 64.f) + EPS);
#pragma unroll
        for (int vt = 0; vt < 2; ++vt)
#pragma unroll
            for (int i = 0; i < 16; ++i) *(LAS bf16_t*)(Hs + tl * RS64 + (32 * vt + crow(i, h)) * 2) = f2bf(num[vt][i] * rn);
    }
    __syncthreads();
    bf16_t* CAT = (bf16_t*)(ws_ + WS_CAT);
    const float* mg = P.in[6] + l * 256 + hh * 64;
#pragma unroll
    for (int q = 0; q < 2; ++q) {
        const int e = tid + q * 512, t = e >> 3, ch = e & 7;
        const u32x4 hw = *(const LAS u32x4*)(Hs + t * RS64 + ch * 16);
        const u32x4 ow = *(const u32x4*)(Z + (t0 + t) * ZP + ZC_MO + hh * 64 + 8 * ch);
        const f32x4 g0 = *(const f32x4*)(mg + 8 * ch), g1 = *(const f32x4*)(mg + 8 * ch + 4);
        u32x4 o;
        o.x = pk2(bflo(hw.x) * g0[0] * sigmoidf_(bflo(ow.x)), bfhi(hw.x) * g0[1] * sigmoidf_(bfhi(ow.x)));
        o.y = pk2(bflo(hw.y) * g0[2] * sigmoidf_(bflo(ow.y)), bfhi(hw.y) * g0[3] * sigmoidf_(bfhi(ow.y)));
        o.z = pk2(bflo(hw.z) * g1[0] * sigmoidf_(bflo(ow.z)), bfhi(hw.z) * g1[1] * sigmoidf_(bfhi(ow.z)));
        o.w = pk2(bflo(hw.w) * g1[2] * sigmoidf_(bflo(ow.w)), bfhi(hw.w) * g1[3] * sigmoidf_(bfhi(ow.w)));
        *(u32x4*)(CAT + (t0 + t) * DM + hh * 64 + 8 * ch) = o;
    }
    __syncthreads();
}

constexpr int TS256 = 520;
__device__ __forceinline__ void swa_item(const Params& P, int l, int item, lds_t lds) {
    const int tid = otid(), lane = tid & 63, w = tid >> 6, r = lane & 31, h = lane >> 5; unsigned char* const ws_ = optr(P.ws);
    const int kvh = item & 1, nb = (item >> 1) & 63, b = item >> 7;
    const size_t t0 = (size_t)b * SEQ + (size_t)nb * 128;
    const bf16_t* Z = (const bf16_t*)(ws_ + WS_ZB);
    lds_t Ks = lds, VT = lds + 256 * RS64, Os = VT + 64 * TS256;
#pragma unroll
    for (int q = 0; q < 4; ++q) {
        const int e = tid + q * 512, kb = e >> 3, ch = e & 7;
        u32x4 kw = {0u, 0u, 0u, 0u}, vw = {0u, 0u, 0u, 0u};
        if (nb > 0 || kb >= 128) { const bf16_t* zr = Z + (t0 - 128 + kb) * ZP; kw = *(const u32x4*)(zr + ZC_SK + kvh * 64 + 8 * ch); vw = *(const u32x4*)(zr + ZC_SV + kvh * 64 + 8 * ch); }
        *(LAS u32x4*)(Ks + kb * RS64 + ch * 16) = kw;
        const unsigned vv[4] = {vw.x, vw.y, vw.z, vw.w};
#pragma unroll
        for (int i = 0; i < 4; ++i) { *(LAS bf16_t*)(VT + (8 * ch + 2 * i) * TS256 + kb * 2) = (bf16_t)(vv[i] & 0xffffu); *(LAS bf16_t*)(VT + (8 * ch + 2 * i + 1) * TS256 + kb * 2) = (bf16_t)(vv[i] >> 16); }
    }
    __syncthreads();
    bf16_t* CAT = (bf16_t*)(ws_ + WS_CAT);
    lds_t Ow = Os + w * 32 * RS64;
    for (int cc = w; cc < 16; cc += 8) {
        const int hq = cc >> 2, qt = cc & 3, hg = kvh * 4 + hq, ql = 32 * qt + r;
        const float sink = P.in[7][l * 8 + hg];
        const bf16_t* qp = Z + (t0 + ql) * ZP + ZC_SQ + hg * 64;
        bf16x8 qf[4];
#pragma unroll
        for (int ks = 0; ks < 4; ++ks) qf[ks] = *(const bf16x8*)(qp + 16 * ks + 8 * h);
        f32x16 S[5];
        float mx = sink;
#pragma unroll
        for (int k5 = 0; k5 < 5; ++k5) {
            const int kt = qt + k5;
            S[k5] = (f32x16){};
#pragma unroll
            for (int ks = 0; ks < 4; ++ks) S[k5] = MFMA32(lds16(Ks + (32 * kt + r) * RS64 + (16 * ks + 8 * h) * 2), qf[ks], S[k5]);
#pragma unroll
            for (int i = 0; i < 16; ++i) { const int kb = 32 * kt + crow(i, h); const bool ok = (kb > ql) && (kb <= ql + 128) && (nb > 0 || kb >= 128);
                S[k5][i] = ok ? S[k5][i] * 0.125f : -1e30f; mx = fmaxf(mx, S[k5][i]); }
        }
        mx = swap_max(mx);
        float sum = 0.f;
#pragma unroll
        for (int k5 = 0; k5 < 5; ++k5)
#pragma unroll
            for (int i = 0; i < 16; ++i) { S[k5][i] = __expf(S[k5][i] - mx); sum += S[k5][i]; }
        sum = swap_add(sum) + __expf(sink - mx);
        const float inv = 1.f / sum;
        f32x16 O[2] = {};
#pragma unroll
        for (int k5 = 0; k5 < 5; ++k5) {
            const int kt = qt + k5;
#pragma unroll
            for (int i = 0; i < 16; ++i) S[k5][i] *= inv;
#pragma unroll
            for (int s2 = 0; s2 < 2; ++s2) { const bf16x8 pf = pack8(S[k5], s2);
#pragma unroll
                for (int dt = 0; dt < 2; ++dt) { lds_t vp = VT + (32 * dt + r) * TS256 + (32 * kt + 16 * s2 + 4 * h) * 2; O[dt] = MFMA32(lds8x2(vp, vp + 16), pf, O[dt]); } }
        }
#pragma unroll
        for (int dt = 0; dt < 2; ++dt)
#pragma unroll
            for (int i = 0; i < 16; ++i) *(LAS bf16_t*)(Ow + r * RS64 + (32 * dt + crow(i, h)) * 2) = f2bf(O[dt][i]);
        asm volatile("s_waitcnt lgkmcnt(0)" ::: "memory");
#pragma unroll
        for (int it = 0; it < 4; ++it) { const int row = it * 8 + (lane >> 3), ch = lane & 7; const u32x4 v = *(const LAS u32x4*)(Ow + row * RS64 + ch * 16);
            *(u32x4*)(CAT + (t0 + 32 * qt + row) * DM + 256 + hg * 64 + 8 * ch) = v; }
        asm volatile("s_waitcnt lgkmcnt(0)" ::: "memory");
    }
    __syncthreads();
}

typedef short v4i16_t __attribute__((ext_vector_type(4)));
__device__ __forceinline__ s16x4 vtr(lds_t p) { return __builtin_bit_cast(s16x4, __builtin_amdgcn_ds_read_tr16_b64_v4i16((LAS v4i16_t*)p)); }
constexpr int DKS = 144, DVS = 192;
constexpr int DK_BYTES = 64 * DKS, DV_BYTES = 64 * DVS, DBUF = DK_BYTES + DV_BYTES;
__device__ __forceinline__ void dsoftmax(f32x16& S0, f32x16& S1, unsigned& qxw, f32x16& Oa, f32x16& Ob, float& mx, float& ls, bf16x8 (&pf)[2][2], bool first, bool needmask, int kbase, int qrow, int h) {
    if (needmask) {
#pragma unroll
        for (int i = 0; i < 16; ++i) { const int key = kbase + crow(i, h); if (key > qrow) S0[i] = -1e30f; if (key + 32 > qrow) S1[i] = -1e30f; }
    }
    float ta = fmaxf(fmaxf(S0[0], S0[1]), S1[0]), tb = fmaxf(fmaxf(S0[2], S0[3]), S1[1]); ta = fmaxf(fmaxf(ta, S1[2]), S1[3]);
#pragma unroll
    for (int i = 4; i < 16; i += 4) { ta = fmaxf(fmaxf(ta, S0[i]), S0[i + 1]); tb = fmaxf(fmaxf(tb, S0[i + 2]), S0[i + 3]); ta = fmaxf(fmaxf(ta, S1[i]), S1[i + 1]); tb = fmaxf(fmaxf(tb, S1[i + 2]), S1[i + 3]); }
    const float tm = swap_max(fmaxf(ta, tb));
    if (first || __any(tm > 8.f)) {
        const float mnew = bf2f(f2bf(mx + (first ? tm : fmaxf(tm, 0.f))));
        const float dl = mnew - mx;
        mx = mnew;
        qxw = h ? 0u : (unsigned)f2bf(-mnew);
        const float alpha = first ? 1.f : __builtin_amdgcn_exp2f(-dl);
        ls *= alpha;
#pragma unroll
        for (int i = 0; i < 16; ++i) { S0[i] -= dl; S1[i] -= dl; Oa[i] *= alpha; Ob[i] *= alpha; }
    }
    float sa = 0.f, sb = 0.f;
#pragma unroll
    for (int i = 0; i < 16; ++i) { S0[i] = __builtin_amdgcn_exp2f(S0[i]); S1[i] = __builtin_amdgcn_exp2f(S1[i]); sa += S0[i]; asm("" : "+v"(sa)); sb += S1[i]; asm("" : "+v"(sb)); }
    ls += sa + sb;
    pf[0][0] = pack8(S0, 0); pf[0][1] = pack8(S0, 1); pf[1][0] = pack8(S1, 0); pf[1][1] = pack8(S1, 1);
}
__device__ __forceinline__ void dqk(f32x16& S0, f32x16& S1, unsigned qxw, lds_t kb, const bf16x8 (&q)[2], int h) {
    const bf16x8 kones = __builtin_bit_cast(bf16x8, (u32x4){h ? 0u : 0x3f80u, 0u, 0u, 0u}), qx = __builtin_bit_cast(bf16x8, (u32x4){qxw, 0u, 0u, 0u});
    S0 = (f32x16){}; S1 = (f32x16){};
#pragma unroll
    for (int ks = 0; ks < 2; ++ks) { S0 = MFMA32(lds16(kb + 32 * ks), q[ks], S0); S1 = MFMA32(lds16(kb + 32 * DKS + 32 * ks), q[ks], S1); }
    S0 = MFMA32(kones, qx, S0); S1 = MFMA32(kones, qx, S1);
}
#define SBAR() __builtin_amdgcn_sched_barrier(0)
__device__ __forceinline__ void diff_item(const Params& P, int l, int seq, int qb, lds_t lds, float lam, float oscale) {
    const int tid = otid(), lane = tid & 63, w = tid >> 6, r = lane & 31, h = lane >> 5; unsigned char* const ws_ = optr(P.ws);
    const int b = seq >> 2, hd = seq & 3;
    const size_t row0 = (size_t)b * SEQ;
    const bf16_t* Z = (const bf16_t*)(ws_ + WS_ZB);
    const int qrow = qb * 256 + w * 32 + r, wmin = qb * 256 + w * 32;
    const bf16_t* qp = Z + (row0 + qrow) * ZP + ZC_DQ + hd * 64;
    bf16x8 qf[2][2];
#pragma unroll
    for (int m = 0; m < 2; ++m)
#pragma unroll
        for (int ks = 0; ks < 2; ++ks) qf[m][ks] = *(const bf16x8*)(qp + 32 * m + 16 * ks + 8 * h);
    f32x16 O[2][2] = {};
    unsigned qxw[2] = {0u, 0u};
    float mx[2] = {0.f, 0.f}, ls[2] = {0.f, 0.f};
    const int NT = 4 * qb + 4, Tw = 4 * qb + (w >> 1) + 1;
    const int skey = tid >> 3, sch = tid & 7;
    const bf16_t* kg = Z + (row0 + skey) * ZP + ZC_DK + hd * 64 + 8 * sch; const bf16_t* vg = Z + (row0 + skey) * ZP + ZC_DV + hd * 64 + 8 * sch;
    lds_t Os = lds + 3 * DBUF;
    const int soffk = skey * DKS + sch * 16, soffv = DK_BYTES + skey * DVS + sch * 16;
    const int koff = r * DKS + 16 * h, voff = DK_BYTES + (((lane & 15) >> 2) + 4 * h) * DVS + (16 * ((lane >> 4) & 1) + 4 * (lane & 3)) * 2;
    u32x4 kreg = *(const u32x4*)kg, vreg = *(const u32x4*)vg;
    *(LAS u32x4*)(lds + soffk) = kreg; *(LAS u32x4*)(lds + soffv) = vreg;
    kreg = *(const u32x4*)(kg + (size_t)64 * ZP); vreg = *(const u32x4*)(vg + (size_t)64 * ZP);
    __syncthreads();
    f32x16 S0a, S0b, S1a, S1b;
    bf16x8 pf0[2][2], pf1[2][2];
    dqk(S0a, S0b, qxw[0], lds + koff, qf[0], h);
    int bc = 0, bn = DBUF;
    for (int t = 0; t < NT; ++t) {
        const bool act = t < Tw, needmask = (64 * t + 63 > wmin);
        lds_t Tb = lds + bc, Tn = lds + bn;
        SBAR();
        if (act) {
            dqk(S1a, S1b, qxw[1], Tb + koff + 64, qf[1], h);
            dsoftmax(S0a, S0b, qxw[0], O[0][0], O[0][1], mx[0], ls[0], pf0, t == 0, needmask, 64 * t, qrow, h);
        }
        SBAR();
        if (t + 1 < NT) { *(LAS u32x4*)(Tn + soffk) = kreg; *(LAS u32x4*)(Tn + soffv) = vreg; }
        __syncthreads();
        if (t + 2 < NT) { kreg = *(const u32x4*)(kg + (size_t)(t + 2) * 64 * ZP); vreg = *(const u32x4*)(vg + (size_t)(t + 2) * 64 * ZP); }
        SBAR();
        if (act) {
            if (t + 1 < Tw) dqk(S0a, S0b, qxw[0], Tn + koff, qf[0], h);
            dsoftmax(S1a, S1b, qxw[1], O[1][0], O[1][1], mx[1], ls[1], pf1, t == 0, needmask, 64 * t, qrow, h);
            SBAR();
#pragma unroll
            for (int kh = 0; kh < 2; ++kh)
#pragma unroll
                for (int s2 = 0; s2 < 2; ++s2) {
                    bf16x8 vf[2];
#pragma unroll
                    for (int dt = 0; dt < 2; ++dt) { lds_t vp = Tb + voff + (32 * kh + 16 * s2) * DVS + 64 * dt; const s16x4 lo = vtr(vp), hi = vtr(vp + 8 * DVS); vf[dt] = __builtin_shufflevector(lo, hi, 0, 1, 2, 3, 4, 5, 6, 7); }
                    O[0][0] = MFMA32(vf[0], pf0[kh][s2], O[0][0]); O[0][1] = MFMA32(vf[1], pf0[kh][s2], O[0][1]);
                    O[1][0] = MFMA32(vf[0], pf1[kh][s2], O[1][0]); O[1][1] = MFMA32(vf[1], pf1[kh][s2], O[1][1]);
                }
        }
        bc = bn; bn = (bn == 2 * DBUF) ? 0 : bn + DBUF;
    }
    const float i1 = 1.f / swap_add(ls[0]), i2 = lam / swap_add(ls[1]);
    float ss = 0.f;
#pragma unroll
    for (int dt = 0; dt < 2; ++dt)
#pragma unroll
        for (int i = 0; i < 16; ++i) { const float o = O[0][dt][i] * i1 - O[1][dt][i] * i2; O[0][dt][i] = o; ss += o * o; }
    ss = swap_add(ss);
    const float rn = oscale / sqrtf(ss * (1.f / 64.f) + EPS);
    lds_t Ow = Os + w * 32 * RS64;
#pragma unroll
    for (int dt = 0; dt < 2; ++dt)
#pragma unroll
        for (int i = 0; i < 16; ++i) *(LAS bf16_t*)(Ow + r * RS64 + (32 * dt + crow(i, h)) * 2) = f2bf(O[0][dt][i] * rn);
    asm volatile("s_waitcnt lgkmcnt(0)" ::: "memory");
    bf16_t* CAT = (bf16_t*)(ws_ + WS_CAT);
    const float* sg = P.in[12] + l * 64;
#pragma unroll
    for (int it = 0; it < 4; ++it) { const int row = it * 8 + (lane >> 3), ch = lane & 7; const u32x4 v = *(const LAS u32x4*)(Ow + row * RS64 + ch * 16);
        const f32x4 g0 = *(const f32x4*)(sg + 8 * ch), g1 = *(const f32x4*)(sg + 8 * ch + 4);
        u32x4 o; o.x = pk2(bflo(v.x) * g0[0], bfhi(v.x) * g0[1]); o.y = pk2(bflo(v.y) * g0[2], bfhi(v.y) * g0[3]); o.z = pk2(bflo(v.z) * g1[0], bfhi(v.z) * g1[1]); o.w = pk2(bflo(v.w) * g1[2], bfhi(v.w) * g1[3]);
        *(u32x4*)(CAT + (row0 + wmin + row) * DM + 768 + hd * 64 + 8 * ch) = o; }
    __syncthreads();
}
#undef SBAR

constexpr int N_PHASES = 19;
__global__ void __launch_bounds__(NTHREADS, 2) hybrid_fwd(Params P) {
    extern __shared__ __attribute__((aligned(16))) unsigned char lds_raw[];
    lds_t lds = (lds_t)lds_raw;
    cg::grid_group grid = cg::this_grid();
    const int G = gridDim.x, lo = P.ph_lo, hi = P.ph_hi;
    int ph = 0;
#define PHASE_BEGIN(k) if (((PH_MASK >> (k)) & 1) && lo <= ph && ph < hi) { for (int rep_ = 0; rep_ <= ((REP_MASK >> (k)) & 1); ++rep_) { if (rep_) grid.sync();
#define PHASE_END   } if (ph + 1 < hi) grid.sync(); } ++ph;
    PHASE_BEGIN(0) prologue(P, lds, G); PHASE_END
    for (int l = 0; l < 2; ++l) {
        unsigned char* wb = P.ws + WS_W + (size_t)l * W_LAYER;
        bf16_t* XB = (bf16_t*)(P.ws + WS_XB); float* RS = (float*)(P.ws + WS_RS);
        PHASE_BEGIN(1) {
            pg8::Gemm g{XB, (const bf16_t*)(wb + W_IN), NTOK, ZP, DM}; pg8::StaticOrder S; S.init(NTOK, ZP, G, (int)blockIdx.x);
            pg8::EpiInProj E{(bf16_t*)(P.ws + WS_ZB), RS, (const f32x2*)(P.ws + WS_ROPE)};
            pg8::gemm_phase<pg8::EpiInProj, pg8::StaticOrder, true, true>(lds, g, S, E);
        } PHASE_END
        PHASE_BEGIN(2) {
            for (int it = blockIdx.x; it < 2048; it += G) mlstm_a_item(P, l, it, lds);
            for (int it = blockIdx.x; it < 1024; it += G) swa_item(P, l, it, lds);
        } PHASE_END
        PHASE_BEGIN(3) {
            mlstm_scan(P, G);
            float d1 = 0.f, d2 = 0.f;
            for (int i = 0; i < 32; ++i) { d1 += P.in[8][l * 32 + i] * P.in[9][l * 32 + i]; d2 += P.in[10][l * 32 + i] * P.in[11][l * 32 + i]; }
            const float lam_init = 0.8f - 0.6f * expf(-0.3f * (float)l);
            const float lam = expf(d1) - expf(d2) + lam_init;
            for (int vg = blockIdx.x; vg < 256; vg += G) {
                const int seq = vg >> 3, j = vg & 7;
                diff_item(P, l, seq, 31 - j, lds, lam, 1.f - lam_init);
                diff_item(P, l, seq, 16 + j, lds, lam, 1.f - lam_init);
                diff_item(P, l, seq, 15 - j, lds, lam, 1.f - lam_init);
                diff_item(P, l, seq, j, lds, lam, 1.f - lam_init);
            }
        } PHASE_END
        PHASE_BEGIN(4) {
            for (int it = blockIdx.x; it < 2048; it += G) mlstm_c_item(P, l, it, lds);
        } PHASE_END
        PHASE_BEGIN(5) {
            pg8::Gemm g{(const bf16_t*)(P.ws + WS_CAT), (const bf16_t*)(wb + W_OUT), NTOK, DM, DM}; pg8::StaticOrder S; S.init(NTOK, DM, G, (int)blockIdx.x);
            pg8::EpiRow<0> E{(bf16_t*)(P.ws + WS_MIX), DM, nullptr};
            pg8::gemm_phase<pg8::EpiRow<0>, pg8::StaticOrder, true, true>(lds, g, S, E);
        } PHASE_END
        PHASE_BEGIN(6) resid_pass(P, P.in[17] + l * DM, false, G); PHASE_END
        PHASE_BEGIN(7) {
            pg8::Gemm g{XB, (const bf16_t*)(wb + W_UP), NTOK, FF, DM}; pg8::StaticOrder S; S.init(NTOK, FF, G, (int)blockIdx.x);
            pg8::EpiRow<1> E{(bf16_t*)(P.ws + WS_U), FF, RS};
            pg8::gemm_phase<pg8::EpiRow<1>, pg8::StaticOrder, true, true>(lds, g, S, E);
        } PHASE_END
        PHASE_BEGIN(8) {
            pg8::Gemm g{(const bf16_t*)(P.ws + WS_U), (const bf16_t*)(wb + W_DOWN), NTOK, DM, FF}; pg8::StaticOrder S; S.init(NTOK, DM, G, (int)blockIdx.x);
            pg8::EpiRow<0> E{(bf16_t*)(P.ws + WS_MIX), DM, nullptr};
            pg8::gemm_phase<pg8::EpiRow<0>, pg8::StaticOrder, true, true>(lds, g, S, E);
        } PHASE_END
        PHASE_BEGIN(9) resid_pass(P, P.in[19] + l * DM, l == 1, G); PHASE_END
    }
#undef PHASE_BEGIN
#undef PHASE_END
}

extern "C" void kernel_launch(void* const* d_in, const int* in_sizes, int n_in, void* d_out, int out_size, void* d_ws, size_t ws_size, hipStream_t stream) {
    static int grid = 0;
    if (grid == 0) {
        if (n_in != 20 || out_size != NTOK * DM || ws_size < WS_END) { fprintf(stderr, "kernel_launch: unexpected shapes (n_in %d out %d ws %zu)\n", n_in, out_size, ws_size); grid = -1; return; }
        int dev = 0, cus = 0, per_cu = 0;
        hipGetDevice(&dev); hipDeviceGetAttribute(&cus, hipDeviceAttributeMultiprocessorCount, dev);
        if (hipFuncSetAttribute((const void*)hybrid_fwd, hipFuncAttributeMaxDynamicSharedMemorySize, LDS_BYTES) != hipSuccess) { fprintf(stderr, "kernel_launch: hipFuncSetAttribute failed\n"); grid = -1; return; }
        if (hipOccupancyMaxActiveBlocksPerMultiprocessor(&per_cu, (const void*)hybrid_fwd, NTHREADS, LDS_BYTES) != hipSuccess || per_cu < 1) { fprintf(stderr, "kernel_launch: occupancy query says %d\n", per_cu); per_cu = 1; }
        (void)hipGetLastError();
        grid = cus;
    }
    if (grid < 0) return;
    Params p{};
    for (int i = 0; i < 20; ++i) p.in[i] = (const float*)d_in[i];
    p.out = (float*)d_out; p.ws = (unsigned char*)d_ws;
#if ONE_LAUNCH
    p.ph_lo = 0; p.ph_hi = N_PHASES;
    void* args[] = {&p};
    hipError_t e = hipLaunchCooperativeKernel((const void*)hybrid_fwd, dim3(grid), dim3(NTHREADS), args, LDS_BYTES, stream);
    if (e != hipSuccess) fprintf(stderr, "cooperative launch failed: %s (grid %d)\n", hipGetErrorString(e), grid);
#else
    for (int ph = 0; ph < N_PHASES; ++ph) {
        p.ph_lo = ph; p.ph_hi = ph + 1;
        hipLaunchKernelGGL(hybrid_fwd, dim3(grid), dim3(NTHREADS), LDS_BYTES, stream, p);
    }
#endif
}
```

```cpp
#include <hip/hip_runtime.h>
#include <hip/hip_cooperative_groups.h>
#include <cstdio>
#include <cstdint>
namespace cg = cooperative_groups;

#ifndef PH_MASK
#define PH_MASK 0x3ff
#endif
#ifndef REP_MASK
#define REP_MASK 0
#endif
#ifndef ONE_LAUNCH
#define ONE_LAUNCH 1
#endif

#define LAS __attribute__((address_space(3)))
typedef unsigned short bf16_t;
typedef short bf16x8 __attribute__((ext_vector_type(8)));
typedef short s16x4 __attribute__((ext_vector_type(4)));
typedef float f32x4 __attribute__((ext_vector_type(4)));
typedef float f32x2 __attribute__((ext_vector_type(2)));
typedef float f32x16 __attribute__((ext_vector_type(16)));
typedef unsigned u32x4 __attribute__((ext_vector_type(4)));
typedef unsigned u32x2 __attribute__((ext_vector_type(2)));
typedef __bf16 bf16x2_t __attribute__((ext_vector_type(2)));
typedef LAS unsigned char* lds_t;

constexpr int BATCH = 8, SEQ = 8192, DM = 1024, FF = 4096, NTOK = BATCH * SEQ;
constexpr int INW = 2568, ZP = 2816;
constexpr int ZC_MQ = 0, ZC_MK = 256, ZC_MV = 512, ZC_MO = 768, ZC_SQ = 1024, ZC_SK = 1536, ZC_SV = 1664, ZC_DQ = 1792, ZC_DK = 2048, ZC_DV = 2304, ZC_G = 2560;
constexpr float EPS = 1e-6f;
constexpr float DQ_SCALE = 0.17677669529663687f * 1.4426950408889634f;
constexpr int NWAVES = 8, NTHREADS = 512;

constexpr size_t MiB = 1u << 20;
constexpr size_t WS_W = 2 * MiB;
constexpr size_t W_LAYER = 24 * MiB, W_IN = 0, W_OUT = 6 * MiB, W_UP = 8 * MiB, W_DOWN = 16 * MiB;
constexpr size_t WS_ROPE = 50 * MiB;
constexpr size_t WS_RS = 52 * MiB;
constexpr size_t WS_XB = 54 * MiB;
constexpr size_t WS_MIX = 182 * MiB;
constexpr size_t WS_U = 310 * MiB;
constexpr size_t WS_ZB = 310 * MiB;
constexpr size_t WS_CAT = 662 * MiB;
constexpr size_t WS_DC = 822 * MiB;
constexpr size_t WS_DN = 854 * MiB;
constexpr size_t WS_DEC = 855 * MiB;
constexpr size_t WS_CS = 856 * MiB;
constexpr size_t WS_NS = 872 * MiB;
constexpr size_t WS_END = 874 * MiB;

constexpr int LDS_BYTES = 147456;

struct Params {
    const float* in[20];
    float* out;
    unsigned char* ws;
    int ph_lo, ph_hi;
};

__device__ __forceinline__ unsigned pk2(float lo, float hi) { f32x2 v = {lo, hi}; bf16x2_t b = __builtin_convertvector(v, bf16x2_t); return __builtin_bit_cast(unsigned, b); }
__device__ __forceinline__ bf16_t f2bf(float f) { return (bf16_t)(pk2(f, 0.f) & 0xffffu); }
__device__ __forceinline__ float bf2f(unsigned u16) { return __uint_as_float(u16 << 16); }
__device__ __forceinline__ float bflo(unsigned w) { return __uint_as_float(w << 16); }
__device__ __forceinline__ float bfhi(unsigned w) { return __uint_as_float(w & 0xffff0000u); }
__device__ __forceinline__ int crow(int i, int h) { return (i & 3) + 8 * (i >> 2) + 4 * h; }
__device__ __forceinline__ float wave_sum(float v) {
#pragma unroll
    for (int o = 1; o < 64; o <<= 1) v += __shfl_xor(v, o);
    return v;
}
__device__ __forceinline__ float swap_add(float v) { auto rr = __builtin_amdgcn_permlane32_swap(__float_as_uint(v), __float_as_uint(v), false, false); return __uint_as_float(rr[0]) + __uint_as_float(rr[1]); }
__device__ __forceinline__ float swap_max(float v) { auto rr = __builtin_amdgcn_permlane32_swap(__float_as_uint(v), __float_as_uint(v), false, false); return fmaxf(__uint_as_float(rr[0]), __uint_as_float(rr[1])); }
#define MFMA32(a, b, c) __builtin_amdgcn_mfma_f32_32x32x16_bf16((a), (b), (c), 0, 0, 0)
__device__ __forceinline__ bf16x8 pack8(const f32x16& x, int s) {
    u32x4 p; p.x = pk2(x[8 * s], x[8 * s + 1]); p.y = pk2(x[8 * s + 2], x[8 * s + 3]); p.z = pk2(x[8 * s + 4], x[8 * s + 5]); p.w = pk2(x[8 * s + 6], x[8 * s + 7]);
    return __builtin_bit_cast(bf16x8, p);
}
__device__ __forceinline__ bf16x8 lds16(lds_t p) { return *(const LAS bf16x8*)p; }
__device__ __forceinline__ bf16x8 lds8x2(lds_t p0, lds_t p1) { s16x4 a = *(const LAS s16x4*)p0, b = *(const LAS s16x4*)p1; return __builtin_shufflevector(a, b, 0, 1, 2, 3, 4, 5, 6, 7); }
__device__ __forceinline__ float sigmoidf_(float x) { return 1.f / (1.f + __expf(-x)); }
__device__ __forceinline__ float logsigmoidf_(float x) { return fminf(x, 0.f) - log1pf(__expf(-fabsf(x))); }

__device__ __forceinline__ int otid() { int t = threadIdx.x; asm volatile("" : "+v"(t)); return t; }
__device__ __forceinline__ size_t ozero() { unsigned z = 0; asm volatile("" : "+s"(z)); return (size_t)z; }
template <class T> __device__ __forceinline__ T* optr(T* p) { return p + ozero(); }
namespace pg8 {
constexpr int BM = 256, BK = 64, HALF = 128, HTB = HALF * BK * 2, STAGE_BYTES = 8 * HTB, NXCD = 8, WGM = 8;
__host__ __device__ __forceinline__ int lds_byte(int r, int c) { const int st = (r >> 4) * 2 + (c >> 5), rr = r & 15, cc = c & 31, ob = rr * 64 + cc * 2; return st * 1024 + (ob ^ (((ob >> 9) & 1) << 5)); }
__host__ __device__ __forceinline__ void stage_rc(int b, int& R, int& C) { const int st = b / 1024, sb = b % 1024, swz = sb ^ (((sb >> 9) & 1) << 5); R = (st >> 1) * 16 + swz / 64; C = (st & 1) * 32 + (swz % 64) / 2; }
__host__ __device__ __forceinline__ int perm32(int rho) { const int n = rho >> 4, i = rho & 15; return 8 * (i >> 2) + 4 * n + (i & 3); }
struct Unit { int pm, pn; };
struct Gemm { const bf16_t* A; const bf16_t* Bt; int M, N, K; };
struct StaticOrder {
    int nM, nN, nwg, G, c;
    __host__ __device__ void init(int M, int N, int G_, int c_) { nM = M / BM; nN = N / BM; nwg = nM * nN; G = G_; c = c_; }
    __host__ __device__ bool next(int i, Unit& u) const {
        const long L = (long)i * G + c; if (L >= nwg) return false;
        int wgid = (int)L; { const int q = nwg / NXCD, r = nwg % NXCD, xcd = wgid % NXCD, off = wgid / NXCD; wgid = (xcd < r ? xcd * (q + 1) : r * (q + 1) + (xcd - r) * q) + off; }
        const int nig = WGM * nN, gid = wgid / nig, fm = gid * WGM, gsz = (nM - fm) < WGM ? (nM - fm) : WGM;
        u.pm = fm + ((wgid % nig) % gsz); u.pn = (wgid % nig) / gsz; return true;
    }
    __device__ __forceinline__ void a_ready(const Unit&) const {}
    __device__ __forceinline__ void done(const Unit&) const {}
};

template <int ACT> struct EpiRow {
    static constexpr bool PERM = true, AFTER_DRAIN = false;
    bf16_t* O; int ldc; const float* rs;
    __device__ __forceinline__ void operator()(const f32x4 (&acc)[2][2][4][2], const Unit& u, int wr, int wc, int fr, int fq) const {
        const int row0 = u.pm * BM + wr * 64 + fr, col0 = u.pn * BM + wc * 32 + 8 * fq;
#pragma unroll
        for (int ai = 0; ai < 2; ++ai)
#pragma unroll
            for (int m = 0; m < 4; ++m) { const int row = row0 + ai * HALF + m * 16; const float s = rs ? rs[row] : 1.f; bf16_t* rowp = O + (size_t)row * ldc + col0;
#pragma unroll
                for (int bj = 0; bj < 2; ++bj) { f32x4 v0 = acc[ai][bj][m][0] * s, v1 = acc[ai][bj][m][1] * s;
                    if (ACT == 1) {
#pragma unroll
                        for (int i = 0; i < 4; ++i) { const float a = fmaxf(v0[i], 0.f), b = fmaxf(v1[i], 0.f); v0[i] = a * a; v1[i] = b * b; } }
                    u32x4 w; w.x = pk2(v0[0], v0[1]); w.y = pk2(v0[2], v0[3]); w.z = pk2(v1[0], v1[1]); w.w = pk2(v1[2], v1[3]);
                    *(u32x4*)(rowp + bj * HALF) = w; } }
    }
};
struct EpiInProj {
    static constexpr bool PERM = true, AFTER_DRAIN = false;
    bf16_t* O; const float* rs; const f32x2* rope;
    __device__ __forceinline__ void operator()(const f32x4 (&acc)[2][2][4][2], const Unit& u, int wr, int wc, int fr, int fq) const {
        const int row0 = u.pm * BM + wr * 64 + fr, col0 = u.pn * BM + wc * 32 + 8 * fq;
        const int pn = u.pn;
        const int j64 = 4 * (wc & 1) + fq;
#pragma unroll
        for (int ai = 0; ai < 2; ++ai)
#pragma unroll
            for (int m = 0; m < 4; ++m) { const int row = row0 + ai * HALF + m * 16; const float s = rs[row]; bf16_t* rowp = O + (size_t)row * ZP + col0;
                const f32x2* tb = rope + (size_t)(row & (SEQ - 1)) * 32;
#pragma unroll
                for (int bj = 0; bj < 2; ++bj) { f32x4 v0 = acc[ai][bj][m][0] * s, v1 = acc[ai][bj][m][1] * s;
                    const bool r64 = (pn == 4) || (pn == 5) || (pn == 6 && bj == 0), r32 = (pn == 7) || (pn == 8);
                    if (r64 || r32) {
                        f32x2 cs[4];
                        if (r64) { const f32x4 t0 = *(const f32x4*)(tb + 4 * j64), t1 = *(const f32x4*)(tb + 4 * j64 + 2); cs[0] = (f32x2){t0[0], t0[1]}; cs[1] = (f32x2){t0[2], t0[3]}; cs[2] = (f32x2){t1[0], t1[1]}; cs[3] = (f32x2){t1[2], t1[3]}; }
                        else {
#pragma unroll
                            for (int i = 0; i < 4; ++i) cs[i] = tb[8 * fq + 2 * i]; }
#pragma unroll
                        for (int i = 0; i < 4; ++i) { const float a = v0[i], b = v1[i]; v0[i] = a * cs[i].x - b * cs[i].y; v1[i] = b * cs[i].x + a * cs[i].y; }
                        if (pn == 7) { v0 = v0 * DQ_SCALE; v1 = v1 * DQ_SCALE; }
                    }
                    u32x4 w; w.x = pk2(v0[0], v0[1]); w.y = pk2(v0[2], v0[3]); w.z = pk2(v1[0], v1[1]); w.w = pk2(v1[2], v1[3]);
                    *(u32x4*)(rowp + bj * HALF) = w; } }
    }
};

template <class Epi, class Sched, bool ALIGN_EPI = false, bool SP2 = false>
__device__ __forceinline__ void gemm_phase(lds_t lds, const Gemm g, const Sched& S, const Epi& E) {
    const int tid = otid(), wid = __builtin_amdgcn_readfirstlane(tid >> 6), lane = tid & 63, wr = wid >> 2, wc = wid & 3, fr = lane & 15, fq = lane >> 4;
    const int K = g.K, nt = K / BK;
    unsigned voffA[2], voffB[2];
#pragma unroll
    for (int i = 0; i < 2; ++i) { int R, C; stage_rc(tid * 16 + i * 8192, R, C); const int Rb = Epi::PERM ? ((R & ~31) + perm32(R & 31)) : R;
        voffA[i] = (unsigned)(R * K + C) * 2u; voffB[i] = (unsigned)(Rb * K + C) * 2u; }
    const size_t kstep = (size_t)(BK * 2);
    const size_t hstep = (size_t)HALF * K * 2;
    const size_t tstep = 2 * hstep;
    const unsigned ldsw = (unsigned)wid * 1024u;
    const int aoff = lds_byte(wr * 64 + fr, fq * 8), boff = lds_byte(wc * 32 + fr, fq * 8);
#define PG8_SA(b, h) (((b) * 2 + (h)) * HTB)
#define PG8_SB(b, h) ((4 + (b) * 2 + (h)) * HTB)
#define PG8_STAGE(bufoff, gbase, voff) do { _Pragma("unroll") for (int _i = 0; _i < 2; ++_i) \
        __builtin_amdgcn_global_load_lds((const unsigned*)((const char*)(gbase) + (voff)[_i]), (LAS unsigned*)(lds + (bufoff) + ldsw + _i * 8192), 16, 0, 0); } while (0)
#define PG8_LDA(dst, b, h) do { _Pragma("unroll") for (int m = 0; m < 4; ++m) _Pragma("unroll") for (int k = 0; k < 2; ++k) dst[m][k] = *(const LAS bf16x8*)(lds + PG8_SA(b, h) + aoff + m * 2048 + k * 1024); } while (0)
#define PG8_LDB(dst, b, h) do { _Pragma("unroll") for (int n = 0; n < 2; ++n) _Pragma("unroll") for (int k = 0; k < 2; ++k) dst[n][k] = *(const LAS bf16x8*)(lds + PG8_SB(b, h) + boff + n * 2048 + k * 1024); } while (0)
#define PG8_MMA(ai, bj, At, Bt) do { __builtin_amdgcn_s_setprio(1); _Pragma("unroll") for (int m = 0; m < 4; ++m) _Pragma("unroll") for (int n = 0; n < 2; ++n) _Pragma("unroll") for (int k = 0; k < 2; ++k) \
        acc[ai][bj][m][n] = __builtin_amdgcn_mfma_f32_16x16x32_bf16(Bt[n][k], At[m][k], acc[ai][bj][m][n], 0, 0, 0); __builtin_amdgcn_s_setprio(0); } while (0)
#define PG8_WAIT_V(n) asm volatile("s_waitcnt vmcnt(" #n ")" ::: "memory")
#define PG8_WAIT_L(n) asm volatile("s_waitcnt lgkmcnt(" #n ")" ::: "memory")
#define PG8_BAR __builtin_amdgcn_s_barrier()
#define PG8_SCHED __builtin_amdgcn_sched_barrier(0)
    Unit cur, nxt; int ui = 0;
    if (!S.next(0, cur)) return;
    f32x4 acc[2][2][4][2];
#pragma unroll
    for (int a = 0; a < 2; ++a)
#pragma unroll
        for (int b = 0; b < 2; ++b)
#pragma unroll
            for (int m = 0; m < 4; ++m)
#pragma unroll
                for (int n = 0; n < 2; ++n) acc[a][b][m][n] = (f32x4){0.f, 0.f, 0.f, 0.f};
    bf16x8 At[4][2], B0[2][2], B1[2][2];
    const char* cA = (const char*)g.A + (size_t)cur.pm * tstep; const char* cB = (const char*)g.Bt + (size_t)cur.pn * tstep;
    S.a_ready(cur);
    if constexpr (SP2) {
        PG8_STAGE(PG8_SB(0, 0), cB, voffB); PG8_STAGE(PG8_SB(0, 1), cB + hstep, voffB); PG8_STAGE(PG8_SA(0, 0), cA, voffA); PG8_STAGE(PG8_SA(0, 1), cA + hstep, voffA);
        if (wr == 1) PG8_BAR;
        PG8_WAIT_V(2); PG8_BAR;
        PG8_STAGE(PG8_SB(1, 0), cB + kstep, voffB); PG8_STAGE(PG8_SA(1, 0), cA + kstep, voffA); PG8_STAGE(PG8_SB(1, 1), cB + hstep + kstep, voffB);
        PG8_WAIT_V(6); PG8_BAR;
    } else {
        PG8_STAGE(PG8_SB(0, 0), cB, voffB); PG8_STAGE(PG8_SA(0, 0), cA, voffA); PG8_STAGE(PG8_SB(0, 1), cB + hstep, voffB); PG8_STAGE(PG8_SA(0, 1), cA + hstep, voffA);
        if (wr == 1) PG8_BAR;
        PG8_WAIT_V(4); PG8_BAR;
        PG8_STAGE(PG8_SB(1, 0), cB + kstep, voffB); PG8_STAGE(PG8_SA(1, 0), cA + kstep, voffA); PG8_STAGE(PG8_SB(1, 1), cB + hstep + kstep, voffB);
        PG8_WAIT_V(6); PG8_BAR;
    }
    for (;;) {
        const bool has_next = S.next(ui + 1, nxt);
        const char* nA = has_next ? (const char*)g.A + (size_t)nxt.pm * tstep : cA; const char* nB = has_next ? (const char*)g.Bt + (size_t)nxt.pn * tstep : cB;
        for (int t = 0; t < nt; t += 2) {
            const bool last = (t == nt - 2);
            const char* a1 = cA + (size_t)(t + 1) * kstep;
            const char* a2 = last ? nA : cA + (size_t)(t + 2) * kstep; const char* b2 = last ? nB : cB + (size_t)(t + 2) * kstep;
            const char* a3 = a2 + kstep; const char* b3 = b2 + kstep;
            if (last && has_next) S.a_ready(nxt);
            if constexpr (SP2) {
            PG8_LDB(B0, 0, 0); PG8_LDB(B1, 0, 1); PG8_SCHED; PG8_LDA(At, 0, 0); PG8_STAGE(PG8_SA(1, 1), a1 + hstep, voffA);
            PG8_WAIT_V(8); PG8_WAIT_L(0); PG8_BAR; PG8_MMA(0, 0, At, B0); PG8_MMA(0, 1, At, B1); PG8_BAR; PG8_SCHED;
            PG8_LDA(At, 0, 1); PG8_STAGE(PG8_SB(0, 0), b2, voffB); PG8_STAGE(PG8_SB(0, 1), b2 + hstep, voffB); PG8_STAGE(PG8_SA(0, 0), a2, voffA);
            PG8_WAIT_V(8); PG8_WAIT_L(0); PG8_BAR; PG8_MMA(1, 0, At, B0); PG8_MMA(1, 1, At, B1); PG8_BAR; PG8_SCHED;
            PG8_LDB(B0, 1, 0); PG8_LDB(B1, 1, 1); PG8_SCHED; PG8_LDA(At, 1, 0); PG8_STAGE(PG8_SA(0, 1), a2 + hstep, voffA);
            PG8_WAIT_V(8); PG8_WAIT_L(0); PG8_BAR; PG8_MMA(0, 0, At, B0); PG8_MMA(0, 1, At, B1); PG8_BAR; PG8_SCHED;
            PG8_LDA(At, 1, 1); PG8_STAGE(PG8_SB(1, 0), b3, voffB); PG8_STAGE(PG8_SB(1, 1), b3 + hstep, voffB); PG8_STAGE(PG8_SA(1, 0), a3, voffA);
            PG8_WAIT_V(8); PG8_WAIT_L(0); PG8_BAR; PG8_MMA(1, 0, At, B0); PG8_MMA(1, 1, At, B1); PG8_BAR; PG8_SCHED;
            } else {
            PG8_LDB(B0, 0, 0); PG8_SCHED; PG8_LDA(At, 0, 0); PG8_STAGE(PG8_SA(1, 1), a1 + hstep, voffA);
            PG8_WAIT_L(8); PG8_BAR; PG8_WAIT_L(0); PG8_MMA(0, 0, At, B0); PG8_BAR; PG8_SCHED;
            PG8_LDB(B1, 0, 1); PG8_STAGE(PG8_SB(0, 0), b2, voffB);
            PG8_BAR; PG8_WAIT_L(0); PG8_MMA(0, 1, At, B1); PG8_BAR;
            PG8_LDA(At, 0, 1); PG8_STAGE(PG8_SA(0, 0), a2, voffA);
            PG8_BAR; PG8_WAIT_L(0); PG8_MMA(1, 0, At, B0); PG8_BAR; PG8_SCHED;
            PG8_STAGE(PG8_SB(0, 1), b2 + hstep, voffB);
            PG8_WAIT_V(6); PG8_BAR; PG8_MMA(1, 1, At, B1); PG8_BAR;
            PG8_LDB(B0, 1, 0); PG8_SCHED; PG8_LDA(At, 1, 0); PG8_STAGE(PG8_SA(0, 1), a2 + hstep, voffA);
            PG8_WAIT_L(8); PG8_BAR; PG8_WAIT_L(0); PG8_MMA(0, 0, At, B0); PG8_BAR; PG8_SCHED;
            PG8_LDB(B1, 1, 1); PG8_STAGE(PG8_SB(1, 0), b3, voffB);
            PG8_BAR; PG8_WAIT_L(0); PG8_MMA(0, 1, At, B1); PG8_BAR;
            PG8_LDA(At, 1, 1); PG8_STAGE(PG8_SA(1, 0), a3, voffA);
            PG8_BAR; PG8_WAIT_L(0); PG8_MMA(1, 0, At, B0); PG8_BAR; PG8_SCHED;
            PG8_STAGE(PG8_SB(1, 1), b3 + hstep, voffB);
            PG8_WAIT_V(6); PG8_BAR; PG8_MMA(1, 1, At, B1); PG8_BAR;
            }
        }
        if constexpr (ALIGN_EPI) { if (wr == 0) PG8_BAR; }
        E(acc, cur, wr, wc, fr, fq); S.done(cur);
        if (!has_next) break;
#pragma unroll
        for (int a = 0; a < 2; ++a)
#pragma unroll
            for (int b = 0; b < 2; ++b)
#pragma unroll
                for (int m = 0; m < 4; ++m)
#pragma unroll
                    for (int n = 0; n < 2; ++n) acc[a][b][m][n] = (f32x4){0.f, 0.f, 0.f, 0.f};
        cur = nxt; cA = nA; cB = nB; ++ui;
        if constexpr (ALIGN_EPI) { if (wr == 1) PG8_BAR; }
    }
    PG8_WAIT_V(0);
    if constexpr (!ALIGN_EPI) { if (wr == 0) PG8_BAR; }
    PG8_BAR;
#undef PG8_SA
#undef PG8_SB
#undef PG8_STAGE
#undef PG8_LDA
#undef PG8_LDB
#undef PG8_MMA
#undef PG8_WAIT_V
#undef PG8_WAIT_L
#undef PG8_BAR
#undef PG8_SCHED
}
}

__device__ __forceinline__ int zsrc(int c) {
    if (c < 1024) return c;
    if (c < ZC_SK) { const int x = c - ZC_SQ, hh = x >> 6, p = x & 63, j = p >> 3, i = p & 7; return 1032 + hh * 64 + (i < 4 ? 4 * j + i : 32 + 4 * j + (i - 4)); }
    if (c < ZC_SV) { const int x = c - ZC_SK, hh = x >> 6, p = x & 63, j = p >> 3, i = p & 7; return 1544 + hh * 64 + (i < 4 ? 4 * j + i : 32 + 4 * j + (i - 4)); }
    if (c < ZC_DQ) return 1672 + (c - ZC_SV);
    if (c < ZC_DK) { const int x = c - ZC_DQ, hh = x >> 5, p = x & 31, j = p >> 3, i = p & 7; return 1800 + hh * 32 + (i < 4 ? 4 * j + i : 16 + 4 * j + (i - 4)); }
    if (c < ZC_DV) { const int x = c - ZC_DK, hh = x >> 5, p = x & 31, j = p >> 3, i = p & 7; return 2056 + hh * 32 + (i < 4 ? 4 * j + i : 16 + 4 * j + (i - 4)); }
    if (c < ZC_G) return 2312 + (c - ZC_DV);
    if (c < ZC_G + 8) return 1024 + (c - ZC_G);
    return -1;
}
template <bool MAPZ> __device__ __forceinline__ void transpose_item(const float* W, int K, int N, int Nst, const float* gk, bf16_t* WT, LAS float* scr, int item, int lane) {
    const int nblk = Nst / 32, kb = item / nblk, nb = item % nblk, k0 = 64 * kb, n0 = 32 * nb;
    const int nsrc = MAPZ ? zsrc(n0 + (lane & 31)) : (n0 + (lane & 31));
#pragma unroll 8
    for (int i = 0; i < 32; ++i) { const int kk = 2 * i + (lane >> 5); float v = 0.f; if (nsrc >= 0) v = W[(size_t)(k0 + kk) * N + nsrc]; if (gk) v *= gk[k0 + kk]; scr[kk * 33 + (lane & 31)] = v; }
    asm volatile("s_waitcnt lgkmcnt(0)" ::: "memory");
    const int c = lane & 7;
#pragma unroll
    for (int j = 0; j < 4; ++j) { const int n = (lane >> 3) + 8 * j; const LAS float* s = scr + (8 * c) * 33 + n;
        u32x4 o; o.x = pk2(s[0 * 33], s[1 * 33]); o.y = pk2(s[2 * 33], s[3 * 33]); o.z = pk2(s[4 * 33], s[5 * 33]); o.w = pk2(s[6 * 33], s[7 * 33]);
        *(u32x4*)(WT + (size_t)(n0 + n) * K + k0 + 8 * c) = o; }
    asm volatile("s_waitcnt lgkmcnt(0)" ::: "memory");
}
__device__ __forceinline__ void sincos_red(double x, float& c, float& s) {
    const double k = rint(x * 0.15915494309189535), r = x - k * 6.283185307179586, r2 = r * r;
    double sn = 1.0, cs = 1.0;
#pragma unroll
    for (int n = 14; n >= 1; --n) { sn = 1.0 - r2 * (1.0 / (double)((2 * n) * (2 * n + 1))) * sn; cs = 1.0 - r2 * (1.0 / (double)((2 * n - 1) * (2 * n))) * cs; }
    s = (float)(r * sn); c = (float)cs;
}
__device__ __forceinline__ void row_to_bf16(const float* xrow, bf16_t* orow, float* rs, int lane) {
    const f32x4* xr = (const f32x4*)xrow + lane;
    f32x4 v[4]; float s = 0.f;
#pragma unroll
    for (int j = 0; j < 4; ++j) { v[j] = xr[64 * j]; s += (v[j].x * v[j].x + v[j].y * v[j].y) + (v[j].z * v[j].z + v[j].w * v[j].w); }
    s = wave_sum(s);
    u32x2* o8 = (u32x2*)orow + lane;
#pragma unroll
    for (int j = 0; j < 4; ++j) o8[64 * j] = (u32x2){pk2(v[j].x, v[j].y), pk2(v[j].z, v[j].w)};
    if (lane == 0) *rs = 1.f / sqrtf(s * (1.f / DM) + EPS);
}
__device__ __forceinline__ void prologue(const Params& P, lds_t lds, int G) {
    const int tid = otid(), lane = tid & 63, wave = tid >> 6; unsigned char* const ws_ = optr(P.ws);
    LAS float* scr = (LAS float*)(lds + wave * 16384);
    const int gw = blockIdx.x * NWAVES + wave, NGW = G * NWAVES;
    constexpr int I_IN = (DM / 64) * (ZP / 32), I_OUT = (DM / 64) * (DM / 32), I_UP = (DM / 64) * (FF / 32), I_DN = (FF / 64) * (DM / 32), I_L = I_IN + I_OUT + I_UP + I_DN;
    for (int it = gw; it < 2 * I_L; it += NGW) {
        const int l = it / I_L; int r = it % I_L;
        unsigned char* wb = ws_ + WS_W + (size_t)l * W_LAYER;
        if (r < I_IN) { transpose_item<true>(P.in[1] + (size_t)l * DM * INW, DM, INW, ZP, P.in[16] + l * DM, (bf16_t*)(wb + W_IN), scr, r, lane); continue; } r -= I_IN;
        if (r < I_OUT) { transpose_item<false>(P.in[13] + (size_t)l * DM * DM, DM, DM, DM, nullptr, (bf16_t*)(wb + W_OUT), scr, r, lane); continue; } r -= I_OUT;
        if (r < I_UP) { transpose_item<false>(P.in[14] + (size_t)l * DM * FF, DM, FF, FF, P.in[18] + l * DM, (bf16_t*)(wb + W_UP), scr, r, lane); continue; } r -= I_UP;
        transpose_item<false>(P.in[15] + (size_t)l * FF * DM, FF, DM, DM, nullptr, (bf16_t*)(wb + W_DOWN), scr, r, lane);
    }
    f32x2* rope = (f32x2*)(ws_ + WS_ROPE);
    for (int e = blockIdx.x * NTHREADS + tid; e < SEQ * 32; e += G * NTHREADS) {
        const int pos = e >> 5, i = e & 31;
        const float inv = (float)exp(-(double)i * (9.210340371976184 / 32.0));
        const float ang = (float)pos * inv;
        float c, s; sincos_red((double)ang, c, s);
        rope[e] = (f32x2){c, s};
    }
    bf16_t* XB = (bf16_t*)(ws_ + WS_XB); float* RS = (float*)(ws_ + WS_RS);
    for (int m = gw; m < NTOK; m += NGW) row_to_bf16(P.in[0] + (size_t)m * DM, XB + (size_t)m * DM, RS + m, lane);
}

__device__ __forceinline__ void resid_pass(const Params& P, const float* gpost, bool last, int G) {
    const int tid = otid(), lane = tid & 63, wave = tid >> 6; unsigned char* const ws_ = optr(P.ws);
    const int gw = blockIdx.x * NWAVES + wave, NGW = G * NWAVES;
    const bf16_t* MIX = (const bf16_t*)(ws_ + WS_MIX); bf16_t* XB = (bf16_t*)(ws_ + WS_XB); float* RS = (float*)(ws_ + WS_RS);
    f32x4 gv[2][2];
#pragma unroll
    for (int j = 0; j < 2; ++j) { gv[j][0] = *(const f32x4*)(gpost + 512 * j + 8 * lane); gv[j][1] = *(const f32x4*)(gpost + 512 * j + 8 * lane + 4); }
    for (int m0 = gw; m0 < NTOK; m0 += 2 * NGW) {
        u32x4 mw[2][2], xw[2][2];
#pragma unroll
        for (int q = 0; q < 2; ++q) { const int m = m0 + q * NGW; if (m < NTOK) {
#pragma unroll
            for (int j = 0; j < 2; ++j) { mw[q][j] = *(const u32x4*)(MIX + (size_t)m * DM + 512 * j + 8 * lane); xw[q][j] = *(const u32x4*)(XB + (size_t)m * DM + 512 * j + 8 * lane); } } }
#pragma unroll
        for (int q = 0; q < 2; ++q) { const int m = m0 + q * NGW; if (m < NTOK) {
            f32x4 mv[2][2], bv[2][2]; float s = 0.f;
#pragma unroll
            for (int j = 0; j < 2; ++j) { const u32x4 w = mw[q][j], x = xw[q][j];
                mv[j][0] = (f32x4){bflo(w.x), bfhi(w.x), bflo(w.y), bfhi(w.y)}; mv[j][1] = (f32x4){bflo(w.z), bfhi(w.z), bflo(w.w), bfhi(w.w)};
                bv[j][0] = (f32x4){bflo(x.x), bfhi(x.x), bflo(x.y), bfhi(x.y)}; bv[j][1] = (f32x4){bflo(x.z), bfhi(x.z), bflo(x.w), bfhi(x.w)};
#pragma unroll
                for (int k = 0; k < 2; ++k) s += (mv[j][k].x * mv[j][k].x + mv[j][k].y * mv[j][k].y) + (mv[j][k].z * mv[j][k].z + mv[j][k].w * mv[j][k].w); }
            s = wave_sum(s);
            const float r = 1.f / sqrtf(s * (1.f / DM) + EPS);
            float s2 = 0.f;
#pragma unroll
            for (int j = 0; j < 2; ++j)
#pragma unroll
                for (int k = 0; k < 2; ++k) { bv[j][k] = bv[j][k] + mv[j][k] * r * gv[j][k]; s2 += (bv[j][k].x * bv[j][k].x + bv[j][k].y * bv[j][k].y) + (bv[j][k].z * bv[j][k].z + bv[j][k].w * bv[j][k].w); }
            if (last) {
#pragma unroll
                for (int j = 0; j < 2; ++j) { f32x4* o = (f32x4*)(P.out + (size_t)m * DM + 512 * j + 8 * lane); o[0] = bv[j][0]; o[1] = bv[j][1]; }
            } else {
                s2 = wave_sum(s2);
#pragma unroll
                for (int j = 0; j < 2; ++j) *(u32x4*)(XB + (size_t)m * DM + 512 * j + 8 * lane) = (u32x4){pk2(bv[j][0].x, bv[j][0].y), pk2(bv[j][0].z, bv[j][0].w), pk2(bv[j][1].x, bv[j][1].y), pk2(bv[j][1].z, bv[j][1].w)};
                if (lane == 0) RS[m] = 1.f / sqrtf(s2 * (1.f / DM) + EPS);
            }
        } }
    }
}

__device__ __forceinline__ void mlstm_gates(const bf16_t* Z, size_t t0, int hh, float ib, float fb, LAS float* bc, LAS float* ig, int tid) {
    if (tid < 64) {
        const int lane = tid;
        const bf16_t* g0 = Z + (t0 + 2 * lane) * ZP + ZC_G; const bf16_t* g1 = g0 + ZP;
        const float i0 = bf2f(g0[hh]) + ib, i1 = bf2f(g1[hh]) + ib;
        const float l0 = logsigmoidf_(bf2f(g0[4 + hh]) + fb), l1 = logsigmoidf_(bf2f(g1[4 + hh]) + fb);
        float x = l0 + l1;
#pragma unroll
        for (int o = 1; o < 64; o <<= 1) { const float t = __shfl_up(x, o); if (lane >= o) x += t; }
        bc[2 * lane] = x - l1; bc[2 * lane + 1] = x; ig[2 * lane] = i0; ig[2 * lane + 1] = i1;
    }
}
__device__ __forceinline__ void conv8(const bf16_t* zp, int tseq, const float* cw, const float* cb, int ch, float scale, float (&y)[8]) {
    const f32x4 b0 = *(const f32x4*)(cb + ch), b1 = *(const f32x4*)(cb + ch + 4);
    y[0] = b0[0]; y[1] = b0[1]; y[2] = b0[2]; y[3] = b0[3]; y[4] = b1[0]; y[5] = b1[1]; y[6] = b1[2]; y[7] = b1[3];
#pragma unroll
    for (int j = 0; j < 4; ++j) {
        if (tseq - 3 + j >= 0) {
            const u32x4 w = *(const u32x4*)(zp - (size_t)(3 - j) * ZP);
            const f32x4 c0 = *(const f32x4*)(cw + j * 512 + ch), c1 = *(const f32x4*)(cw + j * 512 + ch + 4);
            y[0] += bflo(w.x) * c0[0]; y[1] += bfhi(w.x) * c0[1]; y[2] += bflo(w.y) * c0[2]; y[3] += bfhi(w.y) * c0[3];
            y[4] += bflo(w.z) * c1[0]; y[5] += bfhi(w.z) * c1[1]; y[6] += bflo(w.w) * c1[2]; y[7] += bfhi(w.w) * c1[3];
        }
    }
#pragma unroll
    for (int i = 0; i < 8; ++i) y[i] = y[i] * sigmoidf_(y[i]) * scale;
}
constexpr int TS128 = 264;
constexpr int RS64 = 144;
constexpr int MA_LDS = 2 * 64 * TS128 + 3 * 128 * 4;
__device__ __forceinline__ void mlstm_a_pair(const Params& P, int l, int pair, lds_t lds0) {
    const int tid = otid(), lane = tid & 63, w = tid >> 6, r = lane & 31, h = lane >> 5; unsigned char* const ws_ = optr(P.ws);
    const int half = w >> 2, hw = w & 3, ht = tid & 255, item = 2 * pair + half;
    lds_t lds = lds0 + half * MA_LDS;
    const int c = item & 63, hh = (item >> 6) & 3, b = item >> 8;
    const size_t t0 = (size_t)b * SEQ + (size_t)c * 128;
    const bf16_t* Z = (const bf16_t*)(ws_ + WS_ZB);
    const float* cw = P.in[2] + l * 4 * 512; const float* cb = P.in[3] + l * 512;
    lds_t KT = lds, VT = lds + 64 * TS128; LAS float* bc = (LAS float*)(lds + 2 * 64 * TS128); LAS float* ig = bc + 128; LAS float* wst = ig + 128;
    mlstm_gates(Z, t0, hh, P.in[4][l * 4 + hh], P.in[5][l * 4 + hh], bc, ig, ht);
    __syncthreads();
    const float blast = bc[127];
    if (ht < 128) wst[ht] = __expf(blast - bc[ht] + ig[ht]);
    __syncthreads();
#pragma unroll
    for (int q = 0; q < 4; ++q) {
        const int e = ht + q * 256, s = e >> 3, ch = e & 7;
        float y[8];
        conv8(Z + (t0 + s) * ZP + ZC_MK + hh * 64 + 8 * ch, c * 128 + s, cw, cb, 256 + hh * 64 + 8 * ch, 0.125f, y);
#pragma unroll
        for (int i = 0; i < 8; ++i) *(LAS bf16_t*)(KT + (8 * ch + i) * TS128 + s * 2) = f2bf(y[i]);
        const u32x4 vw = *(const u32x4*)(Z + (t0 + s) * ZP + ZC_MV + hh * 64 + 8 * ch);
        const float ws2 = wst[s];
        const float vv[8] = {bflo(vw.x), bfhi(vw.x), bflo(vw.y), bfhi(vw.y), bflo(vw.z), bfhi(vw.z), bflo(vw.w), bfhi(vw.w)};
#pragma unroll
        for (int i = 0; i < 8; ++i) *(LAS bf16_t*)(VT + (8 * ch + i) * TS128 + s * 2) = f2bf(vv[i] * ws2);
    }
    __syncthreads();
    float* DC = (float*)(ws_ + WS_DC) + (size_t)item * 4096; float* DN = (float*)(ws_ + WS_DN) + (size_t)item * 64; float* DEC = (float*)(ws_ + WS_DEC);
    {
        const int vt = hw >> 1, kt = hw & 1;
        f32x16 acc = {};
#pragma unroll
        for (int ks = 0; ks < 8; ++ks) {
            const bf16x8 a = lds16(VT + (32 * vt + r) * TS128 + (16 * ks + 8 * h) * 2);
            const bf16x8 bb = lds16(KT + (32 * kt + r) * TS128 + (16 * ks + 8 * h) * 2);
            acc = MFMA32(a, bb, acc);
        }
#pragma unroll
        for (int i = 0; i < 16; ++i) DC[(32 * vt + crow(i, h)) * 64 + 32 * kt + r] = acc[i];
    }
    {
        float sum = 0.f;
#pragma unroll
        for (int s8 = 0; s8 < 4; ++s8) {
            const u32x4 kw = *(const LAS u32x4*)(KT + lane * TS128 + (4 * hw + s8) * 16);
            const f32x4 w0 = *(const LAS f32x4*)(wst + 8 * (4 * hw + s8)), w1 = *(const LAS f32x4*)(wst + 8 * (4 * hw + s8) + 4);
            sum += bflo(kw.x) * w0[0] + bfhi(kw.x) * w0[1] + bflo(kw.y) * w0[2] + bfhi(kw.y) * w0[3] + bflo(kw.z) * w1[0] + bfhi(kw.z) * w1[1] + bflo(kw.w) * w1[2] + bfhi(kw.w) * w1[3];
        }
        __syncthreads();
        bc[hw * 64 + lane] = sum;
        __syncthreads();
        if (hw == 0) DN[lane] = (bc[lane] + bc[64 + lane]) + (bc[128 + lane] + bc[192 + lane]);
        if (hw == 1 && lane == 0) DEC[item] = __expf(blast);
    }
    __syncthreads();
}
__device__ __forceinline__ void mlstm_scan(const Params& P, int G) {
    unsigned char* const ws_ = optr(P.ws); const int tid = otid();
    const float* DC = (const float*)(ws_ + WS_DC); const float* DN = (const float*)(ws_ + WS_DN); const float* DEC = (const float*)(ws_ + WS_DEC);
    bf16_t* CS = (bf16_t*)(ws_ + WS_CS); float* NS = (float*)(ws_ + WS_NS);
    for (int ch = blockIdx.x * NTHREADS + tid; ch < 32 * 4160; ch += G * NTHREADS) {
        const int seq = ch / 4160, e = ch % 4160;
        const bool isc = e < 4096; const int k = e - 4096;
        float st = 0.f;
        for (int c0 = 0; c0 < 64; c0 += 16) {
            float dv[16], de[16];
#pragma unroll
            for (int j = 0; j < 16; ++j) { const int it = seq * 64 + c0 + j; de[j] = DEC[it]; dv[j] = isc ? DC[(size_t)it * 4096 + e] : DN[it * 64 + k]; }
#pragma unroll
            for (int j = 0; j < 16; ++j) { const int it = seq * 64 + c0 + j; if (isc) CS[(size_t)it * 4096 + e] = f2bf(st); else NS[it * 64 + k] = st; st = de[j] * st + dv[j]; }
        }
    }
}
constexpr int MC_LDS = 2 * 128 * RS64 + 64 * TS128 + 64 * RS64 + 3 * 128 * 4;
__device__ __forceinline__ void mlstm_c_pair(const Params& P, int l, int pair, lds_t lds0) {
    const int tid = otid(), lane = tid & 63, w = tid >> 6, r = lane & 31, h = lane >> 5; unsigned char* const ws_ = optr(P.ws);
    const int half = w >> 2, hw = w & 3, ht = tid & 255, item = 2 * pair + half;
    lds_t lds = lds0 + half * MC_LDS;
    const int c = item & 63, hh = (item >> 6) & 3, b = item >> 8;
    const size_t t0 = (size_t)b * SEQ + (size_t)c * 128;
    const bf16_t* Z = (const bf16_t*)(ws_ + WS_ZB);
    const float* cw = P.in[2] + l * 4 * 512; const float* cb = P.in[3] + l * 512;
    lds_t Qs = lds, Ks = Qs + 128 * RS64, VT = Ks + 128 * RS64, Cs = VT + 64 * TS128, Hs = Qs;
    LAS float* bc = (LAS float*)(Cs + 64 * RS64); LAS float* ig = bc + 128; LAS float* ns = ig + 128;
    mlstm_gates(Z, t0, hh, P.in[4][l * 4 + hh], P.in[5][l * 4 + hh], bc, ig, ht);
#pragma unroll
    for (int q = 0; q < 4; ++q) {
        const int e = ht + q * 256, s = e >> 3, ch = e & 7;
        float y[8];
        conv8(Z + (t0 + s) * ZP + ZC_MQ + hh * 64 + 8 * ch, c * 128 + s, cw, cb, hh * 64 + 8 * ch, 1.f, y);
        *(LAS u32x4*)(Qs + s * RS64 + ch * 16) = (u32x4){pk2(y[0], y[1]), pk2(y[2], y[3]), pk2(y[4], y[5]), pk2(y[6], y[7])};
        conv8(Z + (t0 + s) * ZP + ZC_MK + hh * 64 + 8 * ch, c * 128 + s, cw, cb, 256 + hh * 64 + 8 * ch, 0.125f, y);
        *(LAS u32x4*)(Ks + s * RS64 + ch * 16) = (u32x4){pk2(y[0], y[1]), pk2(y[2], y[3]), pk2(y[4], y[5]), pk2(y[6], y[7])};
        const u32x4 vw = *(const u32x4*)(Z + (t0 + s) * ZP + ZC_MV + hh * 64 + 8 * ch);
        const unsigned vv[4] = {vw.x, vw.y, vw.z, vw.w};
#pragma unroll
        for (int i = 0; i < 4; ++i) { *(LAS bf16_t*)(VT + (8 * ch + 2 * i) * TS128 + s * 2) = (bf16_t)(vv[i] & 0xffffu); *(LAS bf16_t*)(VT + (8 * ch + 2 * i + 1) * TS128 + s * 2) = (bf16_t)(vv[i] >> 16); }
    }
#pragma unroll
    for (int q = 0; q < 2; ++q) { const int e = ht + q * 256, v = e >> 3, ch = e & 7; *(LAS u32x4*)(Cs + v * RS64 + ch * 16) = *(const u32x4*)((const bf16_t*)(ws_ + WS_CS) + (size_t)item * 4096 + v * 64 + ch * 8); }
    if (ht < 64) ns[ht] = ((const float*)(ws_ + WS_NS))[item * 64 + ht];
    __syncthreads();
    {
        const int tt = hw, tl = 32 * tt + r;
        bf16x8 qf[4];
#pragma unroll
        for (int ks = 0; ks < 4; ++ks) qf[ks] = lds16(Qs + tl * RS64 + (16 * ks + 8 * h) * 2);
        f32x16 num[2] = {};
#pragma unroll
        for (int vt = 0; vt < 2; ++vt)
#pragma unroll
            for (int ks = 0; ks < 4; ++ks) num[vt] = MFMA32(lds16(Cs + (32 * vt + r) * RS64 + (16 * ks + 8 * h) * 2), qf[ks], num[vt]);
        float nq = 0.f;
#pragma unroll
        for (int ks = 0; ks < 4; ++ks) {
            const u32x4 qw = __builtin_bit_cast(u32x4, qf[ks]);
            const f32x4 n0 = *(const LAS f32x4*)(ns + 16 * ks + 8 * h), n1 = *(const LAS f32x4*)(ns + 16 * ks + 8 * h + 4);
            nq += bflo(qw.x) * n0[0] + bfhi(qw.x) * n0[1] + bflo(qw.y) * n0[2] + bfhi(qw.y) * n0[3] + bflo(qw.z) * n1[0] + bfhi(qw.z) * n1[1] + bflo(qw.w) * n1[2] + bfhi(qw.w) * n1[3];
        }
        nq = swap_add(nq);
        const float bt = bc[tl], eb = __expf(bt);
#pragma unroll
        for (int vt = 0; vt < 2; ++vt)
#pragma unroll
            for (int i = 0; i < 16; ++i) num[vt][i] *= eb;
        float den = 0.f;
        for (int st = 0; st <= tt; ++st) {
            f32x16 S = {};
#pragma unroll
            for (int ks = 0; ks < 4; ++ks) S = MFMA32(lds16(Ks + (32 * st + r) * RS64 + (16 * ks + 8 * h) * 2), qf[ks], S);
#pragma unroll
            for (int i = 0; i < 16; ++i) { const int s2 = 32 * st + crow(i, h); const float wgt = (s2 <= tl) ? __expf(bt - bc[s2] + ig[s2]) : 0.f; S[i] *= wgt; den += S[i]; }
#pragma unroll
            for (int s2 = 0; s2 < 2; ++s2) { const bf16x8 pf = pack8(S, s2);
#pragma unroll
                for (int vt = 0; vt < 2; ++vt) { lds_t vp = VT + (32 * vt + r) * TS128 + (32 * st + 16 * s2 + 4 * h) * 2; num[vt] = MFMA32(lds8x2(vp, vp + 16), pf, num[vt]); } }
        }
        den = swap_add(den) + eb * nq;
        const float dinv = 1.f / fmaxf(fabsf(den), 1.f);
        float ss = 0.f;
#pragma unroll
        for (int vt = 0; vt < 2; ++vt)
#pragma unroll
            for (int i = 0; i < 16; ++i) { num[vt][i] *= dinv; ss += num[vt][i] * num[vt][i]; }
        ss = swap_add(ss);
        const float rn = 1.f / sqrtf(ss * (1.f / 64.f) + EPS);
#pragma unroll
        for (int vt = 0; vt < 2; ++vt)
#pragma unroll
            for (int i = 0; i < 16; ++i) *(LAS bf16_t*)(Hs + tl * RS64 + (32 * vt + crow(i, h)) * 2) = f2bf(num[vt][i] * rn);
    }
    __syncthreads();
    bf16_t* CAT = (bf16_t*)(ws_ + WS_CAT);
    const float* mg = P.in[6] + l * 256 + hh * 64;
#pragma unroll
    for (int q = 0; q < 4; ++q) {
        const int e = ht + q * 256, t = e >> 3, ch = e & 7;
        const u32x4 hw4 = *(const LAS u32x4*)(Hs + t * RS64 + ch * 16);
        const u32x4 ow = *(const u32x4*)(Z + (t0 + t) * ZP + ZC_MO + hh * 64 + 8 * ch);
        const f32x4 g0 = *(const f32x4*)(mg + 8 * ch), g1 = *(const f32x4*)(mg + 8 * ch + 4);
        u32x4 o;
        o.x = pk2(bflo(hw4.x) * g0[0] * sigmoidf_(bflo(ow.x)), bfhi(hw4.x) * g0[1] * sigmoidf_(bfhi(ow.x)));
        o.y = pk2(bflo(hw4.y) * g0[2] * sigmoidf_(bflo(ow.y)), bfhi(hw4.y) * g0[3] * sigmoidf_(bfhi(ow.y)));
        o.z = pk2(bflo(hw4.z) * g1[0] * sigmoidf_(bflo(ow.z)), bfhi(hw4.z) * g1[1] * sigmoidf_(bfhi(ow.z)));
        o.w = pk2(bflo(hw4.w) * g1[2] * sigmoidf_(bflo(ow.w)), bfhi(hw4.w) * g1[3] * sigmoidf_(bfhi(ow.w)));
        *(u32x4*)(CAT + (t0 + t) * DM + hh * 64 + 8 * ch) = o;
    }
    __syncthreads();
}

constexpr int TS256 = 520;
__device__ __forceinline__ void swa_item(const Params& P, int l, int item, lds_t lds) {
    const int tid = otid(), lane = tid & 63, w = tid >> 6, r = lane & 31, h = lane >> 5; unsigned char* const ws_ = optr(P.ws);
    const int kvh = item & 1, nb = (item >> 1) & 63, b = item >> 7;
    const size_t t0 = (size_t)b * SEQ + (size_t)nb * 128;
    const bf16_t* Z = (const bf16_t*)(ws_ + WS_ZB);
    lds_t Ks = lds, VT = lds + 256 * RS64, Os = VT + 64 * TS256;
#pragma unroll
    for (int q = 0; q < 4; ++q) {
        const int e = tid + q * 512, kb = e >> 3, ch = e & 7;
        u32x4 kw = {0u, 0u, 0u, 0u}, vw = {0u, 0u, 0u, 0u};
        if (nb > 0 || kb >= 128) { const bf16_t* zr = Z + (t0 - 128 + kb) * ZP; kw = *(const u32x4*)(zr + ZC_SK + kvh * 64 + 8 * ch); vw = *(const u32x4*)(zr + ZC_SV + kvh * 64 + 8 * ch); }
        *(LAS u32x4*)(Ks + kb * RS64 + ch * 16) = kw;
        const unsigned vv[4] = {vw.x, vw.y, vw.z, vw.w};
#pragma unroll
        for (int i = 0; i < 4; ++i) { *(LAS bf16_t*)(VT + (8 * ch + 2 * i) * TS256 + kb * 2) = (bf16_t)(vv[i] & 0xffffu); *(LAS bf16_t*)(VT + (8 * ch + 2 * i + 1) * TS256 + kb * 2) = (bf16_t)(vv[i] >> 16); }
    }
    __syncthreads();
    bf16_t* CAT = (bf16_t*)(ws_ + WS_CAT);
    lds_t Ow = Os + w * 32 * RS64;
    for (int cc = w; cc < 16; cc += 8) {
        const int hq = cc >> 2, qt = cc & 3, hg = kvh * 4 + hq, ql = 32 * qt + r;
        const float sink = P.in[7][l * 8 + hg];
        const bf16_t* qp = Z + (t0 + ql) * ZP + ZC_SQ + hg * 64;
        bf16x8 qf[4];
#pragma unroll
        for (int ks = 0; ks < 4; ++ks) qf[ks] = *(const bf16x8*)(qp + 16 * ks + 8 * h);
        f32x16 S[5];
        float mx = sink;
#pragma unroll
        for (int k5 = 0; k5 < 5; ++k5) {
            const int kt = qt + k5;
            S[k5] = (f32x16){};
#pragma unroll
            for (int ks = 0; ks < 4; ++ks) S[k5] = MFMA32(lds16(Ks + (32 * kt + r) * RS64 + (16 * ks + 8 * h) * 2), qf[ks], S[k5]);
#pragma unroll
            for (int i = 0; i < 16; ++i) { const int kb = 32 * kt + crow(i, h); const bool ok = (kb > ql) && (kb <= ql + 128) && (nb > 0 || kb >= 128);
                S[k5][i] = ok ? S[k5][i] * 0.125f : -1e30f; mx = fmaxf(mx, S[k5][i]); }
        }
        mx = swap_max(mx);
        float sum = 0.f;
#pragma unroll
        for (int k5 = 0; k5 < 5; ++k5)
#pragma unroll
            for (int i = 0; i < 16; ++i) { S[k5][i] = __expf(S[k5][i] - mx); sum += S[k5][i]; }
        sum = swap_add(sum) + __expf(sink - mx);
        const float inv = 1.f / sum;
        f32x16 O[2] = {};
#pragma unroll
        for (int k5 = 0; k5 < 5; ++k5) {
            const int kt = qt + k5;
#pragma unroll
            for (int i = 0; i < 16; ++i) S[k5][i] *= inv;
#pragma unroll
            for (int s2 = 0; s2 < 2; ++s2) { const bf16x8 pf = pack8(S[k5], s2);
#pragma unroll
                for (int dt = 0; dt < 2; ++dt) { lds_t vp = VT + (32 * dt + r) * TS256 + (32 * kt + 16 * s2 + 4 * h) * 2; O[dt] = MFMA32(lds8x2(vp, vp + 16), pf, O[dt]); } }
        }
#pragma unroll
        for (int dt = 0; dt < 2; ++dt)
#pragma unroll
            for (int i = 0; i < 16; ++i) *(LAS bf16_t*)(Ow + r * RS64 + (32 * dt + crow(i, h)) * 2) = f2bf(O[dt][i]);
        asm volatile("s_waitcnt lgkmcnt(0)" ::: "memory");
#pragma unroll
        for (int it = 0; it < 4; ++it) { const int row = it * 8 + (lane >> 3), ch = lane & 7; const u32x4 v = *(const LAS u32x4*)(Ow + row * RS64 + ch * 16);
            *(u32x4*)(CAT + (t0 + 32 * qt + row) * DM + 256 + hg * 64 + 8 * ch) = v; }
        asm volatile("s_waitcnt lgkmcnt(0)" ::: "memory");
    }
    __syncthreads();
}

typedef short v4i16_t __attribute__((ext_vector_type(4)));
__device__ __forceinline__ s16x4 vtr(lds_t p) { return __builtin_bit_cast(s16x4, __builtin_amdgcn_ds_read_tr16_b64_v4i16((LAS v4i16_t*)p)); }
constexpr int DKS = 144, DVS = 192;
constexpr int DK_BYTES = 64 * DKS, DV_BYTES = 64 * DVS, DBUF = DK_BYTES + DV_BYTES;
__device__ __forceinline__ void dsoftmax(f32x16& S0, f32x16& S1, unsigned& qxw, f32x16& Oa, f32x16& Ob, float& mx, float& ls, bf16x8 (&pf)[2][2], bool first, bool needmask, int kbase, int qrow, int h) {
    if (needmask) {
#pragma unroll
        for (int i = 0; i < 16; ++i) { const int key = kbase + crow(i, h); if (key > qrow) S0[i] = -1e30f; if (key + 32 > qrow) S1[i] = -1e30f; }
    }
    float ta = fmaxf(fmaxf(S0[0], S0[1]), S1[0]), tb = fmaxf(fmaxf(S0[2], S0[3]), S1[1]); ta = fmaxf(fmaxf(ta, S1[2]), S1[3]);
#pragma unroll
    for (int i = 4; i < 16; i += 4) { ta = fmaxf(fmaxf(ta, S0[i]), S0[i + 1]); tb = fmaxf(fmaxf(tb, S0[i + 2]), S0[i + 3]); ta = fmaxf(fmaxf(ta, S1[i]), S1[i + 1]); tb = fmaxf(fmaxf(tb, S1[i + 2]), S1[i + 3]); }
    const float tm = swap_max(fmaxf(ta, tb));
    if (first || __any(tm > 8.f)) {
        const float mnew = bf2f(f2bf(mx + (first ? tm : fmaxf(tm, 0.f))));
        const float dl = mnew - mx;
        mx = mnew;
        qxw = h ? 0u : (unsigned)f2bf(-mnew);
        const float alpha = first ? 1.f : __builtin_amdgcn_exp2f(-dl);
        ls *= alpha;
#pragma unroll
        for (int i = 0; i < 16; ++i) { S0[i] -= dl; S1[i] -= dl; Oa[i] *= alpha; Ob[i] *= alpha; }
    }
    float sa = 0.f, sb = 0.f;
#pragma unroll
    for (int i = 0; i < 16; ++i) { S0[i] = __builtin_amdgcn_exp2f(S0[i]); S1[i] = __builtin_amdgcn_exp2f(S1[i]); sa += S0[i]; asm("" : "+v"(sa)); sb += S1[i]; asm("" : "+v"(sb)); }
    ls += sa + sb;
    pf[0][0] = pack8(S0, 0); pf[0][1] = pack8(S0, 1); pf[1][0] = pack8(S1, 0); pf[1][1] = pack8(S1, 1);
}
__device__ __forceinline__ void dqk(f32x16& S0, f32x16& S1, unsigned qxw, lds_t kb, const bf16x8 (&q)[2], int h) {
    const bf16x8 kones = __builtin_bit_cast(bf16x8, (u32x4){h ? 0u : 0x3f80u, 0u, 0u, 0u}), qx = __builtin_bit_cast(bf16x8, (u32x4){qxw, 0u, 0u, 0u});
    S0 = (f32x16){}; S1 = (f32x16){};
#pragma unroll
    for (int ks = 0; ks < 2; ++ks) { S0 = MFMA32(lds16(kb + 32 * ks), q[ks], S0); S1 = MFMA32(lds16(kb + 32 * DKS + 32 * ks), q[ks], S1); }
    S0 = MFMA32(kones, qx, S0); S1 = MFMA32(kones, qx, S1);
}
#define SBAR() __builtin_amdgcn_sched_barrier(0)
__device__ __forceinline__ void diff_item(const Params& P, int l, int seq, int qb, lds_t lds, float lam, float oscale) {
    const int tid = otid(), lane = tid & 63, w = tid >> 6, r = lane & 31, h = lane >> 5; unsigned char* const ws_ = optr(P.ws);
    const int b = seq >> 2, hd = seq & 3;
    const size_t row0 = (size_t)b * SEQ;
    const bf16_t* Z = (const bf16_t*)(ws_ + WS_ZB);
    const int qrow = qb * 256 + w * 32 + r, wmin = qb * 256 + w * 32;
    const bf16_t* qp = Z + (row0 + qrow) * ZP + ZC_DQ + hd * 64;
    bf16x8 qf[2][2];
#pragma unroll
    for (int m = 0; m < 2; ++m)
#pragma unroll
        for (int ks = 0; ks < 2; ++ks) qf[m][ks] = *(const bf16x8*)(qp + 32 * m + 16 * ks + 8 * h);
    f32x16 O[2][2] = {};
    unsigned qxw[2] = {0u, 0u};
    float mx[2] = {0.f, 0.f}, ls[2] = {0.f, 0.f};
    const int NT = 4 * qb + 4, Tw = 4 * qb + (w >> 1) + 1;
    const int skey = tid >> 3, sch = tid & 7;
    const bf16_t* kg = Z + (row0 + skey) * ZP + ZC_DK + hd * 64 + 8 * sch; const bf16_t* vg = Z + (row0 + skey) * ZP + ZC_DV + hd * 64 + 8 * sch;
    lds_t Os = lds + 3 * DBUF;
    const int soffk = skey * DKS + sch * 16, soffv = DK_BYTES + skey * DVS + sch * 16;
    const int koff = r * DKS + 16 * h, voff = DK_BYTES + (((lane & 15) >> 2) + 4 * h) * DVS + (16 * ((lane >> 4) & 1) + 4 * (lane & 3)) * 2;
    u32x4 kreg = *(const u32x4*)kg, vreg = *(const u32x4*)vg;
    *(LAS u32x4*)(lds + soffk) = kreg; *(LAS u32x4*)(lds + soffv) = vreg;
    kreg = *(const u32x4*)(kg + (size_t)64 * ZP); vreg = *(const u32x4*)(vg + (size_t)64 * ZP);
    __syncthreads();
    f32x16 S0a, S0b, S1a, S1b;
    bf16x8 pf0[2][2], pf1[2][2];
    dqk(S0a, S0b, qxw[0], lds + koff, qf[0], h);
    int bc = 0, bn = DBUF;
    for (int t = 0; t < NT; ++t) {
        const bool act = t < Tw, needmask = (64 * t + 63 > wmin);
        lds_t Tb = lds + bc, Tn = lds + bn;
        SBAR();
        if (act) {
            dqk(S1a, S1b, qxw[1], Tb + koff + 64, qf[1], h);
            dsoftmax(S0a, S0b, qxw[0], O[0][0], O[0][1], mx[0], ls[0], pf0, t == 0, needmask, 64 * t, qrow, h);
        }
        SBAR();
        if (t + 1 < NT) { *(LAS u32x4*)(Tn + soffk) = kreg; *(LAS u32x4*)(Tn + soffv) = vreg; }
        __syncthreads();
        if (t + 2 < NT) { kreg = *(const u32x4*)(kg + (size_t)(t + 2) * 64 * ZP); vreg = *(const u32x4*)(vg + (size_t)(t + 2) * 64 * ZP); }
        SBAR();
        if (act) {
            if (t + 1 < Tw) dqk(S0a, S0b, qxw[0], Tn + koff, qf[0], h);
            dsoftmax(S1a, S1b, qxw[1], O[1][0], O[1][1], mx[1], ls[1], pf1, t == 0, needmask, 64 * t, qrow, h);
            SBAR();
#pragma unroll
            for (int kh = 0; kh < 2; ++kh)
#pragma unroll
                for (int s2 = 0; s2 < 2; ++s2) {
                    bf16x8 vf[2];
#pragma unroll
                    for (int dt = 0; dt < 2; ++dt) { lds_t vp = Tb + voff + (32 * kh + 16 * s2) * DVS + 64 * dt; const s16x4 lo = vtr(vp), hi = vtr(vp + 8 * DVS); vf[dt] = __builtin_shufflevector(lo, hi, 0, 1, 2, 3, 4, 5, 6, 7); }
                    O[0][0] = MFMA32(vf[0], pf0[kh][s2], O[0][0]); O[0][1] = MFMA32(vf[1], pf0[kh][s2], O[0][1]);
                    O[1][0] = MFMA32(vf[0], pf1[kh][s2], O[1][0]); O[1][1] = MFMA32(vf[1], pf1[kh][s2], O[1][1]);
                }
        }
        bc = bn; bn = (bn == 2 * DBUF) ? 0 : bn + DBUF;
    }
    const float i1 = 1.f / swap_add(ls[0]), i2 = lam / swap_add(ls[1]);
    float ss = 0.f;
#pragma unroll
    for (int dt = 0; dt < 2; ++dt)
#pragma unroll
        for (int i = 0; i < 16; ++i) { const float o = O[0][dt][i] * i1 - O[1][dt][i] * i2; O[0][dt][i] = o; ss += o * o; }
    ss = swap_add(ss);
    const float rn = oscale / sqrtf(ss * (1.f / 64.f) + EPS);
    lds_t Ow = Os + w * 32 * RS64;
#pragma unroll
    for (int dt = 0; dt < 2; ++dt)
#pragma unroll
        for (int i = 0; i < 16; ++i) *(LAS bf16_t*)(Ow + r * RS64 + (32 * dt + crow(i, h)) * 2) = f2bf(O[0][dt][i] * rn);
    asm volatile("s_waitcnt lgkmcnt(0)" ::: "memory");
    bf16_t* CAT = (bf16_t*)(ws_ + WS_CAT);
    const float* sg = P.in[12] + l * 64;
#pragma unroll
    for (int it = 0; it < 4; ++it) { const int row = it * 8 + (lane >> 3), ch = lane & 7; const u32x4 v = *(const LAS u32x4*)(Ow + row * RS64 + ch * 16);
        const f32x4 g0 = *(const f32x4*)(sg + 8 * ch), g1 = *(const f32x4*)(sg + 8 * ch + 4);
        u32x4 o; o.x = pk2(bflo(v.x) * g0[0], bfhi(v.x) * g0[1]); o.y = pk2(bflo(v.y) * g0[2], bfhi(v.y) * g0[3]); o.z = pk2(bflo(v.z) * g1[0], bfhi(v.z) * g1[1]); o.w = pk2(bflo(v.w) * g1[2], bfhi(v.w) * g1[3]);
        *(u32x4*)(CAT + (row0 + wmin + row) * DM + 768 + hd * 64 + 8 * ch) = o; }
    __syncthreads();
}
#undef SBAR

constexpr int N_PHASES = 19;
__global__ void __launch_bounds__(NTHREADS, 2) hybrid_fwd(Params P) {
    extern __shared__ __attribute__((aligned(16))) unsigned char lds_raw[];
    lds_t lds = (lds_t)lds_raw;
    cg::grid_group grid = cg::this_grid();
    const int G = gridDim.x, lo = P.ph_lo, hi = P.ph_hi;
    int ph = 0;
#define PHASE_BEGIN(k) if (((PH_MASK >> (k)) & 1) && lo <= ph && ph < hi) { for (int rep_ = 0; rep_ <= ((REP_MASK >> (k)) & 1); ++rep_) { if (rep_) grid.sync();
#define PHASE_END   } if (ph + 1 < hi) grid.sync(); } ++ph;
    PHASE_BEGIN(0) prologue(P, lds, G); PHASE_END
    for (int l = 0; l < 2; ++l) {
        unsigned char* wb = P.ws + WS_W + (size_t)l * W_LAYER;
        bf16_t* XB = (bf16_t*)(P.ws + WS_XB); float* RS = (float*)(P.ws + WS_RS);
        PHASE_BEGIN(1) {
            pg8::Gemm g{XB, (const bf16_t*)(wb + W_IN), NTOK, ZP, DM}; pg8::StaticOrder S; S.init(NTOK, ZP, G, (int)blockIdx.x);
            pg8::EpiInProj E{(bf16_t*)(P.ws + WS_ZB), RS, (const f32x2*)(P.ws + WS_ROPE)};
            pg8::gemm_phase<pg8::EpiInProj, pg8::StaticOrder, true, true>(lds, g, S, E);
        } PHASE_END
        PHASE_BEGIN(2) {
            for (int it = blockIdx.x; it < 1024; it += G) mlstm_a_pair(P, l, it, lds);
            for (int it = blockIdx.x; it < 1024; it += G) swa_item(P, l, it, lds);
        } PHASE_END
        PHASE_BEGIN(3) {
            mlstm_scan(P, G);
            float d1 = 0.f, d2 = 0.f;
            for (int i = 0; i < 32; ++i) { d1 += P.in[8][l * 32 + i] * P.in[9][l * 32 + i]; d2 += P.in[10][l * 32 + i] * P.in[11][l * 32 + i]; }
            const float lam_init = 0.8f - 0.6f * expf(-0.3f * (float)l);
            const float lam = expf(d1) - expf(d2) + lam_init;
            for (int vg = blockIdx.x; vg < 256; vg += G) {
                const int seq = vg >> 3, j = vg & 7;
                diff_item(P, l, seq, 31 - j, lds, lam, 1.f - lam_init);
                diff_item(P, l, seq, 16 + j, lds, lam, 1.f - lam_init);
                diff_item(P, l, seq, 15 - j, lds, lam, 1.f - lam_init);
                diff_item(P, l, seq, j, lds, lam, 1.f - lam_init);
            }
        } PHASE_END
        PHASE_BEGIN(4) {
            for (int it = blockIdx.x; it < 1024; it += G) mlstm_c_pair(P, l, it, lds);
        } PHASE_END
        PHASE_BEGIN(5) {
            pg8::Gemm g{(const bf16_t*)(P.ws + WS_CAT), (const bf16_t*)(wb + W_OUT), NTOK, DM, DM}; pg8::StaticOrder S; S.init(NTOK, DM, G, (int)blockIdx.x);
            pg8::EpiRow<0> E{(bf16_t*)(P.ws + WS_MIX), DM, nullptr};
            pg8::gemm_phase<pg8::EpiRow<0>, pg8::StaticOrder, true, true>(lds, g, S, E);
        } PHASE_END
        PHASE_BEGIN(6) resid_pass(P, P.in[17] + l * DM, false, G); PHASE_END
        PHASE_BEGIN(7) {
            pg8::Gemm g{XB, (const bf16_t*)(wb + W_UP), NTOK, FF, DM}; pg8::StaticOrder S; S.init(NTOK, FF, G, (int)blockIdx.x);
            pg8::EpiRow<1> E{(bf16_t*)(P.ws + WS_U), FF, RS};
            pg8::gemm_phase<pg8::EpiRow<1>, pg8::StaticOrder, true, true>(lds, g, S, E);
        } PHASE_END
        PHASE_BEGIN(8) {
            pg8::Gemm g{(const bf16_t*)(P.ws + WS_U), (const bf16_t*)(wb + W_DOWN), NTOK, DM, FF}; pg8::StaticOrder S; S.init(NTOK, DM, G, (int)blockIdx.x);
            pg8::EpiRow<0> E{(bf16_t*)(P.ws + WS_MIX), DM, nullptr};
            pg8::gemm_phase<pg8::EpiRow<0>, pg8::StaticOrder, true, true>(lds, g, S, E);
        } PHASE_END
        PHASE_BEGIN(9) resid_pass(P, P.in[19] + l * DM, l == 1, G); PHASE_END
    }
#undef PHASE_BEGIN
#undef PHASE_END
}

extern "C" void kernel_launch(void* const* d_in, const int* in_sizes, int n_in, void* d_out, int out_size, void* d_ws, size_t ws_size, hipStream_t stream) {
    static int grid = 0;
    if (grid == 0) {
        if (n_in != 20 || out_size != NTOK * DM || ws_size < WS_END) { fprintf(stderr, "kernel_launch: unexpected shapes (n_in %d out %d ws %zu)\n", n_in, out_size, ws_size); grid = -1; return; }
        int dev = 0, cus = 0, per_cu = 0;
        hipGetDevice(&dev); hipDeviceGetAttribute(&cus, hipDeviceAttributeMultiprocessorCount, dev);
        if (hipFuncSetAttribute((const void*)hybrid_fwd, hipFuncAttributeMaxDynamicSharedMemorySize, LDS_BYTES) != hipSuccess) { fprintf(stderr, "kernel_launch: hipFuncSetAttribute failed\n"); grid = -1; return; }
        if (hipOccupancyMaxActiveBlocksPerMultiprocessor(&per_cu, (const void*)hybrid_fwd, NTHREADS, LDS_BYTES) != hipSuccess || per_cu < 1) { fprintf(stderr, "kernel_launch: occupancy query says %d\n", per_cu); per_cu = 1; }
        (void)hipGetLastError();
        grid = cus;
    }
    if (grid < 0) return;
    Params p{};
    for (int i = 0; i < 20; ++i) p.in[i] = (const float*)d_in[i];
    p.out = (float*)d_out; p.ws = (unsigned char*)d_ws;
#if ONE_LAUNCH
    p.ph_lo = 0; p.ph_hi = N_PHASES;
    void* args[] = {&p};
    hipError_t e = hipLaunchCooperativeKernel((const void*)hybrid_fwd, dim3(grid), dim3(NTHREADS), args, LDS_BYTES, stream);
    if (e != hipSuccess) fprintf(stderr, "cooperative launch failed: %s (grid %d)\n", hipGetErrorString(e), grid);
#else
    for (int ph = 0; ph < N_PHASES; ++ph) {
        p.ph_lo = ph; p.ph_hi = ph + 1;
        hipLaunchKernelGGL(hybrid_fwd, dim3(grid), dim3(NTHREADS), LDS_BYTES, stream, p);
    }
#endif
}
```

```cpp
#include <hip/hip_runtime.h>
#include <hip/hip_cooperative_groups.h>
#include <cstdio>
#include <cstdint>
namespace cg = cooperative_groups;

#ifndef PH_MASK
#define PH_MASK 0x3ff
#endif
#ifndef REP_MASK
#define REP_MASK 0
#endif
#ifndef ONE_LAUNCH
#define ONE_LAUNCH 1
#endif

#define LAS __attribute__((address_space(3)))
typedef unsigned short bf16_t;
typedef short bf16x8 __attribute__((ext_vector_type(8)));
typedef short s16x4 __attribute__((ext_vector_type(4)));
typedef float f32x4 __attribute__((ext_vector_type(4)));
typedef float f32x2 __attribute__((ext_vector_type(2)));
typedef float f32x16 __attribute__((ext_vector_type(16)));
typedef unsigned u32x4 __attribute__((ext_vector_type(4)));
typedef unsigned u32x2 __attribute__((ext_vector_type(2)));
typedef __bf16 bf16x2_t __attribute__((ext_vector_type(2)));
typedef LAS unsigned char* lds_t;

constexpr int BATCH = 8, SEQ = 8192, DM = 1024, FF = 4096, NTOK = BATCH * SEQ;
constexpr int INW = 2568, ZP = 2816;
constexpr int ZC_MQ = 0, ZC_MK = 256, ZC_MV = 512, ZC_MO = 768, ZC_SQ = 1024, ZC_SK = 1536, ZC_SV = 1664, ZC_DQ = 1792, ZC_DK = 2048, ZC_DV = 2304, ZC_G = 2560;
constexpr float EPS = 1e-6f;
constexpr float DQ_SCALE = 0.17677669529663687f * 1.4426950408889634f;
constexpr int NWAVES = 8, NTHREADS = 512;

constexpr size_t MiB = 1u << 20;
constexpr size_t WS_W = 2 * MiB;
constexpr size_t W_LAYER = 24 * MiB, W_IN = 0, W_OUT = 6 * MiB, W_UP = 8 * MiB, W_DOWN = 16 * MiB;
constexpr size_t WS_ROPE = 50 * MiB;
constexpr size_t WS_RS = 52 * MiB;
constexpr size_t WS_XB = 54 * MiB;
constexpr size_t WS_MIX = 182 * MiB;
constexpr size_t WS_U = 310 * MiB;
constexpr size_t WS_ZB = 310 * MiB;
constexpr size_t WS_CAT = 662 * MiB;
constexpr size_t WS_DC = 822 * MiB;
constexpr size_t WS_DN = 854 * MiB;
constexpr size_t WS_DEC = 855 * MiB;
constexpr size_t WS_CS = 856 * MiB;
constexpr size_t WS_NS = 872 * MiB;
constexpr size_t WS_END = 874 * MiB;

constexpr int LDS_BYTES = 147456;

struct Params {
    const float* in[20];
    float* out;
    unsigned char* ws;
    int ph_lo, ph_hi;
};

__device__ __forceinline__ unsigned pk2(float lo, float hi) { f32x2 v = {lo, hi}; bf16x2_t b = __builtin_convertvector(v, bf16x2_t); return __builtin_bit_cast(unsigned, b); }
__device__ __forceinline__ bf16_t f2bf(float f) { return (bf16_t)(pk2(f, 0.f) & 0xffffu); }
__device__ __forceinline__ float bf2f(unsigned u16) { return __uint_as_float(u16 << 16); }
__device__ __forceinline__ float bflo(unsigned w) { return __uint_as_float(w << 16); }
__device__ __forceinline__ float bfhi(unsigned w) { return __uint_as_float(w & 0xffff0000u); }
__device__ __forceinline__ int crow(int i, int h) { return (i & 3) + 8 * (i >> 2) + 4 * h; }
__device__ __forceinline__ float wave_sum(float v) {
#pragma unroll
    for (int o = 1; o < 64; o <<= 1) v += __shfl_xor(v, o);
    return v;
}
__device__ __forceinline__ float swap_add(float v) { auto rr = __builtin_amdgcn_permlane32_swap(__float_as_uint(v), __float_as_uint(v), false, false); return __uint_as_float(rr[0]) + __uint_as_float(rr[1]); }
__device__ __forceinline__ float swap_max(float v) { auto rr = __builtin_amdgcn_permlane32_swap(__float_as_uint(v), __float_as_uint(v), false, false); return fmaxf(__uint_as_float(rr[0]), __uint_as_float(rr[1])); }
#define MFMA32(a, b, c) __builtin_amdgcn_mfma_f32_32x32x16_bf16((a), (b), (c), 0, 0, 0)
__device__ __forceinline__ bf16x8 pack8(const f32x16& x, int s) {
    u32x4 p; p.x = pk2(x[8 * s], x[8 * s + 1]); p.y = pk2(x[8 * s + 2], x[8 * s + 3]); p.z = pk2(x[8 * s + 4], x[8 * s + 5]); p.w = pk2(x[8 * s + 6], x[8 * s + 7]);
    return __builtin_bit_cast(bf16x8, p);
}
__device__ __forceinline__ bf16x8 lds16(lds_t p) { return *(const LAS bf16x8*)p; }
__device__ __forceinline__ bf16x8 lds8x2(lds_t p0, lds_t p1) { s16x4 a = *(const LAS s16x4*)p0, b = *(const LAS s16x4*)p1; return __builtin_shufflevector(a, b, 0, 1, 2, 3, 4, 5, 6, 7); }
__device__ __forceinline__ float sigmoidf_(float x) { return 1.f / (1.f + __expf(-x)); }
__device__ __forceinline__ float logsigmoidf_(float x) { return fminf(x, 0.f) - log1pf(__expf(-fabsf(x))); }

__device__ __forceinline__ int otid() { int t = threadIdx.x; asm volatile("" : "+v"(t)); return t; }
__device__ __forceinline__ size_t ozero() { unsigned z = 0; asm volatile("" : "+s"(z)); return (size_t)z; }
template <class T> __device__ __forceinline__ T* optr(T* p) { return p + ozero(); }
namespace pg8 {
constexpr int BM = 256, BK = 64, HALF = 128, HTB = HALF * BK * 2, STAGE_BYTES = 8 * HTB, NXCD = 8, WGM = 8;
__host__ __device__ __forceinline__ int lds_byte(int r, int c) { const int st = (r >> 4) * 2 + (c >> 5), rr = r & 15, cc = c & 31, ob = rr * 64 + cc * 2; return st * 1024 + (ob ^ (((ob >> 9) & 1) << 5)); }
__host__ __device__ __forceinline__ void stage_rc(int b, int& R, int& C) { const int st = b / 1024, sb = b % 1024, swz = sb ^ (((sb >> 9) & 1) << 5); R = (st >> 1) * 16 + swz / 64; C = (st & 1) * 32 + (swz % 64) / 2; }
__host__ __device__ __forceinline__ int perm32(int rho) { const int n = rho >> 4, i = rho & 15; return 8 * (i >> 2) + 4 * n + (i & 3); }
struct Unit { int pm, pn; };
struct Gemm { const bf16_t* A; const bf16_t* Bt; int M, N, K; };
struct StaticOrder {
    int nM, nN, nwg, G, c;
    __host__ __device__ void init(int M, int N, int G_, int c_) { nM = M / BM; nN = N / BM; nwg = nM * nN; G = G_; c = c_; }
    __host__ __device__ bool next(int i, Unit& u) const {
        const long L = (long)i * G + c; if (L >= nwg) return false;
        int wgid = (int)L; { const int q = nwg / NXCD, r = nwg % NXCD, xcd = wgid % NXCD, off = wgid / NXCD; wgid = (xcd < r ? xcd * (q + 1) : r * (q + 1) + (xcd - r) * q) + off; }
        const int nig = WGM * nN, gid = wgid / nig, fm = gid * WGM, gsz = (nM - fm) < WGM ? (nM - fm) : WGM;
        u.pm = fm + ((wgid % nig) % gsz); u.pn = (wgid % nig) / gsz; return true;
    }
    __device__ __forceinline__ void a_ready(const Unit&) const {}
    __device__ __forceinline__ void done(const Unit&) const {}
};

template <int ACT> struct EpiRow {
    static constexpr bool PERM = true, AFTER_DRAIN = false;
    bf16_t* O; int ldc; const float* rs;
    __device__ __forceinline__ void operator()(const f32x4 (&acc)[2][2][4][2], const Unit& u, int wr, int wc, int fr, int fq) const {
        const int row0 = u.pm * BM + wr * 64 + fr, col0 = u.pn * BM + wc * 32 + 8 * fq;
#pragma unroll
        for (int ai = 0; ai < 2; ++ai)
#pragma unroll
            for (int m = 0; m < 4; ++m) { const int row = row0 + ai * HALF + m * 16; const float s = rs ? rs[row] : 1.f; bf16_t* rowp = O + (size_t)row * ldc + col0;
#pragma unroll
                for (int bj = 0; bj < 2; ++bj) { f32x4 v0 = acc[ai][bj][m][0] * s, v1 = acc[ai][bj][m][1] * s;
                    if (ACT == 1) {
#pragma unroll
                        for (int i = 0; i < 4; ++i) { const float a = fmaxf(v0[i], 0.f), b = fmaxf(v1[i], 0.f); v0[i] = a * a; v1[i] = b * b; } }
                    u32x4 w; w.x = pk2(v0[0], v0[1]); w.y = pk2(v0[2], v0[3]); w.z = pk2(v1[0], v1[1]); w.w = pk2(v1[2], v1[3]);
                    *(u32x4*)(rowp + bj * HALF) = w; } }
    }
};
struct EpiInProj {
    static constexpr bool PERM = true, AFTER_DRAIN = false;
    bf16_t* O; const float* rs; const f32x2* rope;
    __device__ __forceinline__ void operator()(const f32x4 (&acc)[2][2][4][2], const Unit& u, int wr, int wc, int fr, int fq) const {
        const int row0 = u.pm * BM + wr * 64 + fr, col0 = u.pn * BM + wc * 32 + 8 * fq;
        const int pn = u.pn;
        const int j64 = 4 * (wc & 1) + fq;
#pragma unroll
        for (int ai = 0; ai < 2; ++ai)
#pragma unroll
            for (int m = 0; m < 4; ++m) { const int row = row0 + ai * HALF + m * 16; const float s = rs[row]; bf16_t* rowp = O + (size_t)row * ZP + col0;
                const f32x2* tb = rope + (size_t)(row & (SEQ - 1)) * 32;
#pragma unroll
                for (int bj = 0; bj < 2; ++bj) { f32x4 v0 = acc[ai][bj][m][0] * s, v1 = acc[ai][bj][m][1] * s;
                    const bool r64 = (pn == 4) || (pn == 5) || (pn == 6 && bj == 0), r32 = (pn == 7) || (pn == 8);
                    if (r64 || r32) {
                        f32x2 cs[4];
                        if (r64) { const f32x4 t0 = *(const f32x4*)(tb + 4 * j64), t1 = *(const f32x4*)(tb + 4 * j64 + 2); cs[0] = (f32x2){t0[0], t0[1]}; cs[1] = (f32x2){t0[2], t0[3]}; cs[2] = (f32x2){t1[0], t1[1]}; cs[3] = (f32x2){t1[2], t1[3]}; }
                        else {
#pragma unroll
                            for (int i = 0; i < 4; ++i) cs[i] = tb[8 * fq + 2 * i]; }
#pragma unroll
                        for (int i = 0; i < 4; ++i) { const float a = v0[i], b = v1[i]; v0[i] = a * cs[i].x - b * cs[i].y; v1[i] = b * cs[i].x + a * cs[i].y; }
                        if (pn == 7) { v0 = v0 * DQ_SCALE; v1 = v1 * DQ_SCALE; }
                    }
                    u32x4 w; w.x = pk2(v0[0], v0[1]); w.y = pk2(v0[2], v0[3]); w.z = pk2(v1[0], v1[1]); w.w = pk2(v1[2], v1[3]);
                    *(u32x4*)(rowp + bj * HALF) = w; } }
    }
};

template <class Epi, class Sched, bool ALIGN_EPI = false, bool SP2 = false>
__device__ __forceinline__ void gemm_phase(lds_t lds, const Gemm g, const Sched& S, const Epi& E) {
    const int tid = otid(), wid = __builtin_amdgcn_readfirstlane(tid >> 6), lane = tid & 63, wr = wid >> 2, wc = wid & 3, fr = lane & 15, fq = lane >> 4;
    const int K = g.K, nt = K / BK;
    unsigned voffA[2], voffB[2];
#pragma unroll
    for (int i = 0; i < 2; ++i) { int R, C; stage_rc(tid * 16 + i * 8192, R, C); const int Rb = Epi::PERM ? ((R & ~31) + perm32(R & 31)) : R;
        voffA[i] = (unsigned)(R * K + C) * 2u; voffB[i] = (unsigned)(Rb * K + C) * 2u; }
    const size_t kstep = (size_t)(BK * 2);
    const size_t hstep = (size_t)HALF * K * 2;
    const size_t tstep = 2 * hstep;
    const unsigned ldsw = (unsigned)wid * 1024u;
    const int aoff = lds_byte(wr * 64 + fr, fq * 8), boff = lds_byte(wc * 32 + fr, fq * 8);
#define PG8_SA(b, h) (((b) * 2 + (h)) * HTB)
#define PG8_SB(b, h) ((4 + (b) * 2 + (h)) * HTB)
#define PG8_STAGE(bufoff, gbase, voff) do { _Pragma("unroll") for (int _i = 0; _i < 2; ++_i) \
        __builtin_amdgcn_global_load_lds((const unsigned*)((const char*)(gbase) + (voff)[_i]), (LAS unsigned*)(lds + (bufoff) + ldsw + _i * 8192), 16, 0, 0); } while (0)
#define PG8_LDA(dst, b, h) do { _Pragma("unroll") for (int m = 0; m < 4; ++m) _Pragma("unroll") for (int k = 0; k < 2; ++k) dst[m][k] = *(const LAS bf16x8*)(lds + PG8_SA(b, h) + aoff + m * 2048 + k * 1024); } while (0)
#define PG8_LDB(dst, b, h) do { _Pragma("unroll") for (int n = 0; n < 2; ++n) _Pragma("unroll") for (int k = 0; k < 2; ++k) dst[n][k] = *(const LAS bf16x8*)(lds + PG8_SB(b, h) + boff + n * 2048 + k * 1024); } while (0)
#define PG8_MMA(ai, bj, At, Bt) do { __builtin_amdgcn_s_setprio(1); _Pragma("unroll") for (int m = 0; m < 4; ++m) _Pragma("unroll") for (int n = 0; n < 2; ++n) _Pragma("unroll") for (int k = 0; k < 2; ++k) \
        acc[ai][bj][m][n] = __builtin_amdgcn_mfma_f32_16x16x32_bf16(Bt[n][k], At[m][k], acc[ai][bj][m][n], 0, 0, 0); __builtin_amdgcn_s_setprio(0); } while (0)
#define PG8_WAIT_V(n) asm volatile("s_waitcnt vmcnt(" #n ")" ::: "memory")
#define PG8_WAIT_L(n) asm volatile("s_waitcnt lgkmcnt(" #n ")" ::: "memory")
#define PG8_BAR __builtin_amdgcn_s_barrier()
#define PG8_SCHED __builtin_amdgcn_sched_barrier(0)
    Unit cur, nxt; int ui = 0;
    if (!S.next(0, cur)) return;
    f32x4 acc[2][2][4][2];
#pragma unroll
    for (int a = 0; a < 2; ++a)
#pragma unroll
        for (int b = 0; b < 2; ++b)
#pragma unroll
            for (int m = 0; m < 4; ++m)
#pragma unroll
                for (int n = 0; n < 2; ++n) acc[a][b][m][n] = (f32x4){0.f, 0.f, 0.f, 0.f};
    bf16x8 At[4][2], B0[2][2], B1[2][2];
    const char* cA = (const char*)g.A + (size_t)cur.pm * tstep; const char* cB = (const char*)g.Bt + (size_t)cur.pn * tstep;
    S.a_ready(cur);
    if constexpr (SP2) {
        PG8_STAGE(PG8_SB(0, 0), cB, voffB); PG8_STAGE(PG8_SB(0, 1), cB + hstep, voffB); PG8_STAGE(PG8_SA(0, 0), cA, voffA); PG8_STAGE(PG8_SA(0, 1), cA + hstep, voffA);
        if (wr == 1) PG8_BAR;
        PG8_WAIT_V(2); PG8_BAR;
        PG8_STAGE(PG8_SB(1, 0), cB + kstep, voffB); PG8_STAGE(PG8_SA(1, 0), cA + kstep, voffA); PG8_STAGE(PG8_SB(1, 1), cB + hstep + kstep, voffB);
        PG8_WAIT_V(6); PG8_BAR;
    } else {
        PG8_STAGE(PG8_SB(0, 0), cB, voffB); PG8_STAGE(PG8_SA(0, 0), cA, voffA); PG8_STAGE(PG8_SB(0, 1), cB + hstep, voffB); PG8_STAGE(PG8_SA(0, 1), cA + hstep, voffA);
        if (wr == 1) PG8_BAR;
        PG8_WAIT_V(4); PG8_BAR;
        PG8_STAGE(PG8_SB(1, 0), cB + kstep, voffB); PG8_STAGE(PG8_SA(1, 0), cA + kstep, voffA); PG8_STAGE(PG8_SB(1, 1), cB + hstep + kstep, voffB);
        PG8_WAIT_V(6); PG8_BAR;
    }
    for (;;) {
        const bool has_next = S.next(ui + 1, nxt);
        const char* nA = has_next ? (const char*)g.A + (size_t)nxt.pm * tstep : cA; const char* nB = has_next ? (const char*)g.Bt + (size_t)nxt.pn * tstep : cB;
        for (int t = 0; t < nt; t += 2) {
            const bool last = (t == nt - 2);
            const char* a1 = cA + (size_t)(t + 1) * kstep;
            const char* a2 = last ? nA : cA + (size_t)(t + 2) * kstep; const char* b2 = last ? nB : cB + (size_t)(t + 2) * kstep;
            const char* a3 = a2 + kstep; const char* b3 = b2 + kstep;
            if (last && has_next) S.a_ready(nxt);
            if constexpr (SP2) {
            PG8_LDB(B0, 0, 0); PG8_LDB(B1, 0, 1); PG8_SCHED; PG8_LDA(At, 0, 0); PG8_STAGE(PG8_SA(1, 1), a1 + hstep, voffA);
            PG8_WAIT_V(8); PG8_WAIT_L(0); PG8_BAR; PG8_MMA(0, 0, At, B0); PG8_MMA(0, 1, At, B1); PG8_BAR; PG8_SCHED;
            PG8_LDA(At, 0, 1); PG8_STAGE(PG8_SB(0, 0), b2, voffB); PG8_STAGE(PG8_SB(0, 1), b2 + hstep, voffB); PG8_STAGE(PG8_SA(0, 0), a2, voffA);
            PG8_WAIT_V(8); PG8_WAIT_L(0); PG8_BAR; PG8_MMA(1, 0, At, B0); PG8_MMA(1, 1, At, B1); PG8_BAR; PG8_SCHED;
            PG8_LDB(B0, 1, 0); PG8_LDB(B1, 1, 1); PG8_SCHED; PG8_LDA(At, 1, 0); PG8_STAGE(PG8_SA(0, 1), a2 + hstep, voffA);
            PG8_WAIT_V(8); PG8_WAIT_L(0); PG8_BAR; PG8_MMA(0, 0, At, B0); PG8_MMA(0, 1, At, B1); PG8_BAR; PG8_SCHED;
            PG8_LDA(At, 1, 1); PG8_STAGE(PG8_SB(1, 0), b3, voffB); PG8_STAGE(PG8_SB(1, 1), b3 + hstep, voffB); PG8_STAGE(PG8_SA(1, 0), a3, voffA);
            PG8_WAIT_V(8); PG8_WAIT_L(0); PG8_BAR; PG8_MMA(1, 0, At, B0); PG8_MMA(1, 1, At, B1); PG8_BAR; PG8_SCHED;
            } else {
            PG8_LDB(B0, 0, 0); PG8_SCHED; PG8_LDA(At, 0, 0); PG8_STAGE(PG8_SA(1, 1), a1 + hstep, voffA);
            PG8_WAIT_L(8); PG8_BAR; PG8_WAIT_L(0); PG8_MMA(0, 0, At, B0); PG8_BAR; PG8_SCHED;
            PG8_LDB(B1, 0, 1); PG8_STAGE(PG8_SB(0, 0), b2, voffB);
            PG8_BAR; PG8_WAIT_L(0); PG8_MMA(0, 1, At, B1); PG8_BAR;
            PG8_LDA(At, 0, 1); PG8_STAGE(PG8_SA(0, 0), a2, voffA);
            PG8_BAR; PG8_WAIT_L(0); PG8_MMA(1, 0, At, B0); PG8_BAR; PG8_SCHED;
            PG8_STAGE(PG8_SB(0, 1), b2 + hstep, voffB);
            PG8_WAIT_V(6); PG8_BAR; PG8_MMA(1, 1, At, B1); PG8_BAR;
            PG8_LDB(B0, 1, 0); PG8_SCHED; PG8_LDA(At, 1, 0); PG8_STAGE(PG8_SA(0, 1), a2 + hstep, voffA);
            PG8_WAIT_L(8); PG8_BAR; PG8_WAIT_L(0); PG8_MMA(0, 0, At, B0); PG8_BAR; PG8_SCHED;
            PG8_LDB(B1, 1, 1); PG8_STAGE(PG8_SB(1, 0), b3, voffB);
            PG8_BAR; PG8_WAIT_L(0); PG8_MMA(0, 1, At, B1); PG8_BAR;
            PG8_LDA(At, 1, 1); PG8_STAGE(PG8_SA(1, 0), a3, voffA);
            PG8_BAR; PG8_WAIT_L(0); PG8_MMA(1, 0, At, B0); PG8_BAR; PG8_SCHED;
            PG8_STAGE(PG8_SB(1, 1), b3 + hstep, voffB);
            PG8_WAIT_V(6); PG8_BAR; PG8_MMA(1, 1, At, B1); PG8_BAR;
            }
        }
        if constexpr (ALIGN_EPI) { if (wr == 0) PG8_BAR; }
        E(acc, cur, wr, wc, fr, fq); S.done(cur);
        if (!has_next) break;
#pragma unroll
        for (int a = 0; a < 2; ++a)
#pragma unroll
            for (int b = 0; b < 2; ++b)
#pragma unroll
                for (int m = 0; m < 4; ++m)
#pragma unroll
                    for (int n = 0; n < 2; ++n) acc[a][b][m][n] = (f32x4){0.f, 0.f, 0.f, 0.f};
        cur = nxt; cA = nA; cB = nB; ++ui;
        if constexpr (ALIGN_EPI) { if (wr == 1) PG8_BAR; }
    }
    PG8_WAIT_V(0);
    if constexpr (!ALIGN_EPI) { if (wr == 0) PG8_BAR; }
    PG8_BAR;
#undef PG8_SA
#undef PG8_SB
#undef PG8_STAGE
#undef PG8_LDA
#undef PG8_LDB
#undef PG8_MMA
#undef PG8_WAIT_V
#undef PG8_WAIT_L
#undef PG8_BAR
#undef PG8_SCHED
}
}

__device__ __forceinline__ int zsrc(int c) {
    if (c < 1024) return c;
    if (c < ZC_SK) { const int x = c - ZC_SQ, hh = x >> 6, p = x & 63, j = p >> 3, i = p & 7; return 1032 + hh * 64 + (i < 4 ? 4 * j + i : 32 + 4 * j + (i - 4)); }
    if (c < ZC_SV) { const int x = c - ZC_SK, hh = x >> 6, p = x & 63, j = p >> 3, i = p & 7; return 1544 + hh * 64 + (i < 4 ? 4 * j + i : 32 + 4 * j + (i - 4)); }
    if (c < ZC_DQ) return 1672 + (c - ZC_SV);
    if (c < ZC_DK) { const int x = c - ZC_DQ, hh = x >> 5, p = x & 31, j = p >> 3, i = p & 7; return 1800 + hh * 32 + (i < 4 ? 4 * j + i : 16 + 4 * j + (i - 4)); }
    if (c < ZC_DV) { const int x = c - ZC_DK, hh = x >> 5, p = x & 31, j = p >> 3, i = p & 7; return 2056 + hh * 32 + (i < 4 ? 4 * j + i : 16 + 4 * j + (i - 4)); }
    if (c < ZC_G) return 2312 + (c - ZC_DV);
    if (c < ZC_G + 8) return 1024 + (c - ZC_G);
    return -1;
}
template <bool MAPZ> __device__ __forceinline__ void transpose_item(const float* W, int K, int N, int Nst, const float* gk, bf16_t* WT, LAS float* scr, int item, int lane) {
    const int nblk = Nst / 32, kb = item / nblk, nb = item % nblk, k0 = 64 * kb, n0 = 32 * nb;
    const int nsrc = MAPZ ? zsrc(n0 + (lane & 31)) : (n0 + (lane & 31));
#pragma unroll 8
    for (int i = 0; i < 32; ++i) { const int kk = 2 * i + (lane >> 5); float v = 0.f; if (nsrc >= 0) v = W[(size_t)(k0 + kk) * N + nsrc]; if (gk) v *= gk[k0 + kk]; scr[kk * 33 + (lane & 31)] = v; }
    asm volatile("s_waitcnt lgkmcnt(0)" ::: "memory");
    const int c = lane & 7;
#pragma unroll
    for (int j = 0; j < 4; ++j) { const int n = (lane >> 3) + 8 * j; const LAS float* s = scr + (8 * c) * 33 + n;
        u32x4 o; o.x = pk2(s[0 * 33], s[1 * 33]); o.y = pk2(s[2 * 33], s[3 * 33]); o.z = pk2(s[4 * 33], s[5 * 33]); o.w = pk2(s[6 * 33], s[7 * 33]);
        *(u32x4*)(WT + (size_t)(n0 + n) * K + k0 + 8 * c) = o; }
    asm volatile("s_waitcnt lgkmcnt(0)" ::: "memory");
}
__device__ __forceinline__ void sincos_red(double x, float& c, float& s) {
    const double k = rint(x * 0.15915494309189535), r = x - k * 6.283185307179586, r2 = r * r;
    double sn = 1.0, cs = 1.0;
#pragma unroll
    for (int n = 14; n >= 1; --n) { sn = 1.0 - r2 * (1.0 / (double)((2 * n) * (2 * n + 1))) * sn; cs = 1.0 - r2 * (1.0 / (double)((2 * n - 1) * (2 * n))) * cs; }
    s = (float)(r * sn); c = (float)cs;
}
__device__ __forceinline__ void row_to_bf16(const float* xrow, bf16_t* orow, float* rs, int lane) {
    const f32x4* xr = (const f32x4*)xrow + lane;
    f32x4 v[4]; float s = 0.f;
#pragma unroll
    for (int j = 0; j < 4; ++j) { v[j] = xr[64 * j]; s += (v[j].x * v[j].x + v[j].y * v[j].y) + (v[j].z * v[j].z + v[j].w * v[j].w); }
    s = wave_sum(s);
    u32x2* o8 = (u32x2*)orow + lane;
#pragma unroll
    for (int j = 0; j < 4; ++j) o8[64 * j] = (u32x2){pk2(v[j].x, v[j].y), pk2(v[j].z, v[j].w)};
    if (lane == 0) *rs = 1.f / sqrtf(s * (1.f / DM) + EPS);
}
__device__ __forceinline__ void prologue(const Params& P, lds_t lds, int G) {
    const int tid = otid(), lane = tid & 63, wave = tid >> 6; unsigned char* const ws_ = optr(P.ws);
    LAS float* scr = (LAS float*)(lds + wave * 16384);
    const int gw = blockIdx.x * NWAVES + wave, NGW = G * NWAVES;
    constexpr int I_IN = (DM / 64) * (ZP / 32), I_OUT = (DM / 64) * (DM / 32), I_UP = (DM / 64) * (FF / 32), I_DN = (FF / 64) * (DM / 32), I_L = I_IN + I_OUT + I_UP + I_DN;
    for (int it = gw; it < 2 * I_L; it += NGW) {
        const int l = it / I_L; int r = it % I_L;
        unsigned char* wb = ws_ + WS_W + (size_t)l * W_LAYER;
        if (r < I_IN) { transpose_item<true>(P.in[1] + (size_t)l * DM * INW, DM, INW, ZP, P.in[16] + l * DM, (bf16_t*)(wb + W_IN), scr, r, lane); continue; } r -= I_IN;
        if (r < I_OUT) { transpose_item<false>(P.in[13] + (size_t)l * DM * DM, DM, DM, DM, nullptr, (bf16_t*)(wb + W_OUT), scr, r, lane); continue; } r -= I_OUT;
        if (r < I_UP) { transpose_item<false>(P.in[14] + (size_t)l * DM * FF, DM, FF, FF, P.in[18] + l * DM, (bf16_t*)(wb + W_UP), scr, r, lane); continue; } r -= I_UP;
        transpose_item<false>(P.in[15] + (size_t)l * FF * DM, FF, DM, DM, nullptr, (bf16_t*)(wb + W_DOWN), scr, r, lane);
    }
    f32x2* rope = (f32x2*)(ws_ + WS_ROPE);
    for (int e = blockIdx.x * NTHREADS + tid; e < SEQ * 32; e += G * NTHREADS) {
        const int pos = e >> 5, i = e & 31;
        const float inv = (float)exp(-(double)i * (9.210340371976184 / 32.0));
        const float ang = (float)pos * inv;
        float c, s; sincos_red((double)ang, c, s);
        rope[e] = (f32x2){c, s};
    }
    bf16_t* XB = (bf16_t*)(ws_ + WS_XB); float* RS = (float*)(ws_ + WS_RS);
    for (int m = gw; m < NTOK; m += NGW) row_to_bf16(P.in[0] + (size_t)m * DM, XB + (size_t)m * DM, RS + m, lane);
}

__device__ __forceinline__ void resid_pass(const Params& P, const float* gpost, bool last, int G) {
    const int tid = otid(), lane = tid & 63, wave = tid >> 6; unsigned char* const ws_ = optr(P.ws);
    const int gw = blockIdx.x * NWAVES + wave, NGW = G * NWAVES;
    const bf16_t* MIX = (const bf16_t*)(ws_ + WS_MIX); bf16_t* XB = (bf16_t*)(ws_ + WS_XB); float* RS = (float*)(ws_ + WS_RS);
    f32x4 gv[2][2];
#pragma unroll
    for (int j = 0; j < 2; ++j) { gv[j][0] = *(const f32x4*)(gpost + 512 * j + 8 * lane); gv[j][1] = *(const f32x4*)(gpost + 512 * j + 8 * lane + 4); }
    for (int m0 = gw; m0 < NTOK; m0 += 2 * NGW) {
        u32x4 mw[2][2], xw[2][2];
#pragma unroll
        for (int q = 0; q < 2; ++q) { const int m = m0 + q * NGW; if (m < NTOK) {
#pragma unroll
            for (int j = 0; j < 2; ++j) { mw[q][j] = *(const u32x4*)(MIX + (size_t)m * DM + 512 * j + 8 * lane); xw[q][j] = *(const u32x4*)(XB + (size_t)m * DM + 512 * j + 8 * lane); } } }
#pragma unroll
        for (int q = 0; q < 2; ++q) { const int m = m0 + q * NGW; if (m < NTOK) {
            f32x4 mv[2][2], bv[2][2]; float s = 0.f;
#pragma unroll
            for (int j = 0; j < 2; ++j) { const u32x4 w = mw[q][j], x = xw[q][j];
                mv[j][0] = (f32x4){bflo(w.x), bfhi(w.x), bflo(w.y), bfhi(w.y)}; mv[j][1] = (f32x4){bflo(w.z), bfhi(w.z), bflo(w.w), bfhi(w.w)};
                bv[j][0] = (f32x4){bflo(x.x), bfhi(x.x), bflo(x.y), bfhi(x.y)}; bv[j][1] = (f32x4){bflo(x.z), bfhi(x.z), bflo(x.w), bfhi(x.w)};
#pragma unroll
                for (int k = 0; k < 2; ++k) s += (mv[j][k].x * mv[j][k].x + mv[j][k].y * mv[j][k].y) + (mv[j][k].z * mv[j][k].z + mv[j][k].w * mv[j][k].w); }
            s = wave_sum(s);
            const float r = 1.f / sqrtf(s * (1.f / DM) + EPS);
            float s2 = 0.f;
#pragma unroll
            for (int j = 0; j < 2; ++j)
#pragma unroll
                for (int k = 0; k < 2; ++k) { bv[j][k] = bv[j][k] + mv[j][k] * r * gv[j][k]; s2 += (bv[j][k].x * bv[j][k].x + bv[j][k].y * bv[j][k].y) + (bv[j][k].z * bv[j][k].z + bv[j][k].w * bv[j][k].w); }
            if (last) {
#pragma unroll
                for (int j = 0; j < 2; ++j) { f32x4* o = (f32x4*)(P.out + (size_t)m * DM + 512 * j + 8 * lane); o[0] = bv[j][0]; o[1] = bv[j][1]; }
            } else {
                s2 = wave_sum(s2);
#pragma unroll
                for (int j = 0; j < 2; ++j) *(u32x4*)(XB + (size_t)m * DM + 512 * j + 8 * lane) = (u32x4){pk2(bv[j][0].x, bv[j][0].y), pk2(bv[j][0].z, bv[j][0].w), pk2(bv[j][1].x, bv[j][1].y), pk2(bv[j][1].z, bv[j][1].w)};
                if (lane == 0) RS[m] = 1.f / sqrtf(s2 * (1.f / DM) + EPS);
            }
        } }
    }
}

__device__ __forceinline__ void mlstm_gates(const bf16_t* Z, size_t t0, int hh, float ib, float fb, LAS float* bc, LAS float* ig, int tid) {
    if (tid < 64) {
        const int lane = tid;
        const bf16_t* g0 = Z + (t0 + 2 * lane) * ZP + ZC_G; const bf16_t* g1 = g0 + ZP;
        const float i0 = bf2f(g0[hh]) + ib, i1 = bf2f(g1[hh]) + ib;
        const float l0 = logsigmoidf_(bf2f(g0[4 + hh]) + fb), l1 = logsigmoidf_(bf2f(g1[4 + hh]) + fb);
        float x = l0 + l1;
#pragma unroll
        for (int o = 1; o < 64; o <<= 1) { const float t = __shfl_up(x, o); if (lane >= o) x += t; }
        bc[2 * lane] = x - l1; bc[2 * lane + 1] = x; ig[2 * lane] = i0; ig[2 * lane + 1] = i1;
    }
}
__device__ __forceinline__ void conv8(const bf16_t* zp, int tseq, const float* cw, const float* cb, int ch, float scale, float (&y)[8]) {
    const f32x4 b0 = *(const f32x4*)(cb + ch), b1 = *(const f32x4*)(cb + ch + 4);
    y[0] = b0[0]; y[1] = b0[1]; y[2] = b0[2]; y[3] = b0[3]; y[4] = b1[0]; y[5] = b1[1]; y[6] = b1[2]; y[7] = b1[3];
#pragma unroll
    for (int j = 0; j < 4; ++j) {
        if (tseq - 3 + j >= 0) {
            const u32x4 w = *(const u32x4*)(zp - (size_t)(3 - j) * ZP);
            const f32x4 c0 = *(const f32x4*)(cw + j * 512 + ch), c1 = *(const f32x4*)(cw + j * 512 + ch + 4);
            y[0] += bflo(w.x) * c0[0]; y[1] += bfhi(w.x) * c0[1]; y[2] += bflo(w.y) * c0[2]; y[3] += bfhi(w.y) * c0[3];
            y[4] += bflo(w.z) * c1[0]; y[5] += bfhi(w.z) * c1[1]; y[6] += bflo(w.w) * c1[2]; y[7] += bfhi(w.w) * c1[3];
        }
    }
#pragma unroll
    for (int i = 0; i < 8; ++i) y[i] = y[i] * sigmoidf_(y[i]) * scale;
}
constexpr int TS128 = 264;
constexpr int RS64 = 144;
constexpr int MA_LDS = 2 * 64 * TS128 + 3 * 128 * 4;
__device__ __forceinline__ void mlstm_a_pair(const Params& P, int l, int pair, lds_t lds0) {
    const int tid = otid(), lane = tid & 63, w = tid >> 6, r = lane & 31, h = lane >> 5; unsigned char* const ws_ = optr(P.ws);
    const int half = w >> 2, hw = w & 3, ht = tid & 255, item = 2 * pair + half;
    lds_t lds = lds0 + half * MA_LDS;
    const int c = item & 63, hh = (item >> 6) & 3, b = item >> 8;
    const size_t t0 = (size_t)b * SEQ + (size_t)c * 128;
    const bf16_t* Z = (const bf16_t*)(ws_ + WS_ZB);
    const float* cw = P.in[2] + l * 4 * 512; const float* cb = P.in[3] + l * 512;
    lds_t KT = lds, VT = lds + 64 * TS128; LAS float* bc = (LAS float*)(lds + 2 * 64 * TS128); LAS float* ig = bc + 128; LAS float* wst = ig + 128;
    mlstm_gates(Z, t0, hh, P.in[4][l * 4 + hh], P.in[5][l * 4 + hh], bc, ig, ht);
    __syncthreads();
    const float blast = bc[127];
    if (ht < 128) wst[ht] = __expf(blast - bc[ht] + ig[ht]);
    __syncthreads();
#pragma unroll
    for (int q = 0; q < 4; ++q) {
        const int e = ht + q * 256, s = e >> 3, ch = e & 7;
        float y[8];
        conv8(Z + (t0 + s) * ZP + ZC_MK + hh * 64 + 8 * ch, c * 128 + s, cw, cb, 256 + hh * 64 + 8 * ch, 0.125f, y);
#pragma unroll
        for (int i = 0; i < 8; ++i) *(LAS bf16_t*)(KT + (8 * ch + i) * TS128 + s * 2) = f2bf(y[i]);
        const u32x4 vw = *(const u32x4*)(Z + (t0 + s) * ZP + ZC_MV + hh * 64 + 8 * ch);
        const float ws2 = wst[s];
        const float vv[8] = {bflo(vw.x), bfhi(vw.x), bflo(vw.y), bfhi(vw.y), bflo(vw.z), bfhi(vw.z), bflo(vw.w), bfhi(vw.w)};
#pragma unroll
        for (int i = 0; i < 8; ++i) *(LAS bf16_t*)(VT + (8 * ch + i) * TS128 + s * 2) = f2bf(vv[i] * ws2);
    }
    __syncthreads();
    float* DC = (float*)(ws_ + WS_DC) + (size_t)item * 4096; float* DN = (float*)(ws_ + WS_DN) + (size_t)item * 64; float* DEC = (float*)(ws_ + WS_DEC);
    {
        const int vt = hw >> 1, kt = hw & 1;
        f32x16 acc = {};
#pragma unroll
        for (int ks = 0; ks < 8; ++ks) {
            const bf16x8 a = lds16(VT + (32 * vt + r) * TS128 + (16 * ks + 8 * h) * 2);
            const bf16x8 bb = lds16(KT + (32 * kt + r) * TS128 + (16 * ks + 8 * h) * 2);
            acc = MFMA32(a, bb, acc);
        }
#pragma unroll
        for (int i = 0; i < 16; ++i) DC[(32 * vt + crow(i, h)) * 64 + 32 * kt + r] = acc[i];
    }
    {
        float sum = 0.f;
#pragma unroll
        for (int s8 = 0; s8 < 4; ++s8) {
            const u32x4 kw = *(const LAS u32x4*)(KT + lane * TS128 + (4 * hw + s8) * 16);
            const f32x4 w0 = *(const LAS f32x4*)(wst + 8 * (4 * hw + s8)), w1 = *(const LAS f32x4*)(wst + 8 * (4 * hw + s8) + 4);
            sum += bflo(kw.x) * w0[0] + bfhi(kw.x) * w0[1] + bflo(kw.y) * w0[2] + bfhi(kw.y) * w0[3] + bflo(kw.z) * w1[0] + bfhi(kw.z) * w1[1] + bflo(kw.w) * w1[2] + bfhi(kw.w) * w1[3];
        }
        __syncthreads();
        bc[hw * 64 + lane] = sum;
        __syncthreads();
        if (hw == 0) DN[lane] = (bc[lane] + bc[64 + lane]) + (bc[128 + lane] + bc[192 + lane]);
        if (hw == 1 && lane == 0) DEC[item] = __expf(blast);
    }
    __syncthreads();
}
__device__ __forceinline__ void mlstm_scan(const Params& P, int G) {
    unsigned char* const ws_ = optr(P.ws); const int tid = otid();
    const float* DC = (const float*)(ws_ + WS_DC); const float* DN = (const float*)(ws_ + WS_DN); const float* DEC = (const float*)(ws_ + WS_DEC);
    bf16_t* CS = (bf16_t*)(ws_ + WS_CS); float* NS = (float*)(ws_ + WS_NS);
    for (int ch = blockIdx.x * NTHREADS + tid; ch < 32 * 4160; ch += G * NTHREADS) {
        const int seq = ch / 4160, e = ch % 4160;
        const bool isc = e < 4096; const int k = e - 4096;
        float st = 0.f;
        for (int c0 = 0; c0 < 64; c0 += 16) {
            float dv[16], de[16];
#pragma unroll
            for (int j = 0; j < 16; ++j) { const int it = seq * 64 + c0 + j; de[j] = DEC[it]; dv[j] = isc ? DC[(size_t)it * 4096 + e] : DN[it * 64 + k]; }
#pragma unroll
            for (int j = 0; j < 16; ++j) { const int it = seq * 64 + c0 + j; if (isc) CS[(size_t)it * 4096 + e] = f2bf(st); else NS[it * 64 + k] = st; st = de[j] * st + dv[j]; }
        }
    }
}
constexpr int MC_LDS = 2 * 128 * RS64 + 64 * TS128 + 64 * RS64 + 3 * 128 * 4;
__device__ __forceinline__ void mlstm_c_pair(const Params& P, int l, int pair, lds_t lds0) {
    const int tid = otid(), lane = tid & 63, w = tid >> 6, r = lane & 31, h = lane >> 5; unsigned char* const ws_ = optr(P.ws);
    const int half = w >> 2, hw = w & 3, ht = tid & 255, item = 2 * pair + half;
    lds_t lds = lds0 + half * MC_LDS;
    const int c = item & 63, hh = (item >> 6) & 3, b = item >> 8;
    const size_t t0 = (size_t)b * SEQ + (size_t)c * 128;
    const bf16_t* Z = (const bf16_t*)(ws_ + WS_ZB);
    const float* cw = P.in[2] + l * 4 * 512; const float* cb = P.in[3] + l * 512;
    lds_t Qs = lds, Ks = Qs + 128 * RS64, VT = Ks + 128 * RS64, Cs = VT + 64 * TS128, Hs = Qs;
    LAS float* bc = (LAS float*)(Cs + 64 * RS64); LAS float* ig = bc + 128; LAS float* ns = ig + 128;
    mlstm_gates(Z, t0, hh, P.in[4][l * 4 + hh], P.in[5][l * 4 + hh], bc, ig, ht);
#pragma unroll
    for (int q = 0; q < 4; ++q) {
        const int e = ht + q * 256, s = e >> 3, ch = e & 7;
        float y[8];
        conv8(Z + (t0 + s) * ZP + ZC_MQ + hh * 64 + 8 * ch, c * 128 + s, cw, cb, hh * 64 + 8 * ch, 1.f, y);
        *(LAS u32x4*)(Qs + s * RS64 + ch * 16) = (u32x4){pk2(y[0], y[1]), pk2(y[2], y[3]), pk2(y[4], y[5]), pk2(y[6], y[7])};
        conv8(Z + (t0 + s) * ZP + ZC_MK + hh * 64 + 8 * ch, c * 128 + s, cw, cb, 256 + hh * 64 + 8 * ch, 0.125f, y);
        *(LAS u32x4*)(Ks + s * RS64 + ch * 16) = (u32x4){pk2(y[0], y[1]), pk2(y[2], y[3]), pk2(y[4], y[5]), pk2(y[6], y[7])};
        const u32x4 vw = *(const u32x4*)(Z + (t0 + s) * ZP + ZC_MV + hh * 64 + 8 * ch);
        const unsigned vv[4] = {vw.x, vw.y, vw.z, vw.w};
#pragma unroll
        for (int i = 0; i < 4; ++i) { *(LAS bf16_t*)(VT + (8 * ch + 2 * i) * TS128 + s * 2) = (bf16_t)(vv[i] & 0xffffu); *(LAS bf16_t*)(VT + (8 * ch + 2 * i + 1) * TS128 + s * 2) = (bf16_t)(vv[i] >> 16); }
    }
#pragma unroll
    for (int q = 0; q < 2; ++q) { const int e = ht + q * 256, v = e >> 3, ch = e & 7; *(LAS u32x4*)(Cs + v * RS64 + ch * 16) = *(const u32x4*)((const bf16_t*)(ws_ + WS_CS) + (size_t)item * 4096 + v * 64 + ch * 8); }
    if (ht < 64) ns[ht] = ((const float*)(ws_ + WS_NS))[item * 64 + ht];
    __syncthreads();
    {
        const int tt = hw, tl = 32 * tt + r;
        bf16x8 qf[4];
#pragma unroll
        for (int ks = 0; ks < 4; ++ks) qf[ks] = lds16(Qs + tl * RS64 + (16 * ks + 8 * h) * 2);
        f32x16 num[2] = {};
#pragma unroll
        for (int vt = 0; vt < 2; ++vt)
#pragma unroll
            for (int ks = 0; ks < 4; ++ks) num[vt] = MFMA32(lds16(Cs + (32 * vt + r) * RS64 + (16 * ks + 8 * h) * 2), qf[ks], num[vt]);
        float nq = 0.f;
#pragma unroll
        for (int ks = 0; ks < 4; ++ks) {
            const u32x4 qw = __builtin_bit_cast(u32x4, qf[ks]);
            const f32x4 n0 = *(const LAS f32x4*)(ns + 16 * ks + 8 * h), n1 = *(const LAS f32x4*)(ns + 16 * ks + 8 * h + 4);
            nq += bflo(qw.x) * n0[0] + bfhi(qw.x) * n0[1] + bflo(qw.y) * n0[2] + bfhi(qw.y) * n0[3] + bflo(qw.z) * n1[0] + bfhi(qw.z) * n1[1] + bflo(qw.w) * n1[2] + bfhi(qw.w) * n1[3];
        }
        nq = swap_add(nq);
        const float bt = bc[tl], eb = __expf(bt);
#pragma unroll
        for (int vt = 0; vt < 2; ++vt)
#pragma unroll
            for (int i = 0; i < 16; ++i) num[vt][i] *= eb;
        float den = 0.f;
        for (int st = 0; st <= tt; ++st) {
            f32x16 S = {};
#pragma unroll
            for (int ks = 0; ks < 4; ++ks) S = MFMA32(lds16(Ks + (32 * st + r) * RS64 + (16 * ks + 8 * h) * 2), qf[ks], S);
#pragma unroll
            for (int i = 0; i < 16; ++i) { const int s2 = 32 * st + crow(i, h); const float wgt = (s2 <= tl) ? __expf(bt - bc[s2] + ig[s2]) : 0.f; S[i] *= wgt; den += S[i]; }
#pragma unroll
            for (int s2 = 0; s2 < 2; ++s2) { const bf16x8 pf = pack8(S, s2);
#pragma unroll
                for (int vt = 0; vt < 2; ++vt) { lds_t vp = VT + (32 * vt + r) * TS128 + (32 * st + 16 * s2 + 4 * h) * 2; num[vt] = MFMA32(lds8x2(vp, vp + 16), pf, num[vt]); } }
        }
        den = swap_add(den) + eb * nq;
        const float dinv = 1.f / fmaxf(fabsf(den), 1.f);
        float ss = 0.f;
#pragma unroll
        for (int vt = 0; vt < 2; ++vt)
#pragma unroll
            for (int i = 0; i < 16; ++i) { num[vt][i] *= dinv; ss += num[vt][i] * num[vt][i]; }
        ss = swap_add(ss);
        const float rn = 1.f / sqrtf(ss * (1.f / 64.f) + EPS);
#pragma unroll
        for (int vt = 0; vt < 2; ++vt)
#pragma unroll
            for (int i = 0; i < 16; ++i) *(LAS bf16_t*)(Hs + tl * RS64 + (32 * vt + crow(i, h)) * 2) = f2bf(num[vt][i] * rn);
    }
    __syncthreads();
    bf16_t* CAT = (bf16_t*)(ws_ + WS_CAT);
    const float* mg = P.in[6] + l * 256 + hh * 64;
#pragma unroll
    for (int q = 0; q < 4; ++q) {
        const int e = ht + q * 256, t = e >> 3, ch = e & 7;
        const u32x4 hw4 = *(const LAS u32x4*)(Hs + t * RS64 + ch * 16);
        const u32x4 ow = *(const u32x4*)(Z + (t0 + t) * ZP + ZC_MO + hh * 64 + 8 * ch);
        const f32x4 g0 = *(const f32x4*)(mg + 8 * ch), g1 = *(const f32x4*)(mg + 8 * ch + 4);
        u32x4 o;
        o.x = pk2(bflo(hw4.x) * g0[0] * sigmoidf_(bflo(ow.x)), bfhi(hw4.x) * g0[1] * sigmoidf_(bfhi(ow.x)));
        o.y = pk2(bflo(hw4.y) * g0[2] * sigmoidf_(bflo(ow.y)), bfhi(hw4.y) * g0[3] * sigmoidf_(bfhi(ow.y)));
        o.z = pk2(bflo(hw4.z) * g1[0] * sigmoidf_(bflo(ow.z)), bfhi(hw4.z) * g1[1] * sigmoidf_(bfhi(ow.z)));
        o.w = pk2(bflo(hw4.w) * g1[2] * sigmoidf_(bflo(ow.w)), bfhi(hw4.w) * g1[3] * sigmoidf_(bfhi(ow.w)));
        *(u32x4*)(CAT + (t0 + t) * DM + hh * 64 + 8 * ch) = o;
    }
    __syncthreads();
}

typedef short v4i16s_t __attribute__((ext_vector_type(4)));
__device__ __forceinline__ s16x4 vtr_s(lds_t p) { return __builtin_bit_cast(s16x4, __builtin_amdgcn_ds_read_tr16_b64_v4i16((LAS v4i16s_t*)p)); }
constexpr int SVS = 192;
__device__ __forceinline__ void swa_item(const Params& P, int l, int item, lds_t lds) {
    const int tid = otid(), lane = tid & 63, w = tid >> 6, r = lane & 31, h = lane >> 5; unsigned char* const ws_ = optr(P.ws);
    const int kvh = item & 1, nb = (item >> 1) & 63, b = item >> 7;
    const size_t t0 = (size_t)b * SEQ + (size_t)nb * 128;
    const bf16_t* Z = (const bf16_t*)(ws_ + WS_ZB);
    lds_t Ks = lds, Vs = lds + 256 * RS64, Os = Vs + 256 * SVS;
#pragma unroll
    for (int q = 0; q < 4; ++q) {
        const int e = tid + q * 512, kb = e >> 3, ch = e & 7;
        u32x4 kw = {0u, 0u, 0u, 0u}, vw = {0u, 0u, 0u, 0u};
        if (nb > 0 || kb >= 128) { const bf16_t* zr = Z + (t0 - 128 + kb) * ZP; kw = *(const u32x4*)(zr + ZC_SK + kvh * 64 + 8 * ch); vw = *(const u32x4*)(zr + ZC_SV + kvh * 64 + 8 * ch); }
        *(LAS u32x4*)(Ks + kb * RS64 + ch * 16) = kw;
        *(LAS u32x4*)(Vs + kb * SVS + ch * 16) = vw;
    }
    __syncthreads();
    bf16_t* CAT = (bf16_t*)(ws_ + WS_CAT);
    lds_t Ow = Os + w * 32 * RS64;
    const int voff = (((lane & 15) >> 2) + 4 * h) * SVS + (16 * ((lane >> 4) & 1) + 4 * (lane & 3)) * 2;
    for (int cc = w; cc < 16; cc += 8) {
        const int hq = cc >> 2, qt = cc & 3, hg = kvh * 4 + hq, ql = 32 * qt + r;
        const float sink = P.in[7][l * 8 + hg];
        const bf16_t* qp = Z + (t0 + ql) * ZP + ZC_SQ + hg * 64;
        bf16x8 qf[4];
#pragma unroll
        for (int ks = 0; ks < 4; ++ks) qf[ks] = *(const bf16x8*)(qp + 16 * ks + 8 * h);
        f32x16 S[5];
        float mx = sink;
#pragma unroll
        for (int k5 = 0; k5 < 5; ++k5) {
            const int kt = qt + k5;
            S[k5] = (f32x16){};
#pragma unroll
            for (int ks = 0; ks < 4; ++ks) S[k5] = MFMA32(lds16(Ks + (32 * kt + r) * RS64 + (16 * ks + 8 * h) * 2), qf[ks], S[k5]);
        }
#pragma unroll
        for (int k5 = 0; k5 < 5; ++k5) {
            const int kt = qt + k5;
#pragma unroll
            for (int i = 0; i < 16; ++i) { const int kb = 32 * kt + crow(i, h); const bool ok = (kb > ql) && (kb <= ql + 128) && (nb > 0 || kb >= 128);
                S[k5][i] = ok ? S[k5][i] * 0.125f : -1e30f; mx = fmaxf(mx, S[k5][i]); }
        }
        mx = swap_max(mx);
        float sum = 0.f;
#pragma unroll
        for (int k5 = 0; k5 < 5; ++k5)
#pragma unroll
            for (int i = 0; i < 16; ++i) { S[k5][i] = __expf(S[k5][i] - mx); sum += S[k5][i]; }
        sum = swap_add(sum) + __expf(sink - mx);
        const float inv = 1.f / sum;
        f32x16 O[2] = {};
#pragma unroll
        for (int k5 = 0; k5 < 5; ++k5) {
            const int kt = qt + k5;
#pragma unroll
            for (int s2 = 0; s2 < 2; ++s2) { const bf16x8 pf = pack8(S[k5], s2);
#pragma unroll
                for (int dt = 0; dt < 2; ++dt) { lds_t vp = Vs + voff + (32 * kt + 16 * s2) * SVS + 64 * dt; const s16x4 lo = vtr_s(vp), hi = vtr_s(vp + 8 * SVS);
                    O[dt] = MFMA32(__builtin_shufflevector(lo, hi, 0, 1, 2, 3, 4, 5, 6, 7), pf, O[dt]); } }
        }
#pragma unroll
        for (int dt = 0; dt < 2; ++dt)
#pragma unroll
            for (int i = 0; i < 16; ++i) *(LAS bf16_t*)(Ow + r * RS64 + (32 * dt + crow(i, h)) * 2) = f2bf(O[dt][i] * inv);
        asm volatile("s_waitcnt lgkmcnt(0)" ::: "memory");
#pragma unroll
        for (int it = 0; it < 4; ++it) { const int row = it * 8 + (lane >> 3), ch = lane & 7; const u32x4 v = *(const LAS u32x4*)(Ow + row * RS64 + ch * 16);
            *(u32x4*)(CAT + (t0 + 32 * qt + row) * DM + 256 + hg * 64 + 8 * ch) = v; }
        asm volatile("s_waitcnt lgkmcnt(0)" ::: "memory");
    }
    __syncthreads();
}

typedef short v4i16_t __attribute__((ext_vector_type(4)));
__device__ __forceinline__ s16x4 vtr(lds_t p) { return __builtin_bit_cast(s16x4, __builtin_amdgcn_ds_read_tr16_b64_v4i16((LAS v4i16_t*)p)); }
constexpr int DKS = 144, DVS = 192;
constexpr int DK_BYTES = 64 * DKS, DV_BYTES = 64 * DVS, DBUF = DK_BYTES + DV_BYTES;
__device__ __forceinline__ void dsoftmax(f32x16& S0, f32x16& S1, unsigned& qxw, f32x16& Oa, f32x16& Ob, float& mx, float& ls, bf16x8 (&pf)[2][2], bool first, bool needmask, int kbase, int qrow, int h) {
    if (needmask) {
#pragma unroll
        for (int i = 0; i < 16; ++i) { const int key = kbase + crow(i, h); if (key > qrow) S0[i] = -1e30f; if (key + 32 > qrow) S1[i] = -1e30f; }
    }
    float ta = fmaxf(fmaxf(S0[0], S0[1]), S1[0]), tb = fmaxf(fmaxf(S0[2], S0[3]), S1[1]); ta = fmaxf(fmaxf(ta, S1[2]), S1[3]);
#pragma unroll
    for (int i = 4; i < 16; i += 4) { ta = fmaxf(fmaxf(ta, S0[i]), S0[i + 1]); tb = fmaxf(fmaxf(tb, S0[i + 2]), S0[i + 3]); ta = fmaxf(fmaxf(ta, S1[i]), S1[i + 1]); tb = fmaxf(fmaxf(tb, S1[i + 2]), S1[i + 3]); }
    const float tm = swap_max(fmaxf(ta, tb));
    if (first || __any(tm > 8.f)) {
        const float mnew = bf2f(f2bf(mx + (first ? tm : fmaxf(tm, 0.f))));
        const float dl = mnew - mx;
        mx = mnew;
        qxw = h ? 0u : (unsigned)f2bf(-mnew);
        const float alpha = first ? 1.f : __builtin_amdgcn_exp2f(-dl);
        ls *= alpha;
#pragma unroll
        for (int i = 0; i < 16; ++i) { S0[i] -= dl; S1[i] -= dl; Oa[i] *= alpha; Ob[i] *= alpha; }
    }
    float sa = 0.f, sb = 0.f;
#pragma unroll
    for (int i = 0; i < 16; ++i) { S0[i] = __builtin_amdgcn_exp2f(S0[i]); S1[i] = __builtin_amdgcn_exp2f(S1[i]); sa += S0[i]; asm("" : "+v"(sa)); sb += S1[i]; asm("" : "+v"(sb)); }
    ls += sa + sb;
    pf[0][0] = pack8(S0, 0); pf[0][1] = pack8(S0, 1); pf[1][0] = pack8(S1, 0); pf[1][1] = pack8(S1, 1);
}
__device__ __forceinline__ void dqk(f32x16& S0, f32x16& S1, unsigned qxw, lds_t kb, const bf16x8 (&q)[2], int h) {
    const bf16x8 kones = __builtin_bit_cast(bf16x8, (u32x4){h ? 0u : 0x3f80u, 0u, 0u, 0u}), qx = __builtin_bit_cast(bf16x8, (u32x4){qxw, 0u, 0u, 0u});
    S0 = (f32x16){}; S1 = (f32x16){};
#pragma unroll
    for (int ks = 0; ks < 2; ++ks) { S0 = MFMA32(lds16(kb + 32 * ks), q[ks], S0); S1 = MFMA32(lds16(kb + 32 * DKS + 32 * ks), q[ks], S1); }
    S0 = MFMA32(kones, qx, S0); S1 = MFMA32(kones, qx, S1);
}
#define SBAR() __builtin_amdgcn_sched_barrier(0)
__device__ __forceinline__ void diff_item(const Params& P, int l, int seq, int qb, lds_t lds, float lam, float oscale) {
    const int tid = otid(), lane = tid & 63, w = tid >> 6, r = lane & 31, h = lane >> 5; unsigned char* const ws_ = optr(P.ws);
    const int b = seq >> 2, hd = seq & 3;
    const size_t row0 = (size_t)b * SEQ;
    const bf16_t* Z = (const bf16_t*)(ws_ + WS_ZB);
    const int qrow = qb * 256 + w * 32 + r, wmin = qb * 256 + w * 32;
    const bf16_t* qp = Z + (row0 + qrow) * ZP + ZC_DQ + hd * 64;
    bf16x8 qf[2][2];
#pragma unroll
    for (int m = 0; m < 2; ++m)
#pragma unroll
        for (int ks = 0; ks < 2; ++ks) qf[m][ks] = *(const bf16x8*)(qp + 32 * m + 16 * ks + 8 * h);
    f32x16 O[2][2] = {};
    unsigned qxw[2] = {0u, 0u};
    float mx[2] = {0.f, 0.f}, ls[2] = {0.f, 0.f};
    const int NT = 4 * qb + 4, Tw = 4 * qb + (w >> 1) + 1;
    const int skey = tid >> 3, sch = tid & 7;
    const bf16_t* kg = Z + (row0 + skey) * ZP + ZC_DK + hd * 64 + 8 * sch; const bf16_t* vg = Z + (row0 + skey) * ZP + ZC_DV + hd * 64 + 8 * sch;
    lds_t Os = lds + 3 * DBUF;
    const int soffk = skey * DKS + sch * 16, soffv = DK_BYTES + skey * DVS + sch * 16;
    const int koff = r * DKS + 16 * h, voff = DK_BYTES + (((lane & 15) >> 2) + 4 * h) * DVS + (16 * ((lane >> 4) & 1) + 4 * (lane & 3)) * 2;
    u32x4 kreg = *(const u32x4*)kg, vreg = *(const u32x4*)vg;
    *(LAS u32x4*)(lds + soffk) = kreg; *(LAS u32x4*)(lds + soffv) = vreg;
    kreg = *(const u32x4*)(kg + (size_t)64 * ZP); vreg = *(const u32x4*)(vg + (size_t)64 * ZP);
    __syncthreads();
    f32x16 S0a, S0b, S1a, S1b;
    bf16x8 pf0[2][2], pf1[2][2];
    dqk(S0a, S0b, qxw[0], lds + koff, qf[0], h);
    int bc = 0, bn = DBUF;
    for (int t = 0; t < NT; ++t) {
        const bool act = t < Tw, needmask = (64 * t + 63 > wmin);
        lds_t Tb = lds + bc, Tn = lds + bn;
        SBAR();
        if (act) {
            dqk(S1a, S1b, qxw[1], Tb + koff + 64, qf[1], h);
            dsoftmax(S0a, S0b, qxw[0], O[0][0], O[0][1], mx[0], ls[0], pf0, t == 0, needmask, 64 * t, qrow, h);
        }
        SBAR();
        if (t + 1 < NT) { *(LAS u32x4*)(Tn + soffk) = kreg; *(LAS u32x4*)(Tn + soffv) = vreg; }
        __syncthreads();
        if (t + 2 < NT) { kreg = *(const u32x4*)(kg + (size_t)(t + 2) * 64 * ZP); vreg = *(const u32x4*)(vg + (size_t)(t + 2) * 64 * ZP); }
        SBAR();
        if (act) {
            if (t + 1 < Tw) dqk(S0a, S0b, qxw[0], Tn + koff, qf[0], h);
            dsoftmax(S1a, S1b, qxw[1], O[1][0], O[1][1], mx[1], ls[1], pf1, t == 0, needmask, 64 * t, qrow, h);
            SBAR();
#pragma unroll
            for (int kh = 0; kh < 2; ++kh)
#pragma unroll
                for (int s2 = 0; s2 < 2; ++s2) {
                    bf16x8 vf[2];
#pragma unroll
                    for (int dt = 0; dt < 2; ++dt) { lds_t vp = Tb + voff + (32 * kh + 16 * s2) * DVS + 64 * dt; const s16x4 lo = vtr(vp), hi = vtr(vp + 8 * DVS); vf[dt] = __builtin_shufflevector(lo, hi, 0, 1, 2, 3, 4, 5, 6, 7); }
                    O[0][0] = MFMA32(vf[0], pf0[kh][s2], O[0][0]); O[0][1] = MFMA32(vf[1], pf0[kh][s2], O[0][1]);
                    O[1][0] = MFMA32(vf[0], pf1[kh][s2], O[1][0]); O[1][1] = MFMA32(vf[1], pf1[kh][s2], O[1][1]);
                }
        }
        bc = bn; bn = (bn == 2 * DBUF) ? 0 : bn + DBUF;
    }
    const float i1 = 1.f / swap_add(ls[0]), i2 = lam / swap_add(ls[1]);
    float ss = 0.f;
#pragma unroll
    for (int dt = 0; dt < 2; ++dt)
#pragma unroll
        for (int i = 0; i < 16; ++i) { const float o = O[0][dt][i] * i1 - O[1][dt][i] * i2; O[0][dt][i] = o; ss += o * o; }
    ss = swap_add(ss);
    const float rn = oscale / sqrtf(ss * (1.f / 64.f) + EPS);
    lds_t Ow = Os + w * 32 * RS64;
#pragma unroll
    for (int dt = 0; dt < 2; ++dt)
#pragma unroll
        for (int i = 0; i < 16; ++i) *(LAS bf16_t*)(Ow + r * RS64 + (32 * dt + crow(i, h)) * 2) = f2bf(O[0][dt][i] * rn);
    asm volatile("s_waitcnt lgkmcnt(0)" ::: "memory");
    bf16_t* CAT = (bf16_t*)(ws_ + WS_CAT);
    const float* sg = P.in[12] + l * 64;
#pragma unroll
    for (int it = 0; it < 4; ++it) { const int row = it * 8 + (lane >> 3), ch = lane & 7; const u32x4 v = *(const LAS u32x4*)(Ow + row * RS64 + ch * 16);
        const f32x4 g0 = *(const f32x4*)(sg + 8 * ch), g1 = *(const f32x4*)(sg + 8 * ch + 4);
        u32x4 o; o.x = pk2(bflo(v.x) * g0[0], bfhi(v.x) * g0[1]); o.y = pk2(bflo(v.y) * g0[2], bfhi(v.y) * g0[3]); o.z = pk2(bflo(v.z) * g1[0], bfhi(v.z) * g1[1]); o.w = pk2(bflo(v.w) * g1[2], bfhi(v.w) * g1[3]);
        *(u32x4*)(CAT + (row0 + wmin + row) * DM + 768 + hd * 64 + 8 * ch) = o; }
    __syncthreads();
}
#undef SBAR

constexpr int N_PHASES = 19;
__global__ void __launch_bounds__(NTHREADS, 2) hybrid_fwd(Params P) {
    extern __shared__ __attribute__((aligned(16))) unsigned char lds_raw[];
    lds_t lds = (lds_t)lds_raw;
    cg::grid_group grid = cg::this_grid();
    const int G = gridDim.x, lo = P.ph_lo, hi = P.ph_hi;
    int ph = 0;
#define PHASE_BEGIN(k) if (((PH_MASK >> (k)) & 1) && lo <= ph && ph < hi) { for (int rep_ = 0; rep_ <= ((REP_MASK >> (k)) & 1); ++rep_) { if (rep_) grid.sync();
#define PHASE_END   } if (ph + 1 < hi) grid.sync(); } ++ph;
    PHASE_BEGIN(0) prologue(P, lds, G); PHASE_END
    for (int l = 0; l < 2; ++l) {
        unsigned char* wb = P.ws + WS_W + (size_t)l * W_LAYER;
        bf16_t* XB = (bf16_t*)(P.ws + WS_XB); float* RS = (float*)(P.ws + WS_RS);
        PHASE_BEGIN(1) {
            pg8::Gemm g{XB, (const bf16_t*)(wb + W_IN), NTOK, ZP, DM}; pg8::StaticOrder S; S.init(NTOK, ZP, G, (int)blockIdx.x);
            pg8::EpiInProj E{(bf16_t*)(P.ws + WS_ZB), RS, (const f32x2*)(P.ws + WS_ROPE)};
            pg8::gemm_phase<pg8::EpiInProj, pg8::StaticOrder, true, true>(lds, g, S, E);
        } PHASE_END
        PHASE_BEGIN(2) {
            for (int it = blockIdx.x; it < 1024; it += G) mlstm_a_pair(P, l, it, lds);
            for (int it = blockIdx.x; it < 1024; it += G) swa_item(P, l, it, lds);
        } PHASE_END
        PHASE_BEGIN(3) {
            mlstm_scan(P, G);
            float d1 = 0.f, d2 = 0.f;
            for (int i = 0; i < 32; ++i) { d1 += P.in[8][l * 32 + i] * P.in[9][l * 32 + i]; d2 += P.in[10][l * 32 + i] * P.in[11][l * 32 + i]; }
            const float lam_init = 0.8f - 0.6f * expf(-0.3f * (float)l);
            const float lam = expf(d1) - expf(d2) + lam_init;
            for (int vg = blockIdx.x; vg < 256; vg += G) {
                const int seq = vg >> 3, j = vg & 7;
                diff_item(P, l, seq, 31 - j, lds, lam, 1.f - lam_init);
                diff_item(P, l, seq, 16 + j, lds, lam, 1.f - lam_init);
                diff_item(P, l, seq, 15 - j, lds, lam, 1.f - lam_init);
                diff_item(P, l, seq, j, lds, lam, 1.f - lam_init);
            }
        } PHASE_END
        PHASE_BEGIN(4) {
            for (int it = blockIdx.x; it < 1024; it += G) mlstm_c_pair(P, l, it, lds);
        } PHASE_END
        PHASE_BEGIN(5) {
            pg8::Gemm g{(const bf16_t*)(P.ws + WS_CAT), (const bf16_t*)(wb + W_OUT), NTOK, DM, DM}; pg8::StaticOrder S; S.init(NTOK, DM, G, (int)blockIdx.x);
            pg8::EpiRow<0> E{(bf16_t*)(P.ws + WS_MIX), DM, nullptr};
            pg8::gemm_phase<pg8::EpiRow<0>, pg8::StaticOrder, true, true>(lds, g, S, E);
        } PHASE_END
        PHASE_BEGIN(6) resid_pass(P, P.in[17] + l * DM, false, G); PHASE_END
        PHASE_BEGIN(7) {
            pg8::Gemm g{XB, (const bf16_t*)(wb + W_UP), NTOK, FF, DM}; pg8::StaticOrder S; S.init(NTOK, FF, G, (int)blockIdx.x);
            pg8::EpiRow<1> E{(bf16_t*)(P.ws + WS_U), FF, RS};
            pg8::gemm_phase<pg8::EpiRow<1>, pg8::StaticOrder, true, true>(lds, g, S, E);
        } PHASE_END
        PHASE_BEGIN(8) {
            pg8::Gemm g{(const bf16_t*)(P.ws + WS_U), (const bf16_t*)(wb + W_DOWN), NTOK, DM, FF}; pg8::StaticOrder S; S.init(NTOK, DM, G, (int)blockIdx.x);
            pg8::EpiRow<0> E{(bf16_t*)(P.ws + WS_MIX), DM, nullptr};
            pg8::gemm_phase<pg8::EpiRow<0>, pg8::StaticOrder, true, true>(lds, g, S, E);
        } PHASE_END
        PHASE_BEGIN(9) resid_pass(P, P.in[19] + l * DM, l == 1, G); PHASE_END
    }
#undef PHASE_BEGIN
#undef PHASE_END
}

extern "C" void kernel_launch(void* const* d_in, const int* in_sizes, int n_in, void* d_out, int out_size, void* d_ws, size_t ws_size, hipStream_t stream) {
    static int grid = 0;
    if (grid == 0) {
        if (n_in != 20 || out_size != NTOK * DM || ws_size < WS_END) { fprintf(stderr, "kernel_launch: unexpected shapes (n_in %d out %d ws %zu)\n", n_in, out_size, ws_size); grid = -1; return; }
        int dev = 0, cus = 0, per_cu = 0;
        hipGetDevice(&dev); hipDeviceGetAttribute(&cus, hipDeviceAttributeMultiprocessorCount, dev);
        if (hipFuncSetAttribute((const void*)hybrid_fwd, hipFuncAttributeMaxDynamicSharedMemorySize, LDS_BYTES) != hipSuccess) { fprintf(stderr, "kernel_launch: hipFuncSetAttribute failed\n"); grid = -1; return; }
        if (hipOccupancyMaxActiveBlocksPerMultiprocessor(&per_cu, (const void*)hybrid_fwd, NTHREADS, LDS_BYTES) != hipSuccess || per_cu < 1) { fprintf(stderr, "kernel_launch: occupancy query says %d\n", per_cu); per_cu = 1; }
        (void)hipGetLastError();
        grid = cus;
    }
    if (grid < 0) return;
    Params p{};
    for (int i = 0; i < 20; ++i) p.in[i] = (const float*)d_in[i];
    p.out = (float*)d_out; p.ws = (unsigned char*)d_ws;
#if ONE_LAUNCH
    p.ph_lo = 0; p.ph_hi = N_PHASES;
    void* args[] = {&p};
    hipError_t e = hipLaunchCooperativeKernel((const void*)hybrid_fwd, dim3(grid), dim3(NTHREADS), args, LDS_BYTES, stream);
    if (e != hipSuccess) fprintf(stderr, "cooperative launch failed: %s (grid %d)\n", hipGetErrorString(e), grid);
#else
    for (int ph = 0; ph < N_PHASES; ++ph) {
        p.ph_lo = ph; p.ph_hi = ph + 1;
        hipLaunchKernelGGL(hybrid_fwd, dim3(grid), dim3(NTHREADS), LDS_BYTES, stream, p);
    }
#endif
}
```
